# Optimizing an MI355X kernel written in HIP

```python
import math
import jax, jax.numpy as jnp
from jax import lax
import numpy as np

D_MODEL = 1024
BATCH = 8
SEQ = 4096
DEPTH = 2

GRID_W = 64
CTX_LEN = 256
BLOCK = 128
HEAD_DIM = 64
ROPE_THETA = 10000.0
ROPE_AXIS_PAIRS = HEAD_DIM // 4
EPS = 1e-6
NEG = -1e30
MIX_HALF = D_MODEL // 2

A_HEADS = MIX_HALF // HEAD_DIM
A_KV_HEADS = A_HEADS // 4
A_WINDOW = 128
B_VDIM = 2 * HEAD_DIM
B_HEADS = MIX_HALF // B_VDIM
C_WIDTH = MIX_HALF
C_GROUPS = 4
C_GROUP_DIM = C_WIDTH // C_GROUPS
C_CHUNK = 128
D_NOPE = 64
D_ROPE = 64
D_VDIM = 128
D_HEADS = MIX_HALF // D_VDIM
D_Q_RANK = D_MODEL // 4
D_KV_RANK = D_MODEL // 4
FFN_HIDDEN = ((-(-8 * D_MODEL // 3)) + 255) // 256 * 256

A_Q_DIM = A_HEADS * HEAD_DIM
A_KV_DIM = A_KV_HEADS * HEAD_DIM
B_QK_DIM = B_HEADS * 2 * HEAD_DIM
B_V_TOTAL = B_HEADS * B_VDIM
EVEN_Q = A_Q_DIM + B_QK_DIM
EVEN_KV = 2 * A_KV_DIM + B_QK_DIM + B_V_TOTAL
EVEN_IN = EVEN_Q + EVEN_KV
ODD_C = 2 * C_WIDTH
ODD_KV = D_KV_RANK + D_ROPE
ODD_IN = ODD_C + D_Q_RANK + ODD_KV
UQ_DIM = D_HEADS * (D_NOPE + D_ROPE)
UKV_DIM = D_HEADS * (D_NOPE + D_VDIM)

kernel_name = "hybrid_dit_prefix_ctx_block"


def rms_norm(x, g):
    xf = x.astype(jnp.float32)
    y = xf * lax.rsqrt(jnp.mean(xf * xf, axis=-1, keepdims=True) + EPS)
    return (y * g.astype(jnp.float32)).astype(x.dtype)


def axial_rope(n_tokens):
    rows = n_tokens // GRID_W
    row = jnp.repeat(jnp.arange(rows, dtype=jnp.int32), GRID_W).astype(jnp.float32)
    col = jnp.tile(jnp.arange(GRID_W, dtype=jnp.int32), rows).astype(jnp.float32)
    inv = ROPE_THETA ** (-jnp.arange(ROPE_AXIS_PAIRS, dtype=jnp.float32) / ROPE_AXIS_PAIRS)
    ang = jnp.concatenate([row[:, None] * inv, col[:, None] * inv], axis=-1)
    return jnp.cos(ang)[:, None, :], jnp.sin(ang)[:, None, :]


def apply_rope(x, cos, sin):
    x1, x2 = jnp.split(x, 2, axis=-1)
    return jnp.concatenate([x1 * cos - x2 * sin, x2 * cos + x1 * sin], axis=-1).astype(x.dtype)


def adaln(cvec, w, b, n):
    m = jax.nn.silu(cvec) @ w[:, :n * D_MODEL] + b[:n * D_MODEL]
    return jnp.split(m[..., None, :], n, axis=-1)


def modulate(h, shift, scale):
    return h * (1.0 + scale) + shift


def swiglu(h, w_in, w_out):
    g, u = jnp.split(h @ w_in, 2, axis=-1)
    return (jax.nn.silu(g) * u) @ w_out


def sweep_query_blocks(fn, qs):
    b_, s = qs[0].shape[:2]
    nb = s // BLOCK
    blocks = tuple(q.reshape((b_, nb, BLOCK) + q.shape[2:]).swapaxes(0, 1) for q in qs)
    out = lax.map(lambda t: fn(*t), blocks)
    return out.swapaxes(0, 1).reshape((b_, s) + out.shape[3:])


def window_gqa_sink_latent(q, k, v, kc, vc, sink):
    b_, s, h, d = q.shape
    nb = s // BLOCK
    grp = h // A_KV_HEADS
    scale = d ** -0.5
    qb = q.reshape(b_, nb, BLOCK, A_KV_HEADS, grp, d).swapaxes(0, 1)
    pad = ((0, 0), (BLOCK, BLOCK), (0, 0), (0, 0))
    kp = jnp.pad(k, pad)
    vp = jnp.pad(v, pad)
    offs = jnp.arange(3 * BLOCK) - BLOCK
    qi = jnp.arange(BLOCK)
    band = jnp.abs(qi[:, None] - offs[None, :]) <= A_WINDOW
    sink_l = sink.astype(jnp.float32).reshape(A_KV_HEADS, grp, 1, 1)

    def one_block(args):
        qn, n = args
        start = n * BLOCK
        kn = lax.dynamic_slice_in_dim(kp, start, 3 * BLOCK, axis=1)
        vn = lax.dynamic_slice_in_dim(vp, start, 3 * BLOCK, axis=1)
        kpos = start + offs
        mask = band & ((kpos >= 0) & (kpos < s))[None, :]
        s_loc = jnp.einsum('bqkgd,bmkd->bkgqm', qn, kn).astype(jnp.float32) * scale
        s_loc = jnp.where(mask, s_loc, NEG)
        s_ctx = jnp.einsum('bqkgd,blkd->bkgql', qn, kc).astype(jnp.float32) * scale
        snk = jnp.broadcast_to(sink_l, s_loc.shape[:-1] + (1,))
        p = jax.nn.softmax(jnp.concatenate([s_loc, s_ctx, snk], axis=-1), axis=-1).astype(v.dtype)
        return (jnp.einsum('bkgqm,bmkd->bqkgd', p[..., :3 * BLOCK], vn)
                + jnp.einsum('bkgql,blkd->bqkgd', p[..., 3 * BLOCK:-1], vc))

    out = lax.map(one_block, (qb, jnp.arange(nb)))
    return out.swapaxes(0, 1).reshape(b_, s, h * d)


def ctx_gqa_sink(qc, kc, vc, sink):
    b_, l, h, d = qc.shape
    grp = h // A_KV_HEADS
    qg = qc.reshape(b_, l, A_KV_HEADS, grp, d)
    sc = jnp.einsum('bqkgd,blkd->bkgql', qg, kc).astype(jnp.float32) * d ** -0.5
    snk = jnp.broadcast_to(sink.astype(jnp.float32).reshape(A_KV_HEADS, grp, 1, 1), sc.shape[:-1] + (1,))
    p = jax.nn.softmax(jnp.concatenate([sc, snk], axis=-1), axis=-1)[..., :-1].astype(vc.dtype)
    return jnp.einsum('bkgql,blkd->bqkgd', p, vc).reshape(b_, l, h * d)


def diff_core(q1, q2, k1, k2, v, lam, scale):
    p1 = jax.nn.softmax(jnp.einsum('bqhd,bkhd->bhqk', q1, k1).astype(jnp.float32) * scale, axis=-1)
    p2 = jax.nn.softmax(jnp.einsum('bqhd,bkhd->bhqk', q2, k2).astype(jnp.float32) * scale, axis=-1)
    w = (p1 - lam * p2).astype(v.dtype)
    return jnp.einsum('bhqk,bkhe->bqhe', w, v)


def diff_head_norm(o, g, lam_init):
    b_, n = o.shape[:2]
    return (rms_norm(o, g) * (1.0 - lam_init)).reshape(b_, n, B_V_TOTAL)


def diff_lambda_init(layer_idx):
    return 0.8 - 0.6 * math.exp(-0.3 * layer_idx)


def even_queries(t, qn_a, qn_b):
    b_, n = t.shape[:2]
    qa = rms_norm(t[..., :A_Q_DIM].reshape(b_, n, A_HEADS, HEAD_DIM), qn_a)
    qb = rms_norm(t[..., A_Q_DIM:].reshape(b_, n, B_HEADS, 2, HEAD_DIM), qn_b)
    return qa, qb[..., 0, :], qb[..., 1, :]


def even_keys_values(t, kn_a, kn_b):
    b_, n = t.shape[:2]
    o1 = A_KV_DIM
    o2 = 2 * A_KV_DIM
    o3 = o2 + B_QK_DIM
    ka = rms_norm(t[..., :o1].reshape(b_, n, A_KV_HEADS, HEAD_DIM), kn_a)
    va = t[..., o1:o2].reshape(b_, n, A_KV_HEADS, HEAD_DIM)
    kb = rms_norm(t[..., o2:o3].reshape(b_, n, B_HEADS, 2, HEAD_DIM), kn_b)
    vb = t[..., o3:].reshape(b_, n, B_HEADS, B_VDIM)
    return ka, va, kb[..., 0, :], kb[..., 1, :], vb


def even_mixers(h, hc, cos, sin, w_in, qn_a, kn_a, sink, qn_b, kn_b,
                lq1, lk1, lq2, lk2, subln, lam_init, ctx_out):
    pl = h @ w_in
    pc = hc @ (w_in if ctx_out else w_in[:, EVEN_Q:])
    qa, q1, q2 = even_queries(pl[..., :EVEN_Q], qn_a, qn_b)
    ka, va, k1, k2, vb = even_keys_values(pl[..., EVEN_Q:], kn_a, kn_b)
    kac, vac, k1c, k2c, vbc = even_keys_values(pc[..., -EVEN_KV:], kn_a, kn_b)
    qa, q1, q2 = apply_rope(qa, cos, sin), apply_rope(q1, cos, sin), apply_rope(q2, cos, sin)
    ka, k1, k2 = apply_rope(ka, cos, sin), apply_rope(k1, cos, sin), apply_rope(k2, cos, sin)
    f32 = jnp.float32
    lam = (jnp.exp(jnp.sum(lq1.astype(f32) * lk1.astype(f32)))
           - jnp.exp(jnp.sum(lq2.astype(f32) * lk2.astype(f32))) + lam_init)
    scale_b = HEAD_DIM ** -0.5

    out_a = window_gqa_sink_latent(qa, ka, va, kac, vac, sink)
    k1_all = jnp.concatenate([k1, k1c], axis=1)
    k2_all = jnp.concatenate([k2, k2c], axis=1)
    v_all = jnp.concatenate([vb, vbc], axis=1)
    ob = sweep_query_blocks(lambda a, b: diff_core(a, b, k1_all, k2_all, v_all, lam, scale_b), (q1, q2))
    out_b = diff_head_norm(ob, subln, lam_init)
    mix = jnp.concatenate([out_a, out_b], axis=-1)
    if not ctx_out:
        return mix, None
    qac, q1c, q2c = even_queries(pc[..., :EVEN_Q], qn_a, qn_b)
    out_ac = ctx_gqa_sink(qac, kac, vac, sink)
    out_bc = diff_head_norm(diff_core(q1c, q2c, k1c, k2c, vbc, lam, scale_b), subln, lam_init)
    return mix, jnp.concatenate([out_ac, out_bc], axis=-1)


def spatial_gating(uv, v_norm_g, w_s, b_s):
    b_, n, _ = uv.shape
    u, v = jnp.split(jax.nn.gelu(uv, approximate=False), 2, axis=-1)
    v = rms_norm(v, v_norm_g).reshape(b_, n // C_CHUNK, C_CHUNK, C_GROUPS, C_GROUP_DIM)
    vs = jnp.einsum('gpq,bnqgc->bnpgc', w_s, v) + b_s.T[:, :, None]
    return u * vs.reshape(b_, n, C_WIDTH)


def mla_queries(cq, qa_norm, w_uq, qn_nope, qn_rope):
    b_, n = cq.shape[:2]
    q = (rms_norm(cq, qa_norm) @ w_uq).reshape(b_, n, D_HEADS, D_NOPE + D_ROPE)
    return rms_norm(q[..., :D_NOPE], qn_nope), rms_norm(q[..., D_NOPE:], qn_rope)


def mla_keys_values(t, kva_norm, w_ukv, kn_nope, kn_rope):
    b_, n = t.shape[:2]
    kv = (rms_norm(t[..., :D_KV_RANK], kva_norm) @ w_ukv).reshape(b_, n, D_HEADS, D_NOPE + D_VDIM)
    k_pe = rms_norm(t[..., D_KV_RANK:], kn_rope)
    return rms_norm(kv[..., :D_NOPE], kn_nope), k_pe, kv[..., D_NOPE:]


def mla_core(qn, qp, kn, kp, v, scale):
    sc = (jnp.einsum('bqhd,bkhd->bhqk', qn, kn) + jnp.einsum('bqhr,bkr->bhqk', qp, kp)).astype(jnp.float32) * scale
    p = jax.nn.softmax(sc, axis=-1).astype(v.dtype)
    return jnp.einsum('bhqk,bkhe->bqhe', p, v)


def odd_mixers(h, hc, cos, sin, w_in, c_vnorm, c_ws, c_bs, qa_norm, kva_norm, w_uq, w_ukv,
               qn_nope, kn_nope, qn_rope, kn_rope, ctx_out):
    b_, s = h.shape[:2]
    pl = h @ w_in
    pc = hc @ (w_in if ctx_out else w_in[:, ODD_C + D_Q_RANK:])
    out_c = spatial_gating(pl[..., :ODD_C], c_vnorm, c_ws, c_bs)
    qn, qp = mla_queries(pl[..., ODD_C:ODD_C + D_Q_RANK], qa_norm, w_uq, qn_nope, qn_rope)
    kn, kp, v = mla_keys_values(pl[..., ODD_C + D_Q_RANK:], kva_norm, w_ukv, kn_nope, kn_rope)
    knc, kpc, vc = mla_keys_values(pc[..., -ODD_KV:], kva_norm, w_ukv, kn_nope, kn_rope)
    qp = apply_rope(qp, cos, sin)
    kp = apply_rope(kp[:, :, None, :], cos, sin)[:, :, 0, :]
    kn_all = jnp.concatenate([kn, knc], axis=1)
    kp_all = jnp.concatenate([kp, kpc], axis=1)
    v_all = jnp.concatenate([v, vc], axis=1)
    scale = (D_NOPE + D_ROPE) ** -0.5
    od = sweep_query_blocks(lambda a, b: mla_core(a, b, kn_all, kp_all, v_all, scale), (qn, qp))
    mix = jnp.concatenate([out_c, od.reshape(b_, s, D_HEADS * D_VDIM)], axis=-1)
    if not ctx_out:
        return mix, None
    l = hc.shape[1]
    out_cc = spatial_gating(pc[..., :ODD_C], c_vnorm, c_ws, c_bs)
    qnc, qpc = mla_queries(pc[..., ODD_C:ODD_C + D_Q_RANK], qa_norm, w_uq, qn_nope, qn_rope)
    out_dc = mla_core(qnc, qpc, knc, kpc, vc, scale).reshape(b_, l, D_HEADS * D_VDIM)
    return mix, jnp.concatenate([out_cc, out_dc], axis=-1)


def setup_inputs(seed: int = 0) -> dict:
    key = jax.random.key(seed)
    ks = iter(jax.random.split(key, 48))
    f32 = jnp.float32
    D = D_MODEL
    ne = (DEPTH + 1) // 2
    no = DEPTH // 2

    def nrm(shape, scale):
        return scale * jax.random.normal(next(ks), shape, f32)

    def gain(shape):
        return 1.0 + 0.02 * jax.random.normal(next(ks), shape, f32)

    return {
        "x": nrm((BATCH, SEQ, D), 1.0),
        "c": nrm((BATCH, D), 1.0),
        "ctx": nrm((BATCH, CTX_LEN, D), 1.0),
        "c_ctx": nrm((D,), 1.0),
        "norm1_g": gain((DEPTH, D)),
        "norm2_g": gain((DEPTH, D)),
        "ada_w": nrm((DEPTH, D, 6 * D), 0.5 * D ** -0.5),
        "ada_b": nrm((DEPTH, 6 * D), 0.01),
        "mix_w_out": nrm((DEPTH, D, D), D ** -0.5),
        "ffn_w_in": nrm((DEPTH, D, 2 * FFN_HIDDEN), D ** -0.5),
        "ffn_w_out": nrm((DEPTH, FFN_HIDDEN, D), FFN_HIDDEN ** -0.5),
        "ev_w_in": nrm((ne, D, EVEN_IN), D ** -0.5),
        "ev_qnorm_a": gain((ne, HEAD_DIM)),
        "ev_knorm_a": gain((ne, HEAD_DIM)),
        "ev_sink": nrm((ne, A_HEADS), 0.5),
        "ev_qnorm_b": gain((ne, HEAD_DIM)),
        "ev_knorm_b": gain((ne, HEAD_DIM)),
        "ev_lam_q1": nrm((ne, HEAD_DIM), 0.1),
        "ev_lam_k1": nrm((ne, HEAD_DIM), 0.1),
        "ev_lam_q2": nrm((ne, HEAD_DIM), 0.1),
        "ev_lam_k2": nrm((ne, HEAD_DIM), 0.1),
        "ev_subln": gain((ne, B_VDIM)),
        "od_w_in": nrm((no, D, ODD_IN), D ** -0.5),
        "od_c_vnorm": gain((no, C_WIDTH)),
        "od_c_ws": nrm((no, C_GROUPS, C_CHUNK, C_CHUNK), C_CHUNK ** -0.5),
        "od_c_bs": gain((no, C_GROUPS, C_CHUNK)),
        "od_qa_norm": gain((no, D_Q_RANK)),
        "od_kva_norm": gain((no, D_KV_RANK)),
        "od_w_uq": nrm((no, D_Q_RANK, UQ_DIM), D_Q_RANK ** -0.5),
        "od_w_ukv": nrm((no, D_KV_RANK, UKV_DIM), D_KV_RANK ** -0.5),
        "od_qnorm_nope": gain((no, D_NOPE)),
        "od_knorm_nope": gain((no, D_NOPE)),
        "od_qnorm_rope": gain((no, D_ROPE)),
        "od_knorm_rope": gain((no, D_ROPE)),
    }


def reference(x, c, ctx, c_ctx, norm1_g, norm2_g, ada_w, ada_b, mix_w_out, ffn_w_in, ffn_w_out,
              ev_w_in, ev_qnorm_a, ev_knorm_a, ev_sink, ev_qnorm_b, ev_knorm_b,
              ev_lam_q1, ev_lam_k1, ev_lam_q2, ev_lam_k2, ev_subln,
              od_w_in, od_c_vnorm, od_c_ws, od_c_bs, od_qa_norm, od_kva_norm, od_w_uq, od_w_ukv,
              od_qnorm_nope, od_knorm_nope, od_qnorm_rope, od_knorm_rope):
    n_lat = x.shape[1]
    cos, sin = axial_rope(n_lat)
    xc = ctx
    for i in range(DEPTH):
        last = i == DEPTH - 1
        j = i // 2
        ml = adaln(c, ada_w[i], ada_b[i], 6)
        mc = adaln(c_ctx, ada_w[i], ada_b[i], 2 if last else 6)
        h = modulate(rms_norm(x, norm1_g[i]), ml[0], ml[1])
        hc = modulate(rms_norm(xc, norm1_g[i]), mc[0], mc[1])
        if i % 2 == 0:
            mix, mix_c = even_mixers(h, hc, cos, sin, ev_w_in[j], ev_qnorm_a[j], ev_knorm_a[j], ev_sink[j],
                                     ev_qnorm_b[j], ev_knorm_b[j], ev_lam_q1[j], ev_lam_k1[j],
                                     ev_lam_q2[j], ev_lam_k2[j], ev_subln[j], diff_lambda_init(i), not last)
        else:
            mix, mix_c = odd_mixers(h, hc, cos, sin, od_w_in[j], od_c_vnorm[j], od_c_ws[j], od_c_bs[j],
                                    od_qa_norm[j], od_kva_norm[j], od_w_uq[j], od_w_ukv[j],
                                    od_qnorm_nope[j], od_knorm_nope[j], od_qnorm_rope[j], od_knorm_rope[j],
                                    not last)
        x = x + ml[2] * (mix @ mix_w_out[i])
        h2 = modulate(rms_norm(x, norm2_g[i]), ml[3], ml[4])
        x = x + ml[5] * swiglu(h2, ffn_w_in[i], ffn_w_out[i])
        if not last:
            xc = xc + mc[2] * (mix_c @ mix_w_out[i])
            hc2 = modulate(rms_norm(xc, norm2_g[i]), mc[3], mc[4])
            xc = xc + mc[5] * swiglu(hc2, ffn_w_in[i], ffn_w_out[i])
    return x
```

```cpp
#include <hip/hip_runtime.h>
#include <cstdio>
#include <cstdint>
#include <cmath>

namespace nv {
constexpr int D = 1024, S = 4096, L = 256, R = S + L, NB = 8, FF = 2816;
constexpr float EPS = 1e-6f;

__global__ void __launch_bounds__(256) k_ada(const float* c, const float* c_ctx, const float* ada_w, const float* ada_b, float* mod) {
    __shared__ float sc[9 * 1024];
    const int i = blockIdx.y, n = blockIdx.x * 256 + threadIdx.x;
    for (int idx = threadIdx.x; idx < 9 * 1024; idx += 256) { const int r = idx / 1024, k = idx % 1024; const float v = r < 8 ? c[r * 1024 + k] : c_ctx[k]; sc[idx] = v / (1.f + expf(-v)); }
    __syncthreads();
    float acc[9];
#pragma unroll
    for (int r = 0; r < 9; ++r) acc[r] = 0.f;
    const float* w = ada_w + (size_t)i * 1024 * 6144;
    for (int k = 0; k < 1024; ++k) { const float wv = w[(size_t)k * 6144 + n];
#pragma unroll
        for (int r = 0; r < 9; ++r) acc[r] += sc[r * 1024 + k] * wv; }
#pragma unroll
    for (int r = 0; r < 9; ++r) mod[(size_t)(i * 9 + r) * 6144 + n] = acc[r] + ada_b[i * 6144 + n];
}

__global__ void k_load_x(const float* x, const float* ctx, float* X, int b) {
    const size_t idx = (size_t)blockIdx.x * 256 + threadIdx.x; if (idx >= (size_t)R * D) return;
    const int r = (int)(idx / D), cc = (int)(idx % D);
    X[idx] = r < S ? x[((size_t)b * S + r) * D + cc] : ctx[((size_t)b * L + (r - S)) * D + cc];
}
__global__ void k_store_out(const float* X, float* out, int b) {
    const size_t idx = (size_t)blockIdx.x * 256 + threadIdx.x; if (idx >= (size_t)S * D) return;
    out[(size_t)b * S * D + idx] = X[idx];
}

__device__ __forceinline__ float block_sum256(float v, float* red) {
#pragma unroll
    for (int o = 32; o > 0; o >>= 1) v += __shfl_xor(v, o);
    __syncthreads();
    if ((threadIdx.x & 63) == 0) red[threadIdx.x >> 6] = v;
    __syncthreads();
    return red[0] + red[1] + red[2] + red[3];
}
__global__ void __launch_bounds__(256) k_ln_mod(const float* X, const float* g, const float* modl, int b, int ch, float* H) {
    __shared__ float red[4];
    const int r = blockIdx.x; const float* xr = X + (size_t)r * D; const float* m = modl + (size_t)(r < S ? b : 8) * 6144;
    float v[4], ss = 0.f;
#pragma unroll
    for (int j = 0; j < 4; ++j) { v[j] = xr[threadIdx.x + 256 * j]; ss += v[j] * v[j]; }
    const float tot = block_sum256(ss, red); const float rs = 1.0f / sqrtf(tot / D + EPS);
#pragma unroll
    for (int j = 0; j < 4; ++j) { const int cc = threadIdx.x + 256 * j; H[(size_t)r * D + cc] = v[j] * rs * g[cc] * (1.f + m[(ch + 1) * D + cc]) + m[ch * D + cc]; }
}
__global__ void __launch_bounds__(256) k_rownorm(float* buf, int ld, int col0, int width, const float* g) {
    __shared__ float red[4];
    float* p = buf + (size_t)blockIdx.x * ld + col0; float ss = 0.f;
    for (int cc = threadIdx.x; cc < width; cc += 256) ss += p[cc] * p[cc];
    const float tot = block_sum256(ss, red); const float rs = 1.0f / sqrtf(tot / width + EPS);
    for (int cc = threadIdx.x; cc < width; cc += 256) p[cc] = p[cc] * rs * g[cc];
}

__global__ void __launch_bounds__(256) k_gemm(const float* A, int lda, const float* B, int ldb, float* C, int ldc, int K) {
    __shared__ float As[16][68];
    __shared__ float Bs[16][68];
    const int tx = threadIdx.x % 16, ty = threadIdx.x / 16, m0 = blockIdx.y * 64, n0 = blockIdx.x * 64;
    float acc[4][4];
#pragma unroll
    for (int i = 0; i < 4; ++i)
#pragma unroll
        for (int j = 0; j < 4; ++j) acc[i][j] = 0.f;
    for (int k0 = 0; k0 < K; k0 += 16) {
#pragma unroll
        for (int i = 0; i < 4; ++i) { const int idx = threadIdx.x + i * 256; const int m = idx / 16, k = idx % 16; As[k][m] = A[(size_t)(m0 + m) * lda + k0 + k]; }
#pragma unroll
        for (int i = 0; i < 4; ++i) { const int idx = threadIdx.x + i * 256; const int k = idx / 64, n = idx % 64; Bs[k][n] = B[(size_t)(k0 + k) * ldb + n0 + n]; }
        __syncthreads();
#pragma unroll
        for (int k = 0; k < 16; ++k) { float a[4], bb[4];
#pragma unroll
            for (int i = 0; i < 4; ++i) { a[i] = As[k][ty * 4 + i]; bb[i] = Bs[k][tx * 4 + i]; }
#pragma unroll
            for (int i = 0; i < 4; ++i)
#pragma unroll
                for (int j = 0; j < 4; ++j) acc[i][j] += a[i] * bb[j]; }
        __syncthreads();
    }
#pragma unroll
    for (int i = 0; i < 4; ++i)
#pragma unroll
        for (int j = 0; j < 4; ++j) C[(size_t)(m0 + ty * 4 + i) * ldc + n0 + tx * 4 + j] = acc[i][j];
}

__global__ void k_headnorm_rope(float* buf, int ld, int col0, int ustride, int nunits, const float* g, int do_rope, int nrows) {
    const int idx = blockIdx.x * blockDim.x + threadIdx.x; if (idx >= nrows * nunits) return;
    const int r = idx / nunits, u = idx % nunits; float* p = buf + (size_t)r * ld + col0 + u * ustride;
    float ss = 0.f; for (int d = 0; d < 64; ++d) ss += p[d] * p[d];
    const float rs = 1.0f / sqrtf(ss / 64.f + EPS);
    if (do_rope && r < S) {
        const float row = (float)(r / 64), col = (float)(r % 64);
        for (int i = 0; i < 32; ++i) { const float inv = powf(10000.f, -(float)(i % 16) / 16.f); const float ang = (i < 16 ? row : col) * inv; const float cs = cosf(ang), sn = sinf(ang);
            const float x1 = p[i] * rs * g[i], x2 = p[i + 32] * rs * g[i + 32]; p[i] = x1 * cs - x2 * sn; p[i + 32] = x2 * cs + x1 * sn; }
    } else for (int d = 0; d < 64; ++d) p[d] = p[d] * rs * g[d];
}

template <int DQK> __global__ void __launch_bounds__(64) k_attn(const float* Q, int ldq, int qoff, int qhs, const float* Kp, int ldk, int koff, int khs, const float* Vp, int ldv, int voff, int vhs,
                                                                 float* O, int ldo, int ooff, int ohs, int q0, int gqa, float scale, int a0, int a1, int win, int b0, int b1, const float* sink) {
    const int tb = q0 + blockIdx.x * 64, t = tb + threadIdx.x, h = blockIdx.y, sl = blockIdx.z, kvh = h / gqa;
    float q[DQK];
#pragma unroll
    for (int d = 0; d < DQK; ++d) q[d] = Q[(size_t)t * ldq + qoff + h * qhs + d] * scale;
    float o[32];
#pragma unroll
    for (int j = 0; j < 32; ++j) o[j] = 0.f;
    float m = -INFINITY, l = 0.f;
    int lo = a0, hi = a1; if (win >= 0) { lo = max(a0, tb - win); hi = min(a1, tb + 63 + win + 1); }
    for (int seg = 0; seg < 2; ++seg) {
        const int k0 = seg == 0 ? lo : b0, k1 = seg == 0 ? hi : b1;
        for (int k = k0; k < k1; ++k) {
            const float* kr = Kp + (size_t)k * ldk + koff + kvh * khs; float s = 0.f;
#pragma unroll
            for (int d = 0; d < DQK; ++d) s += q[d] * kr[d];
            const bool valid = !(seg == 0 && win >= 0) || (abs(t - k) <= win);
            if (valid) { const float mn = fmaxf(m, s), a = expf(m - mn), p = expf(s - mn); l = l * a + p; const float* vr = Vp + (size_t)k * ldv + voff + kvh * vhs + sl * 32;
#pragma unroll
                for (int j = 0; j < 32; ++j) o[j] = o[j] * a + p * vr[j];
                m = mn; }
        }
    }
    if (sink) { const float sv = sink[h]; const float mn = fmaxf(m, sv), a = expf(m - mn); l = l * a + expf(sv - mn);
#pragma unroll
        for (int j = 0; j < 32; ++j) o[j] *= a; }
    const float il = 1.f / l;
#pragma unroll
    for (int j = 0; j < 32; ++j) O[(size_t)t * ldo + ooff + h * ohs + sl * 32 + j] = o[j] * il;
}

__global__ void k_diff_combine(const float* O1, const float* O2, const float* lq1, const float* lk1, const float* lq2, const float* lk2, const float* subln, float lam_init, float* MIX, int nrows) {
    const int idx = blockIdx.x * blockDim.x + threadIdx.x; if (idx >= nrows * 4) return;
    const int r = idx / 4, h = idx % 4;
    float s1 = 0.f, s2 = 0.f; for (int d = 0; d < 64; ++d) { s1 += lq1[d] * lk1[d]; s2 += lq2[d] * lk2[d]; }
    const float lam = expf(s1) - expf(s2) + lam_init;
    const float* a = O1 + (size_t)r * 512 + h * 128; const float* bq = O2 + (size_t)r * 512 + h * 128;
    float ss = 0.f; for (int d = 0; d < 128; ++d) { const float v = a[d] - lam * bq[d]; ss += v * v; }
    const float rs = 1.0f / sqrtf(ss / 128.f + EPS);
    for (int d = 0; d < 128; ++d) MIX[(size_t)r * D + 512 + h * 128 + d] = (a[d] - lam * bq[d]) * rs * subln[d] * (1.f - lam_init);
}

__global__ void k_resid(float* X, const float* T, const float* modl, int b, int ch, int nrows) {
    const size_t idx = (size_t)blockIdx.x * 256 + threadIdx.x; if (idx >= (size_t)nrows * D) return;
    const int r = (int)(idx / D), cc = (int)(idx % D);
    X[idx] += modl[(size_t)(r < S ? b : 8) * 6144 + ch * D + cc] * T[idx];
}
__global__ void k_swiglu(const float* PL, float* ACT, int nrows) {
    const size_t idx = (size_t)blockIdx.x * 256 + threadIdx.x; if (idx >= (size_t)nrows * FF) return;
    const int r = (int)(idx / FF), j = (int)(idx % FF); const float gv = PL[(size_t)r * 2 * FF + j], u = PL[(size_t)r * 2 * FF + FF + j];
    ACT[idx] = gv / (1.f + expf(-gv)) * u;
}
__global__ void k_gelu(float* PL, int ld, int ncols, int nrows) {
    const size_t idx = (size_t)blockIdx.x * 256 + threadIdx.x; if (idx >= (size_t)nrows * ncols) return;
    const int r = (int)(idx / ncols), cc = (int)(idx % ncols); float* p = PL + (size_t)r * ld + cc; const float v = *p;
    *p = 0.5f * v * (1.f + erff(v * 0.70710678118654752f));
}
__global__ void k_spatial(const float* PL, int ld, const float* ws, const float* bs, float* MIX, int nrows) {
    const size_t idx = (size_t)blockIdx.x * 256 + threadIdx.x; if (idx >= (size_t)nrows * 512) return;
    const int r = (int)(idx / 512), cc = (int)(idx % 512), gI = cc / 128, p = r % 128, ch = r / 128;
    float acc = 0.f; const float* w = ws + ((size_t)gI * 128 + p) * 128;
    for (int qq = 0; qq < 128; ++qq) acc += w[qq] * PL[(size_t)(ch * 128 + qq) * ld + 512 + cc];
    MIX[(size_t)r * D + cc] = PL[(size_t)r * ld + cc] * (acc + bs[gI * 128 + p]);
}
__global__ void k_build_kc(const float* KVU, const float* PL, int ldp, float* KC, int nrows) {
    const size_t idx = (size_t)blockIdx.x * 256 + threadIdx.x; if (idx >= (size_t)nrows * 512) return;
    const int r = (int)(idx / 512), cc = (int)(idx % 512), h = cc / 128, d = cc % 128;
    KC[idx] = d < 64 ? KVU[(size_t)r * 768 + h * 192 + d] : PL[(size_t)r * ldp + 1536 + d - 64];
}

struct In { const float *x, *c, *ctx, *c_ctx, *norm1_g, *norm2_g, *ada_w, *ada_b, *mix_w_out, *ffn_w_in, *ffn_w_out, *ev_w_in, *ev_qnorm_a, *ev_knorm_a, *ev_sink, *ev_qnorm_b, *ev_knorm_b,
    *ev_lam_q1, *ev_lam_k1, *ev_lam_q2, *ev_lam_k2, *ev_subln, *od_w_in, *od_c_vnorm, *od_c_ws, *od_c_bs, *od_qa_norm, *od_kva_norm, *od_w_uq, *od_w_ukv, *od_qnorm_nope, *od_knorm_nope, *od_qnorm_rope, *od_knorm_rope; };

static inline unsigned cdiv(size_t a, size_t b) { return (unsigned)((a + b - 1) / b); }

static void gemm(hipStream_t st, const float* A, int lda, const float* B, int ldb, float* C, int ldc, int M, int N, int K) {
    hipLaunchKernelGGL(k_gemm, dim3(N / 64, M / 64), dim3(256), 0, st, A, lda, B, ldb, C, ldc, K);
}

static void forward(const In& I, float* out, float* ws, int b_lo, int b_hi, hipStream_t st) {
    float* MOD = ws; ws += 2 * 9 * 6144;
    float* X = ws; ws += (size_t)R * D;
    float* H = ws; ws += (size_t)R * D;
    float* PL = ws; ws += (size_t)R * 5632;
    float* MIX = ws; ws += (size_t)R * D;
    float* T = ws; ws += (size_t)R * D;
    float* ACT = ws; ws += (size_t)R * FF;
    float* QU = ws; ws += (size_t)R * 512;
    float* KC = ws; ws += (size_t)R * 512;
    float* KVU = ws; ws += (size_t)R * 768;
    float* O1 = ws; ws += (size_t)R * 512;
    float* O2 = ws; ws += (size_t)R * 512;
    hipLaunchKernelGGL(k_ada, dim3(6144 / 256, 2), dim3(256), 0, st, I.c, I.c_ctx, I.ada_w, I.ada_b, MOD);
    for (int b = b_lo; b < b_hi; ++b) {
        hipLaunchKernelGGL(k_load_x, dim3(cdiv((size_t)R * D, 256)), dim3(256), 0, st, I.x, I.ctx, X, b);
        for (int i = 0; i < 2; ++i) {
            const float* modl = MOD + (size_t)i * 9 * 6144;
            hipLaunchKernelGGL(k_ln_mod, dim3(R), dim3(256), 0, st, X, I.norm1_g + i * D, modl, b, 0, H);
            if (i == 0) {
                const int ld = 2304;
                gemm(st, H, D, I.ev_w_in, ld, PL, ld, R, ld, D);
                hipLaunchKernelGGL(k_headnorm_rope, dim3(cdiv((size_t)R * 8, 256)), dim3(256), 0, st, PL, ld, 0, 64, 8, I.ev_qnorm_a, 1, R);
                hipLaunchKernelGGL(k_headnorm_rope, dim3(cdiv((size_t)R * 8, 256)), dim3(256), 0, st, PL, ld, 512, 64, 8, I.ev_qnorm_b, 1, R);
                hipLaunchKernelGGL(k_headnorm_rope, dim3(cdiv((size_t)R * 2, 256)), dim3(256), 0, st, PL, ld, 1024, 64, 2, I.ev_knorm_a, 1, R);
                hipLaunchKernelGGL(k_headnorm_rope, dim3(cdiv((size_t)R * 8, 256)), dim3(256), 0, st, PL, ld, 1280, 64, 8, I.ev_knorm_b, 1, R);
                hipLaunchKernelGGL(k_attn<64>, dim3(S / 64, 8, 2), dim3(64), 0, st, PL, ld, 0, 64, PL, ld, 1024, 64, PL, ld, 1152, 64, MIX, D, 0, 64, 0, 4, 0.125f, 0, S, 128, S, R, I.ev_sink);
                hipLaunchKernelGGL(k_attn<64>, dim3(L / 64, 8, 2), dim3(64), 0, st, PL, ld, 0, 64, PL, ld, 1024, 64, PL, ld, 1152, 64, MIX, D, 0, 64, S, 4, 0.125f, S, R, -1, 0, 0, I.ev_sink);
                for (int s2 = 0; s2 < 2; ++s2) {
                    float* O = s2 ? O2 : O1;
                    hipLaunchKernelGGL(k_attn<64>, dim3(S / 64, 4, 4), dim3(64), 0, st, PL, ld, 512 + 64 * s2, 128, PL, ld, 1280 + 64 * s2, 128, PL, ld, 1792, 128, O, 512, 0, 128, 0, 1, 0.125f, 0, R, -1, 0, 0, (const float*)nullptr);
                    hipLaunchKernelGGL(k_attn<64>, dim3(L / 64, 4, 4), dim3(64), 0, st, PL, ld, 512 + 64 * s2, 128, PL, ld, 1280 + 64 * s2, 128, PL, ld, 1792, 128, O, 512, 0, 128, S, 1, 0.125f, S, R, -1, 0, 0, (const float*)nullptr);
                }
                const float lam_init = 0.8f - 0.6f * expf(-0.3f * (float)i);
                hipLaunchKernelGGL(k_diff_combine, dim3(cdiv((size_t)R * 4, 256)), dim3(256), 0, st, O1, O2, I.ev_lam_q1, I.ev_lam_k1, I.ev_lam_q2, I.ev_lam_k2, I.ev_subln, lam_init, MIX, R);
            } else {
                const int ld = 1600;
                gemm(st, H, D, I.od_w_in, ld, PL, ld, R, ld, D);
                hipLaunchKernelGGL(k_gelu, dim3(cdiv((size_t)R * 1024, 256)), dim3(256), 0, st, PL, ld, 1024, R);
                hipLaunchKernelGGL(k_rownorm, dim3(R), dim3(256), 0, st, PL, ld, 512, 512, I.od_c_vnorm);
                hipLaunchKernelGGL(k_spatial, dim3(cdiv((size_t)R * 512, 256)), dim3(256), 0, st, PL, ld, I.od_c_ws, I.od_c_bs, MIX, R);
                hipLaunchKernelGGL(k_rownorm, dim3(R), dim3(256), 0, st, PL, ld, 1024, 256, I.od_qa_norm);
                hipLaunchKernelGGL(k_rownorm, dim3(R), dim3(256), 0, st, PL, ld, 1280, 256, I.od_kva_norm);
                gemm(st, PL + 1024, ld, I.od_w_uq, 512, QU, 512, R, 512, 256);
                gemm(st, PL + 1280, ld, I.od_w_ukv, 768, KVU, 768, R, 768, 256);
                hipLaunchKernelGGL(k_headnorm_rope, dim3(cdiv((size_t)R * 4, 256)), dim3(256), 0, st, QU, 512, 0, 128, 4, I.od_qnorm_nope, 0, R);
                hipLaunchKernelGGL(k_headnorm_rope, dim3(cdiv((size_t)R * 4, 256)), dim3(256), 0, st, QU, 512, 64, 128, 4, I.od_qnorm_rope, 1, R);
                hipLaunchKernelGGL(k_headnorm_rope, dim3(cdiv((size_t)R * 4, 256)), dim3(256), 0, st, KVU, 768, 0, 192, 4, I.od_knorm_nope, 0, R);
                hipLaunchKernelGGL(k_headnorm_rope, dim3(cdiv((size_t)R * 1, 256)), dim3(256), 0, st, PL, ld, 1536, 64, 1, I.od_knorm_rope, 1, R);
                hipLaunchKernelGGL(k_build_kc, dim3(cdiv((size_t)R * 512, 256)), dim3(256), 0, st, KVU, PL, ld, KC, R);
                hipLaunchKernelGGL(k_attn<128>, dim3(S / 64, 4, 4), dim3(64), 0, st, QU, 512, 0, 128, KC, 512, 0, 128, KVU, 768, 64, 192, MIX, D, 512, 128, 0, 1, 0.08838834764831845f, 0, R, -1, 0, 0, (const float*)nullptr);
                hipLaunchKernelGGL(k_attn<128>, dim3(L / 64, 4, 4), dim3(64), 0, st, QU, 512, 0, 128, KC, 512, 0, 128, KVU, 768, 64, 192, MIX, D, 512, 128, S, 1, 0.08838834764831845f, S, R, -1, 0, 0, (const float*)nullptr);
            }
            gemm(st, MIX, D, I.mix_w_out + (size_t)i * D * D, D, T, D, R, D, D);
            hipLaunchKernelGGL(k_resid, dim3(cdiv((size_t)R * D, 256)), dim3(256), 0, st, X, T, modl, b, 2, R);
            hipLaunchKernelGGL(k_ln_mod, dim3(R), dim3(256), 0, st, X, I.norm2_g + i * D, modl, b, 3, H);
            gemm(st, H, D, I.ffn_w_in + (size_t)i * D * 2 * FF, 2 * FF, PL, 2 * FF, R, 2 * FF, D);
            hipLaunchKernelGGL(k_swiglu, dim3(cdiv((size_t)R * FF, 256)), dim3(256), 0, st, PL, ACT, R);
            gemm(st, ACT, FF, I.ffn_w_out + (size_t)i * FF * D, D, T, D, R, D, FF);
            hipLaunchKernelGGL(k_resid, dim3(cdiv((size_t)R * D, 256)), dim3(256), 0, st, X, T, modl, b, 5, R);
        }
        if (out) hipLaunchKernelGGL(k_store_out, dim3(cdiv((size_t)S * D, 256)), dim3(256), 0, st, X, out, b);
    }
}
}

extern "C" void kernel_launch(void* const* d_in, const int* in_sizes, int n_in, void* d_out, int out_size, void* d_ws, size_t ws_size, hipStream_t stream) {
    nv::In I;
    const float** ip = (const float**)&I;
    for (int i = 0; i < 34; ++i) ip[i] = (const float*)d_in[i];
    nv::forward(I, (float*)d_out, (float*)d_ws, 0, 8, stream);
}
```

```cpp
#define DBG_CHK 0
#define DBG_PH_END 17
#include <hip/hip_runtime.h>
#include <cstdio>
#include <cstdint>
#ifndef TS_PHASE
#define TS_PHASE -1
#endif
#ifndef TS_BLOCK
#define TS_BLOCK 0
#endif
#define TS_GEMM (TS_PHASE >= 110 && TS_PHASE <= 114)
#ifndef TS_GEMM_ID
#define TS_GEMM_ID -1
#endif
namespace pg8 {
#define PG8_LAS __attribute__((address_space(3)))
typedef unsigned short bf16_t;
typedef short bf16x8 __attribute__((ext_vector_type(8)));
typedef float f32x4 __attribute__((ext_vector_type(4)));
typedef unsigned u32x4 __attribute__((ext_vector_type(4)));
constexpr int BM = 256, BK = 64, HALF = 128, HTB = HALF * BK * 2  , STAGE_BYTES = 8 * HTB, NXCD = 8, WGM = 8;

__host__ __device__ __forceinline__ int lds_byte(int r, int c) { const int st = (r >> 4) * 2 + (c >> 5), rr = r & 15, cc = c & 31, ob = rr * 64 + cc * 2; return st * 1024 + (ob ^ (((ob >> 9) & 1) << 5)); }
__host__ __device__ __forceinline__ void stage_rc(int b, int& R, int& C) { const int st = b / 1024, sb = b % 1024, swz = sb ^ (((sb >> 9) & 1) << 5); R = (st >> 1) * 16 + swz / 64; C = (st & 1) * 32 + (swz % 64) / 2; }
__host__ __device__ __forceinline__ int perm32(int rho) { const int n = rho >> 4, i = rho & 15; return 8 * (i >> 2) + 4 * n + (i & 3); }

struct Unit { int pm, pn, k0, nt, aux; };
struct Gemm { const bf16_t* A; const bf16_t* Bt; int M, N, K; };

struct StaticOrder {
    int nM, nN, nwg, G, c;
    __host__ __device__ void init(int M, int N, int G_, int c_) { nM = M / BM; nN = N / BM; nwg = nM * nN; G = G_; c = c_; }
    __host__ __device__ bool next(int i, Unit& u) const {
        const long L = (long)i * G + c; if (L >= nwg) return false;
        int wgid = (int)L; { const int q = nwg / NXCD, r = nwg % NXCD, xcd = wgid % NXCD, off = wgid / NXCD; wgid = (xcd < r ? xcd * (q + 1) : r * (q + 1) + (xcd - r) * q) + off; }
        const int nig = WGM * nN, gid = wgid / nig, fm = gid * WGM, gsz = (nM - fm) < WGM ? (nM - fm) : WGM;
        u.pm = fm + ((wgid % nig) % gsz); u.pn = (wgid % nig) / gsz; u.k0 = 0; u.nt = 0; u.aux = 0; return true;
    }
    __device__ __forceinline__ void a_ready(const Unit&) const {}
    __device__ __forceinline__ void done(const Unit&) const {}
};

__device__ __forceinline__ unsigned cvt_pk_bf16(float lo, float hi) { unsigned r; asm volatile("v_cvt_pk_bf16_f32 %0, %1, %2" : "=v"(r) : "v"(lo), "v"(hi)); return r; }
typedef float f32x2 __attribute__((ext_vector_type(2)));
__device__ __forceinline__ f32x2 gelu_pk(f32x2 v) {
    const f32x2 av = __builtin_elementwise_abs(v), d = av * 0.2316418882f + 1.0f;
    f32x2 t; t.x = __builtin_amdgcn_rcpf(d.x); t.y = __builtin_amdgcn_rcpf(d.y);
    f32x2 q = t * 0.5307027145f + (-0.7265760135f); q = q * t + 0.7107068705f; q = q * t + (-0.142248368f); q = q * t + 0.127414796f; q = q * t;
    const f32x2 s = (v * v) * (-0.72134752044f);
    f32x2 e; e.x = __builtin_amdgcn_exp2f(s.x); e.y = __builtin_amdgcn_exp2f(s.y);
    const f32x2 m = v * (q * e), r = v - m;
    f32x2 o; o.x = v.x < 0.f ? m.x : r.x; o.y = v.y < 0.f ? m.y : r.y; return o;
}

template <int ACT  > struct EpiBf16 {
    static constexpr bool PERM = true, AFTER_DRAIN = false; static_assert(ACT == 0 || ACT == 1, "EpiBf16: ACT is 0 (none) or 1 (gelu_pk)");
    bf16_t* O; int ldc; const float* bias; int split_cols; size_t split_stride; float scale0;
    __device__ __forceinline__ void operator()(const f32x4 (&acc)[2][2][4][2], const Unit& u, int wr, int wc, int fr, int fq) const {
        const int row0 = u.pm * BM + wr * 64 + fr; int colt = u.pn * BM; bf16_t* base = O;
        float sc = 1.f; if (split_cols) { const int t = colt / split_cols; base += (size_t)t * split_stride; colt -= t * split_cols; if (t == 0) sc = scale0; }
        const int col0 = colt + wc * 32 + 8 * fq, bcol0 = u.pn * BM + wc * 32 + 8 * fq;
        f32x4 bv[2][2];
#pragma unroll
        for (int bj = 0; bj < 2; ++bj)
#pragma unroll
            for (int n = 0; n < 2; ++n) bv[bj][n] = bias ? *(const f32x4*)(bias + bcol0 + bj * HALF + 4 * n) : (f32x4){0.f, 0.f, 0.f, 0.f};
#pragma unroll
        for (int ai = 0; ai < 2; ++ai)
#pragma unroll
            for (int m = 0; m < 4; ++m) { bf16_t* rowp = base + (size_t)(row0 + ai * HALF + m * 16) * ldc + col0;
#pragma unroll
                for (int bj = 0; bj < 2; ++bj) { f32x4 v0 = acc[ai][bj][m][0] + bv[bj][0], v1 = acc[ai][bj][m][1] + bv[bj][1];
                    if (ACT == 1) { f32x2 a = gelu_pk((f32x2){v0[0], v0[1]}), b = gelu_pk((f32x2){v0[2], v0[3]}), c = gelu_pk((f32x2){v1[0], v1[1]}), d = gelu_pk((f32x2){v1[2], v1[3]});
                        v0 = (f32x4){a.x, a.y, b.x, b.y}; v1 = (f32x4){c.x, c.y, d.x, d.y}; }
                    v0 = v0 * sc; v1 = v1 * sc; u32x4 w; w.x = cvt_pk_bf16(v0[0], v0[1]); w.y = cvt_pk_bf16(v0[2], v0[3]); w.z = cvt_pk_bf16(v1[0], v1[1]); w.w = cvt_pk_bf16(v1[2], v1[3]);
                    *(u32x4*)(rowp + bj * HALF) = w; } }
    }
};

struct PanelStats {
    unsigned* xbuf;
    unsigned* cnt;
    unsigned* tmo;
    int ntn; float eps;
    unsigned code;
    __device__ __forceinline__ bool run(const f32x4 (&v)[2][2][4][2], const Unit& u, int wr, int wc, int fr, int fq, PG8_LAS unsigned char* lds, int wid, int lane) const {
        typedef float f32x2v __attribute__((ext_vector_type(2)));
        PG8_LAS f32x2v* P = (PG8_LAS f32x2v*)lds;
        PG8_LAS f32x2v* S = (PG8_LAS f32x2v*)(lds + 8192);
        PG8_LAS unsigned* flag = (PG8_LAS unsigned*)(lds + 8192 + 2048);
#pragma unroll
        for (int ai = 0; ai < 2; ++ai)
#pragma unroll
            for (int m = 0; m < 4; ++m) {
                float s = 0.f;
#pragma unroll
                for (int bj = 0; bj < 2; ++bj)
#pragma unroll
                    for (int n = 0; n < 2; ++n) { const f32x4 x = v[ai][bj][m][n]; s += (x[0] + x[1]) + (x[2] + x[3]); }
                s += __shfl_xor(s, 16); s += __shfl_xor(s, 32);
                const float mw = s * (1.0f / 64.0f); float q = 0.f;
#pragma unroll
                for (int bj = 0; bj < 2; ++bj)
#pragma unroll
                    for (int n = 0; n < 2; ++n) { const f32x4 d = v[ai][bj][m][n] - mw; q += (d[0] * d[0] + d[1] * d[1]) + (d[2] * d[2] + d[3] * d[3]); }
                q += __shfl_xor(q, 16); q += __shfl_xor(q, 32);
                if (fq == 0) P[(ai * HALF + wr * 64 + m * 16 + fr) * 4 + wc] = (f32x2v){mw, q};
            }
        asm volatile("s_waitcnt lgkmcnt(0)" ::: "memory"); __builtin_amdgcn_s_barrier(); asm volatile("" ::: "memory");
#if defined(BROKEN_EXCHANGE_NO_WAIT)
#warning BROKEN CONTROL BUILD: the row-statistics exchange does not wait; results are wrong by design
        if (blockIdx.x >= 64) { const long long t0_ = clock64(); while (clock64() - t0_ < 60000) __builtin_amdgcn_s_sleep(8); }
#endif
        const int row = wid * 32 + (lane & 31);
        if (lane < 32) {
            const f32x2v a = P[row * 4 + 0], b = P[row * 4 + 1], c = P[row * 4 + 2], d = P[row * 4 + 3];
            const float mt = (a.x + b.x + c.x + d.x) * 0.25f;
            const float da = a.x - mt, db = b.x - mt, dc = c.x - mt, dd = d.x - mt;
            const float m2 = (a.y + b.y) + (c.y + d.y) + 64.0f * ((da * da + db * db) + (dc * dc + dd * dd));
            unsigned long long* slot = (unsigned long long*)xbuf + ((size_t)(u.pm * BM + row) * 4 + u.pn);
            __hip_atomic_store(slot, ((unsigned long long)__float_as_uint(m2) << 32) | __float_as_uint(mt), __ATOMIC_RELAXED, __HIP_MEMORY_SCOPE_AGENT);
        }
        asm volatile("s_waitcnt vmcnt(0)" ::: "memory");
        if (lane == 0) __hip_atomic_fetch_add(cnt + 64 * u.pm, 1u, __ATOMIC_RELAXED, __HIP_MEMORY_SCOPE_AGENT);
        if (wid == 0) {
            bool dead = false; const unsigned long long t0 = __builtin_amdgcn_s_memrealtime(); const unsigned want = 8u * (unsigned)ntn;
            for (;;) {
#if defined(BROKEN_EXCHANGE_NO_WAIT)
                break;
#endif
                if ((unsigned)__builtin_amdgcn_readfirstlane(__hip_atomic_load(cnt + 64 * u.pm, __ATOMIC_RELAXED, __HIP_MEMORY_SCOPE_AGENT)) >= want) break;
                if (__builtin_amdgcn_s_memrealtime() - t0 > 2000000ull) {
                    if (lane == 0) { unsigned expect = 0u; __hip_atomic_compare_exchange_strong(tmo + 1, &expect, code | (unsigned)(u.pm & 0xff), __ATOMIC_RELAXED, __ATOMIC_RELAXED, __HIP_MEMORY_SCOPE_AGENT);
                                     __hip_atomic_store(tmo, 1u, __ATOMIC_RELAXED, __HIP_MEMORY_SCOPE_AGENT); }
                    dead = true; break; }
                __builtin_amdgcn_s_sleep(2);
            }
            __builtin_amdgcn_fence(__ATOMIC_ACQUIRE, "agent");
            if (lane == 0) flag[0] = dead ? 1u : 0u;
        }
        asm volatile("s_waitcnt vmcnt(0) lgkmcnt(0)" ::: "memory"); __builtin_amdgcn_s_barrier(); asm volatile("" ::: "memory");
        const bool bad = flag[0] != 0u;
        if (lane < 32) {
            const unsigned long long* slot = (const unsigned long long*)xbuf + (size_t)(u.pm * BM + row) * 4; float mt[4], m2[4]; float ms = 0.f;
#pragma unroll
            for (int t = 0; t < 4; ++t) { if (t < ntn) { const unsigned long long w = __hip_atomic_load(slot + t, __ATOMIC_RELAXED, __HIP_MEMORY_SCOPE_AGENT); mt[t] = __uint_as_float((unsigned)w); m2[t] = __uint_as_float((unsigned)(w >> 32)); } else { mt[t] = 0.f; m2[t] = 0.f; } ms += mt[t]; }
            const float mean = ms / (float)ntn; float q = 0.f;
#pragma unroll
            for (int t = 0; t < 4; ++t) if (t < ntn) { const float dm = mt[t] - mean; q += m2[t] + 256.0f * dm * dm; }
            S[row] = (f32x2v){mean, 1.0f / sqrtf(q / (256.0f * (float)ntn) + eps)};
        }
        asm volatile("s_waitcnt lgkmcnt(0)" ::: "memory"); __builtin_amdgcn_s_barrier(); asm volatile("" ::: "memory");
        return bad;
    }
};
struct EpiLnRes {
    static constexpr bool PERM = false, AFTER_DRAIN = true;
    const float* base; float* out; int ldc; const float* bias; PanelStats st; unsigned poison;
    __device__ __forceinline__ void fused(f32x4 (&acc)[2][2][4][2], const Unit& u, int wr, int wc, int fr, int fq, PG8_LAS unsigned char* lds, int wid, int lane) const {
        typedef float f32x2v __attribute__((ext_vector_type(2)));
        const PG8_LAS f32x2v* S = (const PG8_LAS f32x2v*)(lds + 8192);
        const int col0 = u.pn * BM + wc * 32 + 4 * fq;
#pragma unroll
        for (int bj = 0; bj < 2; ++bj)
#pragma unroll
            for (int n = 0; n < 2; ++n) { const f32x4 bv = bias ? *(const f32x4*)(bias + col0 + bj * HALF + n * 16) : (f32x4){0.f, 0.f, 0.f, 0.f};
#pragma unroll
                for (int ai = 0; ai < 2; ++ai)
#pragma unroll
                    for (int m = 0; m < 4; ++m) acc[ai][bj][m][n] += bv; }
        f32x4 pre[4][2][2];
#pragma unroll
        for (int m = 0; m < 4; ++m) { const size_t off = (size_t)(u.pm * BM + wr * 64 + m * 16 + fr) * ldc + col0;
#pragma unroll
            for (int bj = 0; bj < 2; ++bj)
#pragma unroll
                for (int n = 0; n < 2; ++n) pre[m][bj][n] = *(const f32x4*)(base + off + bj * HALF + n * 16); }
        const bool bad = st.run(acc, u, wr, wc, fr, fq, lds, wid, lane) || poison != 0u;
        const float qnan = __builtin_nanf("");
#pragma unroll
        for (int ai = 0; ai < 2; ++ai)
#pragma unroll
            for (int m = 0; m < 4; ++m) { const int r = ai * HALF + wr * 64 + m * 16 + fr; const f32x2v sr = S[r]; const size_t off = (size_t)(u.pm * BM + r) * ldc + col0;
#pragma unroll
                for (int bj = 0; bj < 2; ++bj)
#pragma unroll
                    for (int n = 0; n < 2; ++n) { const f32x4 bs = ai == 0 ? pre[m][bj][n] : *(const f32x4*)(base + off + bj * HALF + n * 16); f32x4 o = bs + (acc[ai][bj][m][n] - sr.x) * sr.y;
                        if (bad) o = (f32x4){qnan, qnan, qnan, qnan}; *(f32x4*)(out + off + bj * HALF + n * 16) = o; }
                if (m & 1) asm volatile("" ::: "memory"); }
    }
};
struct EpiLnResLn {
    static constexpr bool PERM = false, AFTER_DRAIN = true;
    const float* base; float* out; bf16_t* xn; int ldc; const float* bias; PanelStats st1, st2; unsigned poison;
    __device__ __forceinline__ void fused(f32x4 (&acc)[2][2][4][2], const Unit& u, int wr, int wc, int fr, int fq, PG8_LAS unsigned char* lds, int wid, int lane) const {
        typedef float f32x2v __attribute__((ext_vector_type(2))); typedef unsigned u32x2v __attribute__((ext_vector_type(2)));
        const PG8_LAS f32x2v* S = (const PG8_LAS f32x2v*)(lds + 8192);
        const int col0 = u.pn * BM + wc * 32 + 4 * fq;
#pragma unroll
        for (int bj = 0; bj < 2; ++bj)
#pragma unroll
            for (int n = 0; n < 2; ++n) { const f32x4 bv = bias ? *(const f32x4*)(bias + col0 + bj * HALF + n * 16) : (f32x4){0.f, 0.f, 0.f, 0.f};
#pragma unroll
                for (int ai = 0; ai < 2; ++ai)
#pragma unroll
                    for (int m = 0; m < 4; ++m) acc[ai][bj][m][n] += bv; }
        bool bad = st1.run(acc, u, wr, wc, fr, fq, lds, wid, lane) || poison != 0u;
        const float qnan = __builtin_nanf("");
#pragma unroll
        for (int ai = 0; ai < 2; ++ai)
#pragma unroll
            for (int m = 0; m < 4; ++m) { const int r = ai * HALF + wr * 64 + m * 16 + fr; const f32x2v sr = S[r]; const size_t off = (size_t)(u.pm * BM + r) * ldc + col0;
#pragma unroll
                for (int bj = 0; bj < 2; ++bj)
#pragma unroll
                    for (int n = 0; n < 2; ++n) { const f32x4 bs = *(const f32x4*)(base + off + bj * HALF + n * 16); acc[ai][bj][m][n] = bs + (acc[ai][bj][m][n] - sr.x) * sr.y; }
                asm volatile("" : "+v"(acc[ai][0][m][0]), "+v"(acc[ai][0][m][1]), "+v"(acc[ai][1][m][0]), "+v"(acc[ai][1][m][1]));
                if (m & 1) asm volatile("" ::: "memory"); }
        const bool bad1 = bad;
        bad = st2.run(acc, u, wr, wc, fr, fq, lds, wid, lane) || bad;
#pragma unroll
        for (int ai = 0; ai < 2; ++ai)
#pragma unroll
            for (int m = 0; m < 4; ++m) { const int r = ai * HALF + wr * 64 + m * 16 + fr; const f32x2v sr = S[r]; const size_t off = (size_t)(u.pm * BM + r) * ldc + col0;
#pragma unroll
                for (int bj = 0; bj < 2; ++bj)
#pragma unroll
                    for (int n = 0; n < 2; ++n) { const f32x4 x1 = acc[ai][bj][m][n]; *(f32x4*)(out + off + bj * HALF + n * 16) = bad1 ? (f32x4){qnan, qnan, qnan, qnan} : x1;
                        const f32x4 o = (x1 - sr.x) * sr.y; u32x2v w; w.x = cvt_pk_bf16(o[0], o[1]); w.y = cvt_pk_bf16(o[2], o[3]);
                        if (bad) { w.x = 0x7fc07fc0u; w.y = 0x7fc07fc0u; } *(u32x2v*)(xn + off + bj * HALF + n * 16) = w; }
                asm volatile("" ::: "memory"); }
    }
};

template <class Epi, class Sched, bool ALIGN_EPI = false, bool SP2 = false>
__device__ __forceinline__ void gemm_phase(PG8_LAS unsigned char* lds, const Gemm g, const Sched& S, const Epi& E) {
    int tid_ = threadIdx.x; asm volatile("" : "+v"(tid_));
    const int tid = tid_, wid = __builtin_amdgcn_readfirstlane(tid >> 6), lane = tid & 63, wr = wid >> 2, wc = wid & 3, fr = lane & 15, fq = lane >> 4;
    const int K = g.K, ntf = K / BK;
    unsigned voffA[2], voffB[2];
#pragma unroll
    for (int i = 0; i < 2; ++i) { int R, C; stage_rc(tid * 16 + i * 8192, R, C); const int Rb = Epi::PERM ? ((R & ~31) + perm32(R & 31)) : R;
        voffA[i] = (unsigned)(R * K + C) * 2u; voffB[i] = (unsigned)(Rb * K + C) * 2u; }
    const size_t kstep = (size_t)(BK * 2);
    const size_t hstep = (size_t)HALF * K * 2;
    const size_t tstep = 2 * hstep;
    const unsigned ldsw = (unsigned)wid * 1024u;
    const int aoff = lds_byte(wr * 64 + fr, fq * 8), boff = lds_byte(wc * 32 + fr, fq * 8);
#define PG8_SA(b, h) (((b) * 2 + (h)) * HTB)
#define PG8_SB(b, h) ((4 + (b) * 2 + (h)) * HTB)
#define PG8_STAGE(bufoff, gbase, voff) do { _Pragma("unroll") for (int _i = 0; _i < 2; ++_i) \
        __builtin_amdgcn_global_load_lds((const unsigned*)((const char*)(gbase) + (voff)[_i]), (PG8_LAS unsigned*)(lds + (bufoff) + ldsw + _i * 8192), 16, 0, 0); } while (0)
#define PG8_LDA(dst, b, h) do { _Pragma("unroll") for (int m = 0; m < 4; ++m) _Pragma("unroll") for (int k = 0; k < 2; ++k) dst[m][k] = *(const PG8_LAS bf16x8*)(lds + PG8_SA(b, h) + aoff + m * 2048 + k * 1024); } while (0)
#define PG8_LDB(dst, b, h) do { _Pragma("unroll") for (int n = 0; n < 2; ++n) _Pragma("unroll") for (int k = 0; k < 2; ++k) dst[n][k] = *(const PG8_LAS bf16x8*)(lds + PG8_SB(b, h) + boff + n * 2048 + k * 1024); } while (0)
#define PG8_MMA(ai, bj, At, Bt) do { __builtin_amdgcn_s_setprio(1); _Pragma("unroll") for (int m = 0; m < 4; ++m) _Pragma("unroll") for (int n = 0; n < 2; ++n) _Pragma("unroll") for (int k = 0; k < 2; ++k) \
        acc[ai][bj][m][n] = __builtin_amdgcn_mfma_f32_16x16x32_bf16(Bt[n][k], At[m][k], acc[ai][bj][m][n], 0, 0, 0); __builtin_amdgcn_s_setprio(0); } while (0)
#define PG8_WAIT_V(n) asm volatile("s_waitcnt vmcnt(" #n ")" ::: "memory")
#define PG8_WAIT_L(n) asm volatile("s_waitcnt lgkmcnt(" #n ")" ::: "memory")
#define PG8_BAR __builtin_amdgcn_s_barrier()
#define PG8_SCHED __builtin_amdgcn_sched_barrier(0)
    const unsigned long long tg_in = TS_GEMM ? __builtin_amdgcn_s_memrealtime() : 0ull; unsigned long long tg_ep = 0, tg_l0 = 0; (void)tg_in; (void)tg_ep; (void)tg_l0;
    Unit cur, nxt; int ui = 0;
    if (!S.next(0, cur)) return;
    f32x4 acc[2][2][4][2];
#pragma unroll
    for (int a = 0; a < 2; ++a)
#pragma unroll
        for (int b = 0; b < 2; ++b)
#pragma unroll
            for (int m = 0; m < 4; ++m)
#pragma unroll
                for (int n = 0; n < 2; ++n) acc[a][b][m][n] = (f32x4){0.f, 0.f, 0.f, 0.f};
    bf16x8 At[4][2], B0[2][2], B1[2][2];
    const char* cA = (const char*)g.A + (size_t)cur.pm * tstep + (size_t)cur.k0 * 2; const char* cB = (const char*)g.Bt + (size_t)cur.pn * tstep + (size_t)cur.k0 * 2;
    S.a_ready(cur);
    if constexpr (SP2) {
        PG8_STAGE(PG8_SB(0, 0), cB, voffB); PG8_STAGE(PG8_SB(0, 1), cB + hstep, voffB); PG8_STAGE(PG8_SA(0, 0), cA, voffA); PG8_STAGE(PG8_SA(0, 1), cA + hstep, voffA);
        if (wr == 1) PG8_BAR;
        PG8_WAIT_V(2); PG8_BAR;
        PG8_STAGE(PG8_SB(1, 0), cB + kstep, voffB); PG8_STAGE(PG8_SA(1, 0), cA + kstep, voffA); PG8_STAGE(PG8_SB(1, 1), cB + hstep + kstep, voffB);
        PG8_WAIT_V(6); PG8_BAR;
    } else {
        PG8_STAGE(PG8_SB(0, 0), cB, voffB); PG8_STAGE(PG8_SA(0, 0), cA, voffA); PG8_STAGE(PG8_SB(0, 1), cB + hstep, voffB); PG8_STAGE(PG8_SA(0, 1), cA + hstep, voffA);
        if (wr == 1) PG8_BAR;
        PG8_WAIT_V(4); PG8_BAR;
        PG8_STAGE(PG8_SB(1, 0), cB + kstep, voffB); PG8_STAGE(PG8_SA(1, 0), cA + kstep, voffA); PG8_STAGE(PG8_SB(1, 1), cB + hstep + kstep, voffB);
        PG8_WAIT_V(6); PG8_BAR;
    }
    if (TS_GEMM) tg_l0 = __builtin_amdgcn_s_memrealtime();
    for (;;) {
        const bool has_next = S.next(ui + 1, nxt);
        const char* nA = has_next ? (const char*)g.A + (size_t)nxt.pm * tstep + (size_t)nxt.k0 * 2 : cA; const char* nB = has_next ? (const char*)g.Bt + (size_t)nxt.pn * tstep + (size_t)nxt.k0 * 2 : cB;
        const int nt = cur.nt ? cur.nt : ntf;
        for (int t = 0; t < nt; t += 2) {
            const bool last = (t == nt - 2);
            const char* a1 = cA + (size_t)(t + 1) * kstep;
            const char* a2 = last ? nA : cA + (size_t)(t + 2) * kstep; const char* b2 = last ? nB : cB + (size_t)(t + 2) * kstep;
            const char* a3 = a2 + kstep; const char* b3 = b2 + kstep;
            if (last && has_next) S.a_ready(nxt);
            if constexpr (SP2) {
            PG8_LDB(B0, 0, 0); PG8_LDB(B1, 0, 1); PG8_SCHED; PG8_LDA(At, 0, 0); PG8_STAGE(PG8_SA(1, 1), a1 + hstep, voffA);
            PG8_WAIT_V(8); PG8_WAIT_L(0); PG8_BAR; PG8_MMA(0, 0, At, B0); PG8_MMA(0, 1, At, B1); PG8_BAR; PG8_SCHED;
            PG8_LDA(At, 0, 1); PG8_STAGE(PG8_SB(0, 0), b2, voffB); PG8_STAGE(PG8_SB(0, 1), b2 + hstep, voffB); PG8_STAGE(PG8_SA(0, 0), a2, voffA);
            PG8_WAIT_V(8); PG8_WAIT_L(0); PG8_BAR; PG8_MMA(1, 0, At, B0); PG8_MMA(1, 1, At, B1); PG8_BAR; PG8_SCHED;
            PG8_LDB(B0, 1, 0); PG8_LDB(B1, 1, 1); PG8_SCHED; PG8_LDA(At, 1, 0); PG8_STAGE(PG8_SA(0, 1), a2 + hstep, voffA);
            PG8_WAIT_V(8); PG8_WAIT_L(0); PG8_BAR; PG8_MMA(0, 0, At, B0); PG8_MMA(0, 1, At, B1); PG8_BAR; PG8_SCHED;
            PG8_LDA(At, 1, 1); PG8_STAGE(PG8_SB(1, 0), b3, voffB); PG8_STAGE(PG8_SB(1, 1), b3 + hstep, voffB); PG8_STAGE(PG8_SA(1, 0), a3, voffA);
            PG8_WAIT_V(8); PG8_WAIT_L(0); PG8_BAR; PG8_MMA(1, 0, At, B0); PG8_MMA(1, 1, At, B1); PG8_BAR; PG8_SCHED;
            } else {
            PG8_LDB(B0, 0, 0); PG8_SCHED; PG8_LDA(At, 0, 0); PG8_STAGE(PG8_SA(1, 1), a1 + hstep, voffA);
            PG8_WAIT_L(8); PG8_BAR; PG8_WAIT_L(0); PG8_MMA(0, 0, At, B0); PG8_BAR; PG8_SCHED;
            PG8_LDB(B1, 0, 1); PG8_STAGE(PG8_SB(0, 0), b2, voffB);
            PG8_BAR; PG8_WAIT_L(0); PG8_MMA(0, 1, At, B1); PG8_BAR;
            PG8_LDA(At, 0, 1); PG8_STAGE(PG8_SA(0, 0), a2, voffA);
            PG8_BAR; PG8_WAIT_L(0); PG8_MMA(1, 0, At, B0); PG8_BAR; PG8_SCHED;
            PG8_STAGE(PG8_SB(0, 1), b2 + hstep, voffB);
            PG8_WAIT_V(6); PG8_BAR; PG8_MMA(1, 1, At, B1); PG8_BAR;
            PG8_LDB(B0, 1, 0); PG8_SCHED; PG8_LDA(At, 1, 0); PG8_STAGE(PG8_SA(0, 1), a2 + hstep, voffA);
            PG8_WAIT_L(8); PG8_BAR; PG8_WAIT_L(0); PG8_MMA(0, 0, At, B0); PG8_BAR; PG8_SCHED;
            PG8_LDB(B1, 1, 1); PG8_STAGE(PG8_SB(1, 0), b3, voffB);
            PG8_BAR; PG8_WAIT_L(0); PG8_MMA(0, 1, At, B1); PG8_BAR;
            PG8_LDA(At, 1, 1); PG8_STAGE(PG8_SA(1, 0), a3, voffA);
            PG8_BAR; PG8_WAIT_L(0); PG8_MMA(1, 0, At, B0); PG8_BAR; PG8_SCHED;
            PG8_STAGE(PG8_SB(1, 1), b3 + hstep, voffB);
            PG8_WAIT_V(6); PG8_BAR; PG8_MMA(1, 1, At, B1); PG8_BAR;
            }
        }
        if constexpr (ALIGN_EPI) { if (wr == 0) PG8_BAR; }
        { const unsigned long long te0 = TS_GEMM ? __builtin_amdgcn_s_memrealtime() : 0ull;
        if constexpr (!Epi::AFTER_DRAIN) { E(acc, cur, wr, wc, fr, fq); S.done(cur); }
        if (TS_GEMM) tg_ep += __builtin_amdgcn_s_memrealtime() - te0; }
        if (!has_next) break;
#pragma unroll
        for (int a = 0; a < 2; ++a)
#pragma unroll
            for (int b = 0; b < 2; ++b)
#pragma unroll
                for (int m = 0; m < 4; ++m)
#pragma unroll
                    for (int n = 0; n < 2; ++n) acc[a][b][m][n] = (f32x4){0.f, 0.f, 0.f, 0.f};
        cur = nxt; cA = nA; cB = nB; ++ui;
        if constexpr (ALIGN_EPI) { if (wr == 1) PG8_BAR; }
    }
    PG8_WAIT_V(0);
    if constexpr (!ALIGN_EPI) { if (wr == 0) PG8_BAR; }
    PG8_BAR;
    if constexpr (Epi::AFTER_DRAIN) { E.fused(acc, cur, wr, wc, fr, fq, lds, wid, lane); S.done(cur); }
    if (TS_GEMM && blockIdx.x == TS_BLOCK && threadIdx.x == 0) { volatile PG8_LAS unsigned long long* ts = (volatile PG8_LAS unsigned long long*)(lds + 139264 + 8192 + 256); const unsigned long long te = __builtin_amdgcn_s_memrealtime(); const unsigned long long cid = ts[31]; ts[31] = cid + 1; if (TS_PHASE != 113 || (int)cid == TS_GEMM_ID) { ts[28] += tg_l0 - tg_in; ts[29] += tg_ep; ts[30] += te - tg_in; } }
#undef PG8_SA
#undef PG8_SB
#undef PG8_STAGE
#undef PG8_LDA
#undef PG8_LDB
#undef PG8_MMA
#undef PG8_WAIT_V
#undef PG8_WAIT_L
#undef PG8_BAR
#undef PG8_SCHED
}
}

#ifndef PG8_SP2
#define PG8_SP2 true
#endif
#ifndef PG8_ALIGN
#define PG8_ALIGN true
#endif

#include <hip/hip_cooperative_groups.h>
namespace mk {
using pg8::bf16_t; using pg8::bf16x8; using pg8::f32x4; using pg8::u32x4; using pg8::f32x2; using pg8::Unit; using pg8::Gemm; using pg8::cvt_pk_bf16; using pg8::gelu_pk;
typedef float f32x16 __attribute__((ext_vector_type(16)));
typedef short s16x4 __attribute__((ext_vector_type(4)));
typedef short v4i16_t __attribute__((ext_vector_type(4)));
typedef __bf16 bf16x2_t __attribute__((ext_vector_type(2)));
typedef __attribute__((address_space(3))) const unsigned char* lds_cptr;
typedef __attribute__((address_space(3))) unsigned char* lds_ptr;

constexpr int DM = 1024, SEQ = 4096, CTXL = 256, NB = 8, MLAT = NB * SEQ, MCTX = NB * CTXL, MALL = MLAT + MCTX, FFH = 2816, NKT = 68;
constexpr float EPS = 1e-6f, LOG2E = 1.4426950408889634f;
constexpr int NWAVES = 8, NTHR = 512;
constexpr int NSL = 8;
constexpr size_t MiB = 1u << 20;
constexpr size_t WS_CTL = 0, CTL_ZERO_BYTES = 1 * MiB;
constexpr size_t WS_W_EV = 1 * MiB, WS_W_OD = 6 * MiB, WS_W_MIX = 10 * MiB  , WS_W_FI = 14 * MiB  , WS_W_FO = 36 * MiB  ;
constexpr size_t WS_W_UQ = 48 * MiB, WS_W_UKV = 48 * MiB + 256 * 1024, WS_W_S = 48 * MiB + 640 * 1024;
constexpr size_t WS_MODP = 49 * MiB;
constexpr size_t WS_MOD = WS_MODP + 7 * MiB - 256 * 1024;
constexpr size_t WS_VSS = 56 * MiB + 512 * 1024, WS_CQS = WS_VSS + 1152 * 1024, WS_CKS = WS_CQS + 1152 * 1024;
constexpr size_t WS_XR = 60 * MiB;
constexpr size_t WS_HN = 196 * MiB;
constexpr size_t WS_MIX = 264 * MiB;
constexpr size_t WS_S = 332 * MiB;
constexpr size_t WS_Q = WS_S, WS_KA = 400 * MiB, WS_VA = WS_KA + 8704 * 1024, WS_KB = 417 * MiB, WS_VB = 451 * MiB;
constexpr size_t WS_UACT = WS_S, WS_VACT = 364 * MiB, WS_CQ = 396 * MiB, WS_CKV = 412 * MiB, WS_KD = 429 * MiB, WS_VD = 463 * MiB;
constexpr size_t WS_OB = WS_HN, WS_Q2 = WS_HN;
constexpr size_t WS_PART = 451 * MiB;
constexpr size_t WS_ACT = WS_MIX;
constexpr size_t WS_SNAP = 498 * MiB, WS_END = 512 * MiB;
static_assert(WS_CQ + (size_t)MLAT * 256 * 2 == WS_CKV && WS_W_UQ + 512 * 256 * 2 == WS_W_UKV, "the combined MLA up-projection GEMM needs CQ | CKV and W_UQ | W_UKV contiguous");
static_assert(WS_MOD + 2 * 9 * 6144 * 4 <= WS_VSS && WS_CKS + 1152 * 1024 <= WS_XR, "ws map");
static_assert(WS_VA + 8704 * 1024 <= WS_KB && WS_VB + 34 * MiB <= WS_SNAP && WS_VD + 34 * MiB <= WS_SNAP && WS_ACT + (size_t)MALL * FFH * 2 <= WS_SNAP, "ws map 2");
constexpr int CW_BAR = 4096;
constexpr int RING_BYTES = 139264  , ROPE_OFF = RING_BYTES, MISC_OFF = ROPE_OFF + 8192, PTR_OFF = MISC_OFF + 512  , LDS_BYTES = RING_BYTES + 16384;

#ifndef TS_PHASE
#define TS_PHASE -1
#endif
#ifndef TS_BLOCK
#define TS_BLOCK 0
#endif
#define TS_ATT (TS_PHASE >= 105 && TS_PHASE <= 108)
#ifndef TS_SUB
#define TS_SUB 0
#endif
#ifndef TS_SCALE
#define TS_SCALE 1.0f
#endif
#ifndef AT_ABL
#define AT_ABL 0
#endif
#ifndef TS_CLK
#define TS_CLK 0
#endif
#ifndef TS_SEAM_LO
#define TS_SEAM_LO 1
#endif
#ifndef TS_SEAM_HI
#define TS_SEAM_HI 9
#endif
#ifndef TS_SEAM_SKIP
#define TS_SEAM_SKIP -1
#endif
#ifndef AT_KSO_B
#define AT_KSO_B 1
#endif
#ifndef AT_KSO_A
#define AT_KSO_A 0
#endif
#ifndef AT_KSO_MLA
#define AT_KSO_MLA 0
#endif
#ifndef AT_DMA_LATE
#define AT_DMA_LATE 0
#endif
#ifndef AT_KSO_A
#define AT_KSO_A 0
#endif
#ifndef GS_AT_START
#define GS_AT_START 1
#endif
#ifndef TS_BASE
#define TS_BASE 2250
#endif
#define GAS __attribute__((address_space(1)))
#define LAS __attribute__((address_space(3)))
typedef GAS unsigned gu32;
#define RLX_AGENT __ATOMIC_RELAXED, __HIP_MEMORY_SCOPE_AGENT

#define XB_TMO      128
#define XB_XCNT(j)  (256  + 64 * (j))
#define XB_XSUB(j)  (1280 + 64 * (j))
#define XB_XGEN(j)  (2304 + 64 * (j))
#define XB_TOP      3328
#define XB_TOPGEN   3392
#define XCD_BAR_WORDS 3456
#define XB_SPIN_CAP (1u << 18)
__device__ __forceinline__ unsigned xb_ld(unsigned* p)              { return __hip_atomic_load(p, __ATOMIC_RELAXED, __HIP_MEMORY_SCOPE_AGENT); }
__device__ __forceinline__ unsigned xb_add(unsigned* p, unsigned v) { return __hip_atomic_fetch_add(p, v, __ATOMIC_RELAXED, __HIP_MEMORY_SCOPE_AGENT); }
__device__ __forceinline__ unsigned xb_xcc_id() { return (unsigned)__builtin_amdgcn_s_getreg((3 << 11) | 20) & 0xFu; }
#define XB_SPIN(cond, bar) do { unsigned _sp = 0; while (cond) { __builtin_amdgcn_s_sleep(1); \
    if ((++_sp & 255u) == 0u) { if (xb_ld(&(bar)[XB_TMO])) break; if (_sp > XB_SPIN_CAP) { atomicAdd(&(bar)[XB_TMO], 1u); break; } } } } while (0)
struct XcdBarrier { unsigned* bar; unsigned x; volatile LAS unsigned* st; };
__device__ __forceinline__ XcdBarrier xcd_barrier_post(unsigned* bar, volatile LAS unsigned* st) {
    XcdBarrier b; b.bar = bar; b.x = xb_xcc_id(); b.st = st;
    if (threadIdx.x == 0) (void)xb_add(&bar[XB_XCNT(b.x)], 1u);
    return b;
}
__device__ __forceinline__ void xcd_barrier_complete(unsigned* bar, unsigned x, unsigned& nloc, unsigned& nx) {
    const unsigned G = gridDim.x * gridDim.y * gridDim.z;
    unsigned sum, cnt, mine, sp = 0u;
    for (;;) {
        sum = 0u; cnt = 0u; mine = 0u;
#pragma unroll
        for (unsigned j = 0; j < 16; ++j) { const unsigned c = xb_ld(&bar[XB_XCNT(j)]); sum += c; cnt += (c > 0u) ? 1u : 0u; mine = (j == x) ? c : mine; }
        if (sum == G) break;
        __builtin_amdgcn_s_sleep(1);
        if ((++sp & 255u) == 0u) { if (xb_ld(&bar[XB_TMO])) break; if (sp > XB_SPIN_CAP) { atomicAdd(&bar[XB_TMO], 1u); break; } }
    }
    nloc = mine > 0u ? mine : 1u; nx = cnt > 0u ? cnt : 1u;
}
__device__ __forceinline__ void xcd_barrier(const XcdBarrier& b) {
    asm volatile("s_waitcnt vmcnt(0)" ::: "memory");
    __syncthreads();
    if (threadIdx.x == 0) {
        unsigned* bar = b.bar;
        __builtin_amdgcn_s_waitcnt(0);
        unsigned nloc = b.st[0], nx = b.st[1];
        if (nloc == 0u) { xcd_barrier_complete(bar, b.x, nloc, nx); b.st[0] = nloc; b.st[1] = nx; }
        const unsigned old = xb_add(&bar[XB_XSUB(b.x)], 1u);
        const unsigned gen = old / nloc;
        if (old + 1u == (gen + 1u) * nloc) {
            __builtin_amdgcn_fence(__ATOMIC_RELEASE, "agent");
            asm volatile("s_waitcnt vmcnt(0)" ::: "memory");
            const unsigned og = xb_add(&bar[XB_TOP], 1u);
            const unsigned tg = og / nx;
            if (og + 1u == (tg + 1u) * nx) xb_add(&bar[XB_TOPGEN], 1u);
            else XB_SPIN(xb_ld(&bar[XB_TOPGEN]) == tg, bar);
            __builtin_amdgcn_fence(__ATOMIC_ACQUIRE, "agent");
            xb_add(&bar[XB_XGEN(b.x)], 1u);
            asm volatile("s_waitcnt vmcnt(0)" ::: "memory");
        } else {
            XB_SPIN(xb_ld(&bar[XB_XGEN(b.x)]) == gen, bar);
            __builtin_amdgcn_fence(__ATOMIC_ACQUIRE, "agent");
            asm volatile("s_waitcnt vmcnt(0)" ::: "memory");
        }
    }
    __syncthreads();
}

__device__ __forceinline__ unsigned f2bf(float f) { unsigned u = __builtin_bit_cast(unsigned, f); return (u + 0x7fffu + ((u >> 16) & 1u)) >> 16; }
__device__ __forceinline__ unsigned pk2(float lo, float hi) { f32x2 v = {lo, hi}; bf16x2_t b = __builtin_convertvector(v, bf16x2_t); return __builtin_bit_cast(unsigned, b); }
__device__ __forceinline__ float bf2f(unsigned short h) { return __builtin_bit_cast(float, (unsigned)h << 16); }
template <int M> __device__ __forceinline__ float shx(float v) {
    if (M == 32) { auto rr = __builtin_amdgcn_permlane32_swap(__float_as_uint(v), __float_as_uint(v), false, false); const bool up = (threadIdx.x & 32) != 0; return __uint_as_float(up ? rr[0] : rr[1]); }
    else return __uint_as_float((unsigned)__builtin_amdgcn_ds_swizzle((int)__float_as_uint(v), 0x1F | (M << 10)));
}
__device__ __forceinline__ float wave_sum(float v) { v += shx<1>(v); v += shx<2>(v); v += shx<4>(v); v += shx<8>(v); v += shx<16>(v); v += shx<32>(v); return v; }
__device__ __forceinline__ float wave_max(float v) { v = fmaxf(v, shx<1>(v)); v = fmaxf(v, shx<2>(v)); v = fmaxf(v, shx<4>(v)); v = fmaxf(v, shx<8>(v)); v = fmaxf(v, shx<16>(v)); v = fmaxf(v, shx<32>(v)); return v; }
__device__ __forceinline__ int ltid() { int t = threadIdx.x; asm volatile("" : "+v"(t)); return t; }
__device__ __forceinline__ int obx() { int b = blockIdx.x; asm volatile("" : "+s"(b)); return b; }
__device__ __forceinline__ int crow(int r, int hi) { return (r & 3) + 8 * (r >> 2) + 4 * hi; }
__device__ __forceinline__ s16x4 vtr(lds_cptr p) { return __builtin_bit_cast(s16x4, __builtin_amdgcn_ds_read_tr16_b64_v4i16((LAS v4i16_t*)p)); }
__device__ __forceinline__ float fast_rcp(float x) { return __builtin_amdgcn_rcpf(x); }
__device__ __forceinline__ float silu_f(float g) { return g * fast_rcp(1.f + __builtin_amdgcn_exp2f(-g * LOG2E)); }
__device__ __forceinline__ float gain_absmax64(const float* g) { return wave_max(fabsf(g[threadIdx.x & 63])); }

struct Frame { lds_ptr lds; unsigned char* ws; float* out; int wave, vcu, G; };
__device__ __forceinline__ const float* inp(const Frame& F, int i) {
    const unsigned long long v = ((const LAS unsigned long long*)(F.lds + PTR_OFF))[i];
    const unsigned lo = __builtin_amdgcn_readfirstlane((unsigned)v), hi = __builtin_amdgcn_readfirstlane((unsigned)(v >> 32));
    return (const float*)(const GAS float*)(((unsigned long long)hi << 32) | lo);
}
__device__ __forceinline__ Frame mkframe() {
    Frame F; asm volatile("" ::: "memory");
    extern __shared__ __attribute__((aligned(16))) unsigned char lds_raw[];
    F.lds = (lds_ptr)lds_raw;
    F.ws = (unsigned char*)inp(F, 34); F.out = (float*)inp(F, 35);
    F.wave = __builtin_amdgcn_readfirstlane(ltid() >> 6);
    F.G = gridDim.x; { const int bx = blockIdx.x; F.vcu = (F.G % 8 == 0) ? (bx % 8) * (F.G / 8) + bx / 8 : bx; }
    return F;
}
enum { I_X = 0, I_C, I_CTX, I_CCTX, I_N1G, I_N2G, I_ADAW, I_ADAB, I_MIXW, I_FIW, I_FOW, I_EVW, I_QNA, I_KNA, I_SINK, I_QNB, I_KNB, I_LQ1, I_LK1, I_LQ2, I_LK2, I_SUBLN,
       I_ODW, I_CVN, I_CWS, I_CBS, I_QAN, I_KVAN, I_WUQ, I_WUKV, I_QNN, I_KNN, I_QNR, I_KNR };

__device__ __forceinline__ int map_head(int R) { const int pn = R >> 8, bj = (R >> 7) & 1, wc = (R >> 5) & 3, rho = R & 31; return 256 * pn + 64 * wc + 32 * bj + rho; }
__device__ __forceinline__ int map_od(int R) { if (R < 1536) return R; const int q = R - 1536, bj = (q >> 7) & 1, wc = (q >> 5) & 3, rho = q & 31; return wc == 0 ? 1536 + 32 * bj + rho : -1; }
__device__ __forceinline__ int map_fi(int R) { const int pn = R >> 8, bj = (R >> 7) & 1, q = R & 127; return bj * FFH + 128 * pn + q; }
__device__ __forceinline__ int map_ukv(int R) { const int pn = R >> 8, bj = (R >> 7) & 1, wc = (R >> 5) & 3, rho = R & 31;
    if (pn == 0) return 192 * wc + 32 * bj + rho; const int u = 4 * (pn - 1) + wc; return 192 * (u >> 1) + 64 + 64 * (u & 1) + 32 * bj + rho; }

__device__ __forceinline__ void transpose_item(const float* W, int K, int ldn, bf16_t* WT, int n0, int cs, int k0, const float* kscale, LAS float* scr, int lane) {
    float tv[32];
#pragma unroll
    for (int i = 0; i < 32; ++i) { const int kk = 2 * i + (lane >> 5); tv[i] = cs >= 0 ? W[(size_t)(k0 + kk) * ldn + cs + (lane & 31)] : 0.f; }
#pragma unroll
    for (int i = 0; i < 32; ++i) { const int kk = 2 * i + (lane >> 5); float v = tv[i]; if (kscale) v *= kscale[k0 + kk]; scr[kk * 33 + (lane & 31)] = v; }
    asm volatile("s_waitcnt lgkmcnt(0)" ::: "memory");
    const int c = lane & 7;
#pragma unroll
    for (int j = 0; j < 4; ++j) { const int n = (lane >> 3) + 8 * j; const LAS float* s = scr + (8 * c) * 33 + n;
        u32x4 o; o.x = pk2(s[0 * 33], s[1 * 33]); o.y = pk2(s[2 * 33], s[3 * 33]); o.z = pk2(s[4 * 33], s[5 * 33]); o.w = pk2(s[6 * 33], s[7 * 33]);
        *(u32x4*)(WT + (size_t)(n0 + n) * K + k0 + 8 * c) = o; }
    asm volatile("s_waitcnt lgkmcnt(0)" ::: "memory");
}

__device__ __forceinline__ void p0_prologue(Frame& F) {
    LAS float* scr = (LAS float*)(F.lds + F.wave * 16384);
    const int lane = ltid() & 63;
    const int gw = F.vcu * NWAVES + F.wave, NGW = F.G * NWAVES;
    constexpr int N_ADA = 2 * 16 * 24;
    constexpr int I_EV = 16 * 72, I_ODD = 16 * 56, I_MIX1 = 16 * 32, I_FI1 = 16 * 176, I_FO1 = 44 * 32, I_UQ = 4 * 16, I_UKV = 4 * 24;
    constexpr int N_TR = I_EV + I_ODD + 2 * I_MIX1 + 2 * I_FI1 + 2 * I_FO1 + I_UQ + I_UKV;
    constexpr int N_WS = 16;
    static_assert(N_ADA == 256 * 3, "three adaLN items per workgroup");
    if (ltid() == 0) *((volatile LAS unsigned*)(F.lds + MISC_OFF) + 16) = 0u;
    __syncthreads();
    (void)gw; (void)NGW;
    if (F.wave < 3) { const int it = F.vcu * 3 + F.wave;
        {
            const int i = it / (16 * 24), ks = (it / 24) % 16, cc = it % 24;
            for (int idx = lane; idx < 9 * 64; idx += 64) { const int r = idx >> 6, k = idx & 63; const float v = r < 8 ? inp(F, I_C)[r * DM + ks * 64 + k] : inp(F, I_CCTX)[ks * 64 + k]; scr[idx] = v / (1.f + expf(-v)); }
            asm volatile("s_waitcnt lgkmcnt(0)" ::: "memory");
            f32x4 acc[9];
#pragma unroll
            for (int r = 0; r < 9; ++r) acc[r] = (f32x4){0.f, 0.f, 0.f, 0.f};
            const float* w = inp(F, I_ADAW) + ((size_t)i * DM + ks * 64) * 6144 + cc * 256 + lane * 4;
#pragma unroll 8
            for (int k = 0; k < 64; ++k) { const f32x4 wv = *(const f32x4*)(w + (size_t)k * 6144);
#pragma unroll
                for (int r = 0; r < 9; ++r) acc[r] += wv * scr[r * 64 + k]; }
            float* mp = (float*)(F.ws + WS_MODP) + ((size_t)(i * 16 + ks) * 9) * 6144 + cc * 256 + lane * 4;
#pragma unroll
            for (int r = 0; r < 9; ++r) *(f32x4*)(mp + (size_t)r * 6144) = acc[r];
            asm volatile("s_waitcnt lgkmcnt(0)" ::: "memory");
        }
    }
    volatile LAS unsigned* ticket = (volatile LAS unsigned*)(F.lds + MISC_OFF) + 16;
    for (;;) {
        unsigned jj = 0; if (lane == 0) jj = __hip_atomic_fetch_add((LAS unsigned*)ticket, 1u, __ATOMIC_RELAXED, __HIP_MEMORY_SCOPE_WORKGROUP);
        jj = __builtin_amdgcn_readfirstlane(jj);
        const int it = F.vcu + F.G * (int)jj; if (it >= N_TR + N_WS) break;
        int r = it;
        if (r < I_EV) { const int kb = r / 72, nb = r % 72; transpose_item(inp(F, I_EVW), DM, 2304, (bf16_t*)(F.ws + WS_W_EV), 32 * nb, map_head(32 * nb), 64 * kb, nullptr, scr, lane); continue; } r -= I_EV;
        if (r < I_ODD) { const int kb = r / 56, nb = r % 56; transpose_item(inp(F, I_ODW), DM, 1600, (bf16_t*)(F.ws + WS_W_OD), 32 * nb, map_od(32 * nb), 64 * kb, nullptr, scr, lane); continue; } r -= I_ODD;
        if (r < 2 * I_MIX1) { const int l = r / I_MIX1, q = r % I_MIX1, kb = q / 32, nb = q % 32; transpose_item(inp(F, I_MIXW) + (size_t)l * DM * DM, DM, DM, (bf16_t*)(F.ws + WS_W_MIX + l * 2 * MiB), 32 * nb, 32 * nb, 64 * kb, nullptr, scr, lane); continue; } r -= 2 * I_MIX1;
        if (r < 2 * I_FI1) { const int l = r / I_FI1, q = r % I_FI1, kb = q / 176, nb = q % 176; transpose_item(inp(F, I_FIW) + (size_t)l * DM * 2 * FFH, DM, 2 * FFH, (bf16_t*)(F.ws + WS_W_FI + l * 11 * MiB), 32 * nb, map_fi(32 * nb), 64 * kb, nullptr, scr, lane); continue; } r -= 2 * I_FI1;
        if (r < 2 * I_FO1) { const int l = r / I_FO1, q = r % I_FO1, kb = q / 32, nb = q % 32; transpose_item(inp(F, I_FOW) + (size_t)l * FFH * DM, FFH, DM, (bf16_t*)(F.ws + WS_W_FO + l * 6 * MiB), 32 * nb, 32 * nb, 64 * kb, nullptr, scr, lane); continue; } r -= 2 * I_FO1;
        if (r < I_UQ) { const int kb = r / 16, nb = r % 16; transpose_item(inp(F, I_WUQ), 256, 512, (bf16_t*)(F.ws + WS_W_UQ), 32 * nb, map_head(32 * nb), 64 * kb, inp(F, I_QAN), scr, lane); continue; } r -= I_UQ;
        if (r < I_UKV) { const int kb = r / 24, nb = r % 24; transpose_item(inp(F, I_WUKV), 256, 768, (bf16_t*)(F.ws + WS_W_UKV), 32 * nb, map_ukv(32 * nb), 64 * kb, inp(F, I_KVAN), scr, lane); continue; } r -= I_UKV;
        { bf16_t* d = (bf16_t*)(F.ws + WS_W_S); const float* s = inp(F, I_CWS);
#pragma unroll 4
          for (int j = 0; j < 64; ++j) { const int e = r * 4096 + j * 64 + lane; d[e] = (bf16_t)f2bf(s[e]); } }
    }
}

__device__ __forceinline__ void load_mod16(Frame& F, int lane, int layer, int mr, int chunk, bool from_partials, f32x4 (&dst)[4]) {
    if (from_partials) {
        const float* mp = (const float*)(F.ws + WS_MODP) + ((size_t)(layer * 16) * 9 + mr) * 6144 + chunk * DM + lane * 4;
        const float* bias = inp(F, I_ADAB) + layer * 6144 + chunk * DM + lane * 4;
#pragma unroll
        for (int j = 0; j < 4; ++j) { f32x4 a = *(const f32x4*)(bias + 256 * j);
            for (int ks = 0; ks < 16; ++ks) a += *(const f32x4*)(mp + (size_t)ks * 9 * 6144 + 256 * j);
            dst[j] = a; }
    } else {
        const float* m = (const float*)(F.ws + WS_MOD) + ((size_t)layer * 9 + mr) * 6144 + chunk * DM + lane * 4;
#pragma unroll
        for (int j = 0; j < 4; ++j) dst[j] = *(const f32x4*)(m + 256 * j);
    }
}
template <bool SRC_BF16>
__device__ __forceinline__ void ln_phase(Frame& F, int layer, int chunk, const float* gain, const void* src_lat, const void* src_ctx, int mrows, bool from_partials, bf16_t* ctx_out = nullptr, const float* parts = nullptr) {
    const int lane = ltid() & 63;
    const int gw = F.vcu * NWAVES + F.wave;
    bf16_t* HN = (bf16_t*)(F.ws + WS_HN);
    f32x4 gv[4], sh[4], sc[4];
#pragma unroll
    for (int j = 0; j < 4; ++j) gv[j] = *(const f32x4*)(gain + lane * 4 + 256 * j);
#define LN_LOAD(V, SS, XB, RO) do { SS = 0.f; _Pragma("unroll") for (int j = 0; j < 4; ++j) { \
            if (SRC_BF16) { const unsigned long long w_ = *(const unsigned long long*)((XB) + ((RO) + 256 * j) * 2); const unsigned lo_ = (unsigned)w_, hi_ = (unsigned)(w_ >> 32); \
                V[j] = (f32x4){__builtin_bit_cast(float, lo_ << 16), __builtin_bit_cast(float, lo_ & 0xffff0000u), __builtin_bit_cast(float, hi_ << 16), __builtin_bit_cast(float, hi_ & 0xffff0000u)}; } \
            else V[j] = *(const f32x4*)((XB) + ((RO) + 256 * j) * 4); \
            SS += (V[j].x * V[j].x + V[j].y * V[j].y) + (V[j].z * V[j].z + V[j].w * V[j].w); } } while (0)
#define LN_STORE(V, RS, M) do { unsigned long long* o8_ = (unsigned long long*)(HN + (size_t)(M) * DM) + lane; _Pragma("unroll") for (int j = 0; j < 4; ++j) { const f32x4 y_ = V[j] * (RS) * gv[j] * (sc[j] + 1.0f) + sh[j]; \
            o8_[64 * j] = (unsigned long long)pk2(y_.x, y_.y) | ((unsigned long long)pk2(y_.z, y_.w) << 32); } } while (0)
    { const int m0 = gw * 16; if (m0 < mrows) { const int mr = m0 >> 12; load_mod16(F, lane, layer, mr, chunk, from_partials, sh); load_mod16(F, lane, layer, mr, chunk + 1, from_partials, sc);
        const unsigned char* xb = (const unsigned char*)src_lat;
#pragma unroll 1
        for (int q = 0; q < 4; ++q) { f32x4 va[4], vb[4], vc[4], vd[4]; float sa, sb, sc2, sd; const size_t ro = (size_t)(m0 + 4 * q) * DM + lane * 4;
            LN_LOAD(va, sa, xb, ro); LN_LOAD(vb, sb, xb, ro + DM); LN_LOAD(vc, sc2, xb, ro + 2 * DM); LN_LOAD(vd, sd, xb, ro + 3 * DM);
            sa = wave_sum(sa); sb = wave_sum(sb); sc2 = wave_sum(sc2); sd = wave_sum(sd);
            const float ra = 1.0f / sqrtf(sa * (1.f / DM) + EPS), rb = 1.0f / sqrtf(sb * (1.f / DM) + EPS), rc = 1.0f / sqrtf(sc2 * (1.f / DM) + EPS), rd = 1.0f / sqrtf(sd * (1.f / DM) + EPS);
            LN_STORE(va, ra, m0 + 4 * q); LN_STORE(vb, rb, m0 + 4 * q + 1); LN_STORE(vc, rc, m0 + 4 * q + 2); LN_STORE(vd, rd, m0 + 4 * q + 3); } } }
    { const int m = MLAT + gw; if (m < mrows) { load_mod16(F, lane, layer, 8, chunk, from_partials, sh); load_mod16(F, lane, layer, 8, chunk + 1, from_partials, sc);
        const size_t ro = (size_t)(m - MLAT) * DM + lane * 4; f32x4 v[4]; float ss; LN_LOAD(v, ss, (const unsigned char*)src_ctx, ro);
        if (ctx_out) {
            if (parts) { ss = 0.f;
#pragma unroll
                for (int j = 0; j < 4; ++j) {
#pragma unroll
                    for (int sl = 0; sl < NSL; ++sl) { const unsigned long long w_ = *(const unsigned long long*)((const bf16_t*)parts + ((size_t)sl * MCTX + (m - MLAT)) * DM + lane * 4 + 256 * j); const unsigned lo_ = (unsigned)w_, hi_ = (unsigned)(w_ >> 32);
                        v[j] += (f32x4){__builtin_bit_cast(float, lo_ << 16), __builtin_bit_cast(float, lo_ & 0xffff0000u), __builtin_bit_cast(float, hi_ << 16), __builtin_bit_cast(float, hi_ & 0xffff0000u)}; }
                    ss += (v[j].x * v[j].x + v[j].y * v[j].y) + (v[j].z * v[j].z + v[j].w * v[j].w); } }
            unsigned long long* x8 = (unsigned long long*)(ctx_out + (size_t)(m - MLAT) * DM) + lane;
#pragma unroll
            for (int j = 0; j < 4; ++j) x8[64 * j] = (unsigned long long)pk2(v[j].x, v[j].y) | ((unsigned long long)pk2(v[j].z, v[j].w) << 32); }
        const float rs = 1.0f / sqrtf(wave_sum(ss) * (1.f / DM) + EPS);
        LN_STORE(v, rs, m); } }
#undef LN_LOAD
#undef LN_STORE
}
__device__ __forceinline__ void mod_reduce(Frame& F) {
    const int gt = F.vcu * NTHR + ltid();
    if (gt < 2 * 9 * 6144) { const int i = gt / (9 * 6144), rem = gt % (9 * 6144), r = rem / 6144, n = rem % 6144;
        float a = inp(F, I_ADAB)[i * 6144 + n]; const float* mp = (const float*)(F.ws + WS_MODP) + ((size_t)(i * 16) * 9 + r) * 6144 + n;
        for (int ks = 0; ks < 16; ++ks) a += mp[(size_t)ks * 9 * 6144];
        ((float*)(F.ws + WS_MOD))[gt] = a; }
}

__device__ __forceinline__ u32x4 pack8(const f32x4 a, const f32x4 b) { u32x4 w; w.x = pk2(a[0], a[1]); w.y = pk2(a[2], a[3]); w.z = pk2(b[0], b[1]); w.w = pk2(b[2], b[3]); return w; }
struct RowGrp { int b, ktile, is_ctx; };
__device__ __forceinline__ RowGrp rowgrp(int rb) { RowGrp g; if (rb < MLAT) { g.b = rb >> 12; g.ktile = (rb & 4095) >> 6; g.is_ctx = 0; } else { const int rc = rb - MLAT; g.b = rc >> 8; g.ktile = 64 + ((rc & 255) >> 6); g.is_ctx = 1; } return g; }
__device__ __forceinline__ void rope8(f32x4 (&v0)[2], f32x4 (&v1)[2], const LAS f32x2* T, int pos, int fq) {
    const LAS f32x2* t = T + pos * 16 + 8 * (fq & 1);
#pragma unroll
    for (int n = 0; n < 2; ++n)
#pragma unroll
        for (int j = 0; j < 4; ++j) { const f32x2 cs = t[4 * n + j]; const float x1 = v0[n][j], x2 = v1[n][j]; v0[n][j] = x1 * cs.x - x2 * cs.y; v1[n][j] = x2 * cs.x + x1 * cs.y; }
}

__device__ __forceinline__ void head_row(f32x4 (&v0)[2], f32x4 (&v1)[2], const f32x4 (&g0)[2], const f32x4 (&g1)[2], float r2, const LAS f32x2* T, int pos, int fq) {
    float ss = 0.f;
#pragma unroll
    for (int n = 0; n < 2; ++n) { ss += (v0[n][0] * v0[n][0] + v0[n][1] * v0[n][1]) + (v0[n][2] * v0[n][2] + v0[n][3] * v0[n][3]); ss += (v1[n][0] * v1[n][0] + v1[n][1] * v1[n][1]) + (v1[n][2] * v1[n][2] + v1[n][3] * v1[n][3]); }
    ss += shx<16>(ss); ss += shx<32>(ss);
    const float rs = __builtin_amdgcn_sqrtf(r2) * __builtin_amdgcn_rsqf(r2 * ss * (1.f / 64.f) + EPS);
#pragma unroll
    for (int n = 0; n < 2; ++n) {
        v0[n] = v0[n] * rs * g0[n]; v1[n] = v1[n] * rs * g1[n];
        if (pos >= 0) { const LAS f32x2* t = T + pos * 16 + 8 * (fq & 1) + 4 * n;
#pragma unroll
            for (int j = 0; j < 4; ++j) { const f32x2 cs = t[j]; const float x1 = v0[n][j], x2 = v1[n][j]; v0[n][j] = x1 * cs.x - x2 * cs.y; v1[n][j] = x2 * cs.x + x1 * cs.y; } }
    }
}
__device__ __forceinline__ void load_gains(const float* gp, int fq, f32x4 (&g0)[2], f32x4 (&g1)[2]) {
#pragma unroll
    for (int n = 0; n < 2; ++n) { g0[n] = *(const f32x4*)(gp + 8 * fq + 4 * n); g1[n] = *(const f32x4*)(gp + 32 + 8 * fq + 4 * n); }
}

struct EpiEven {
    static constexpr bool PERM = true, AFTER_DRAIN = false;
    unsigned char* ws; lds_ptr lds; float qscale;
    __device__ __forceinline__ void operator()(const f32x4 (&acc)[2][2][4][2], const Unit& u, int wr, int wc, int fr_, int fq_) const {
        int fr = fr_, fq = fq_; asm volatile("" : "+v"(fr), "+v"(fq));
        const int unit = 4 * u.pn + wc;
        const LAS f32x2* T = (const LAS f32x2*)(lds + ROPE_OFF); Frame Fq; Fq.lds = lds;
        const int gi = unit < 8 ? I_QNA : unit < 16 ? I_QNB : unit < 18 ? I_KNA : unit < 20 ? -1 : unit < 28 ? I_KNB : -1;
        const float* gp = gi >= 0 ? inp(Fq, gi) : nullptr;
        f32x4 g0[2], g1[2]; if (gp) load_gains(gp, fq, g0, g1);
#pragma unroll
        for (int ai = 0; ai < 2; ++ai) {
            const int rb = u.pm * 256 + ai * 128 + wr * 64; const RowGrp G = rowgrp(rb);
#pragma unroll
            for (int m = 0; m < 4; ++m) {
                const int kk = 16 * m + fr; const size_t row = (size_t)rb + kk;
                f32x4 v0[2] = {acc[ai][0][m][0], acc[ai][0][m][1]}, v1[2] = {acc[ai][1][m][0], acc[ai][1][m][1]};
                if (gp) head_row(v0, v1, g0, g1, 1.0f, T, G.is_ctx ? -1 : (fq < 2 ? G.ktile : kk), fq);
                if (unit < 16) {
                    bf16_t* q = (bf16_t*)(ws + WS_Q) + row * DM + 64 * unit + 8 * fq;
                    *(u32x4*)q = pack8(v0[0] * qscale, v0[1] * qscale); *(u32x4*)(q + 32) = pack8(v1[0] * qscale, v1[1] * qscale);
                } else if (unit < 18 || (unit >= 20 && unit < 28)) {
                    unsigned char* img = unit < 18 ? ws + WS_KA + ((size_t)(G.b * 2 + (unit - 16)) * NKT + G.ktile) * 8192 : ws + WS_KB + ((size_t)(G.b * 8 + (unit - 20)) * NKT + G.ktile) * 8192;
                    *(u32x4*)(img + fq * 1024 + kk * 16) = pack8(v0[0], v0[1]); *(u32x4*)(img + (4 + fq) * 1024 + kk * 16) = pack8(v1[0], v1[1]);
                } else if (unit < 20) {
                    unsigned char* img = ws + WS_VA + ((size_t)(G.b * 2 + (unit - 18)) * NKT + G.ktile) * 8192 + m * 1024 + fr * 64 + fq * 16;
                    *(u32x4*)img = pack8(v0[0], v0[1]); *(u32x4*)(img + 4096) = pack8(v1[0], v1[1]);
                } else {
                    const int j = unit - 28, h = j >> 1, half = j & 1;
                    unsigned char* img = ws + WS_VB + ((size_t)(G.b * 4 + h) * NKT + G.ktile) * 16384 + (2 * half) * 4096 + m * 1024 + fr * 64 + fq * 16;
                    *(u32x4*)img = pack8(v0[0], v0[1]); *(u32x4*)(img + 4096) = pack8(v1[0], v1[1]);
                }
                asm volatile("" ::: "memory");
            }
        }
    }
};

__device__ __forceinline__ void unpack8(const u32x4 w, f32x4& a, f32x4& b) {
#pragma unroll
    for (int j = 0; j < 2; ++j) { a[2 * j] = __builtin_bit_cast(float, w[j] << 16); a[2 * j + 1] = __builtin_bit_cast(float, w[j] & 0xffff0000u); b[2 * j] = __builtin_bit_cast(float, w[2 + j] << 16); b[2 * j + 1] = __builtin_bit_cast(float, w[2 + j] & 0xffff0000u); }
}
template <bool IN_BF16, bool OUT_BF16> struct EpiResid {
    static constexpr bool PERM = true, AFTER_DRAIN = false;
    const void* xin_lat; const void* xin_ctx; void* out_lat; void* out_ctx; const float* gate  ; float* part;
    __device__ __forceinline__ void operator()(const f32x4 (&acc)[2][2][4][2], const Unit& u, int wr, int wc, int fr_, int fq_) const {
        int fr = fr_, fq = fq_; asm volatile("" : "+v"(fr), "+v"(fq));
        const int rb0 = u.pm * 256; const bool ctx = rb0 >= MLAT; const int mr = ctx ? 8 : (rb0 >> 12);
        if (u.nt) {
            bf16_t* pp = (bf16_t*)part + ((size_t)u.aux * MCTX + (rb0 - MLAT)) * DM + u.pn * 256 + wc * 32 + 8 * fq;
#pragma unroll
            for (int bj = 0; bj < 2; ++bj) { const f32x4 ga = *(const f32x4*)(gate + (size_t)8 * 6144 + u.pn * 256 + wc * 32 + 8 * fq + 128 * bj), gb = *(const f32x4*)(gate + (size_t)8 * 6144 + u.pn * 256 + wc * 32 + 8 * fq + 128 * bj + 4);
#pragma unroll
                for (int ai = 0; ai < 2; ++ai)
#pragma unroll
                    for (int m = 0; m < 4; ++m) *(u32x4*)(pp + (size_t)(ai * 128 + wr * 64 + 16 * m + fr) * DM + 128 * bj) = pack8(ga * acc[ai][bj][m][0], gb * acc[ai][bj][m][1]); }
            return; }
        const size_t ro = (size_t)(ctx ? rb0 - MLAT : rb0) * DM;
        const unsigned char* xin = (const unsigned char*)(ctx ? xin_ctx : xin_lat) + ro * (IN_BF16 ? 2 : 4); unsigned char* out = (unsigned char*)(ctx ? out_ctx : out_lat) + ro * (OUT_BF16 ? 2 : 4);
        const int c0 = u.pn * 256 + wc * 32 + 8 * fq;
        f32x4 gt[2][2];
#pragma unroll
        for (int bj = 0; bj < 2; ++bj)
#pragma unroll
            for (int n = 0; n < 2; ++n) gt[bj][n] = *(const f32x4*)(gate + (size_t)mr * 6144 + c0 + 128 * bj + 4 * n);
#pragma unroll
        for (int ai = 0; ai < 2; ++ai) {
            u32x4 xb[4][2]; f32x4 xf[4][2][2];
#pragma unroll
            for (int m = 0; m < 4; ++m) { const size_t off = (size_t)(ai * 128 + wr * 64 + 16 * m + fr) * DM + c0;
#pragma unroll
                for (int bj = 0; bj < 2; ++bj) {
                    if (IN_BF16) xb[m][bj] = *(const u32x4*)(xin + (off + 128 * bj) * 2);
                    else { xf[m][bj][0] = *(const f32x4*)(xin + (off + 128 * bj) * 4); xf[m][bj][1] = *(const f32x4*)(xin + (off + 128 * bj + 4) * 4); } } }
            asm volatile("" ::: "memory");
#pragma unroll
            for (int m = 0; m < 4; ++m) { const size_t off = (size_t)(ai * 128 + wr * 64 + 16 * m + fr) * DM + c0;
#pragma unroll
                for (int bj = 0; bj < 2; ++bj) { f32x4 x0, x1;
                    if (IN_BF16) unpack8(xb[m][bj], x0, x1); else { x0 = xf[m][bj][0]; x1 = xf[m][bj][1]; }
                    x0 += gt[bj][0] * acc[ai][bj][m][0]; x1 += gt[bj][1] * acc[ai][bj][m][1];
                    if (OUT_BF16) *(u32x4*)(out + (off + 128 * bj) * 2) = pack8(x0, x1);
                    else { *(f32x4*)(out + (off + 128 * bj) * 4) = x0; *(f32x4*)(out + (off + 128 * bj + 4) * 4) = x1; } } }
            asm volatile("" ::: "memory");
        }
    }
};

struct EpiSwiglu {
    static constexpr bool PERM = true, AFTER_DRAIN = false;
    bf16_t* act;
    __device__ __forceinline__ void operator()(const f32x4 (&acc)[2][2][4][2], const Unit& u, int wr, int wc, int fr_, int fq_) const {
        int fr = fr_, fq = fq_; asm volatile("" : "+v"(fr), "+v"(fq));
#pragma unroll
        for (int ai = 0; ai < 2; ++ai)
#pragma unroll
            for (int m = 0; m < 4; ++m) { const size_t row = (size_t)u.pm * 256 + ai * 128 + wr * 64 + 16 * m + fr; f32x4 o[2];
#pragma unroll
                for (int n = 0; n < 2; ++n)
#pragma unroll
                    for (int j = 0; j < 4; ++j) o[n][j] = silu_f(acc[ai][0][m][n][j]) * acc[ai][1][m][n][j];
                *(u32x4*)(act + row * FFH + u.pn * 128 + wc * 32 + 8 * fq) = pack8(o[0], o[1]); }
    }
};

struct EpiOdd {
    static constexpr bool PERM = true, AFTER_DRAIN = false;
    unsigned char* ws; lds_ptr lds;
    __device__ __forceinline__ void operator()(const f32x4 (&acc)[2][2][4][2], const Unit& u, int wr, int wc, int fr_, int fq_) const {
        int fr = fr_, fq = fq_; asm volatile("" : "+v"(fr), "+v"(fq));
        const int pn = u.pn;
        if (pn == 6) {
            if (wc != 0) return;
            const LAS f32x2* T = (const LAS f32x2*)(lds + ROPE_OFF); Frame Fq; Fq.lds = lds; const float* knr = inp(Fq, I_KNR);
            f32x4 g0[2], g1[2]; load_gains(knr, fq, g0, g1);
#pragma unroll
            for (int ai = 0; ai < 2; ++ai) { const int rb = u.pm * 256 + ai * 128 + wr * 64; const RowGrp G = rowgrp(rb);
#pragma unroll
                for (int m = 0; m < 4; ++m) { const int kk = 16 * m + fr;
                    f32x4 v0[2] = {acc[ai][0][m][0], acc[ai][0][m][1]}, v1[2] = {acc[ai][1][m][0], acc[ai][1][m][1]};
                    head_row(v0, v1, g0, g1, 1.0f, T, G.is_ctx ? -1 : (fq < 2 ? G.ktile : kk), fq);
                    const u32x4 w0 = pack8(v0[0], v0[1]), w1 = pack8(v1[0], v1[1]);
#pragma unroll
                    for (int h = 0; h < 4; ++h) { unsigned char* img = ws + WS_KD + ((size_t)(G.b * 4 + h) * NKT + G.ktile) * 16384 + kk * 16;
                        *(u32x4*)(img + (8 + fq) * 1024) = w0; *(u32x4*)(img + (12 + fq) * 1024) = w1; }
                    asm volatile("" ::: "memory"); } }
            return;
        }
        const bool act = pn < 4; bf16_t* dbase; int ldd; float* sbase = nullptr;
        if (pn < 2) { dbase = (bf16_t*)(ws + WS_UACT) + 256 * pn; ldd = 512; }
        else if (pn < 4) { dbase = (bf16_t*)(ws + WS_VACT) + 256 * (pn - 2); ldd = 512; sbase = (float*)(ws + WS_VSS) + (pn - 2) * 4 + wc; }
        else if (pn == 4) { dbase = (bf16_t*)(ws + WS_CQ); ldd = 256; sbase = (float*)(ws + WS_CQS) + wc; }
        else { dbase = (bf16_t*)(ws + WS_CKV); ldd = 256; sbase = (float*)(ws + WS_CKS) + wc; }
        const int c0 = 32 * wc + 8 * fq;
#pragma unroll
        for (int ai = 0; ai < 2; ++ai)
#pragma unroll
            for (int m = 0; m < 4; ++m) { const size_t row = (size_t)u.pm * 256 + ai * 128 + wr * 64 + 16 * m + fr; float ss = 0.f;
#pragma unroll
                for (int bj = 0; bj < 2; ++bj) { f32x4 a = acc[ai][bj][m][0], b = acc[ai][bj][m][1];
                    if (act) { f32x2 t0 = gelu_pk((f32x2){a[0], a[1]}), t1 = gelu_pk((f32x2){a[2], a[3]}), t2 = gelu_pk((f32x2){b[0], b[1]}), t3 = gelu_pk((f32x2){b[2], b[3]});
                        a = (f32x4){t0.x, t0.y, t1.x, t1.y}; b = (f32x4){t2.x, t2.y, t3.x, t3.y}; }
                    ss += (a[0] * a[0] + a[1] * a[1]) + (a[2] * a[2] + a[3] * a[3]) + (b[0] * b[0] + b[1] * b[1]) + (b[2] * b[2] + b[3] * b[3]);
                    *(u32x4*)(dbase + row * ldd + 128 * bj + c0) = pack8(a, b); }
                if (sbase) { ss += shx<16>(ss); ss += shx<32>(ss); if (fq == 0) sbase[row * 8] = ss; }
                asm volatile("" ::: "memory"); }
    }
};

struct EpiUq {
    static constexpr bool PERM = true, AFTER_DRAIN = false;
    unsigned char* ws; lds_ptr lds; float qscale;
    __device__ __forceinline__ void operator()(const f32x4 (&acc)[2][2][4][2], const Unit& u, int wr, int wc, int fr_, int fq_) const {
        int fr = fr_, fq = fq_; asm volatile("" : "+v"(fr), "+v"(fq));
        const LAS f32x2* T = (const LAS f32x2*)(lds + ROPE_OFF); Frame Fq; Fq.lds = lds;
        const int unit = 4 * u.pn + wc, part = unit & 1; const float* gp = inp(Fq, part ? I_QNR : I_QNN);
        f32x4 g0[2], g1[2]; load_gains(gp, fq, g0, g1);
        float r2s[8];
#pragma unroll
        for (int i = 0; i < 8; ++i) { const size_t row = (size_t)u.pm * 256 + (i >> 2) * 128 + wr * 64 + 16 * (i & 3) + fr; const f32x4 sq = *(const f32x4*)((const float*)(ws + WS_CQS) + row * 8); r2s[i] = __builtin_amdgcn_rcpf(((sq[0] + sq[1]) + (sq[2] + sq[3])) * (1.f / 256.f) + EPS); }
#pragma unroll
        for (int ai = 0; ai < 2; ++ai) { const int rb = u.pm * 256 + ai * 128 + wr * 64; const RowGrp G = rowgrp(rb);
#pragma unroll
            for (int m = 0; m < 4; ++m) { const int kk = 16 * m + fr; const size_t row = (size_t)rb + kk; const float r2 = r2s[ai * 4 + m];
                f32x4 v0[2] = {acc[ai][0][m][0], acc[ai][0][m][1]}, v1[2] = {acc[ai][1][m][0], acc[ai][1][m][1]};
                head_row(v0, v1, g0, g1, r2, T, (part && !G.is_ctx) ? (fq < 2 ? G.ktile : kk) : -1, fq);
                bf16_t* q = (bf16_t*)(ws + WS_Q2) + row * 512 + 64 * unit + 8 * fq;
                *(u32x4*)q = pack8(v0[0] * qscale, v0[1] * qscale); *(u32x4*)(q + 32) = pack8(v1[0] * qscale, v1[1] * qscale);
                asm volatile("" ::: "memory"); } }
    }
};
struct EpiUkv {
    static constexpr bool PERM = true, AFTER_DRAIN = false;
    unsigned char* ws; lds_ptr lds;
    __device__ __forceinline__ void operator()(const f32x4 (&acc)[2][2][4][2], const Unit& u, int wr, int wc, int fr_, int fq_) const {
        int fr = fr_, fq = fq_; asm volatile("" : "+v"(fr), "+v"(fq));
        const float* knn = nullptr; if (u.pn == 0) { Frame Fq; Fq.lds = lds; knn = inp(Fq, I_KNN); }
        f32x4 g0[2], g1[2]; if (u.pn == 0) load_gains(knn, fq, g0, g1);
        float r2s[8];
#pragma unroll
        for (int i = 0; i < 8; ++i) { const size_t row = (size_t)u.pm * 256 + (i >> 2) * 128 + wr * 64 + 16 * (i & 3) + fr; const f32x4 sq = *(const f32x4*)((const float*)(ws + WS_CKS) + row * 8); r2s[i] = __builtin_amdgcn_rcpf(((sq[0] + sq[1]) + (sq[2] + sq[3])) * (1.f / 256.f) + EPS); }
#pragma unroll
        for (int ai = 0; ai < 2; ++ai) { const int rb = u.pm * 256 + ai * 128 + wr * 64; const RowGrp G = rowgrp(rb);
#pragma unroll
            for (int m = 0; m < 4; ++m) { const int kk = 16 * m + fr; const size_t row = (size_t)rb + kk; const float r2 = r2s[ai * 4 + m];
                f32x4 v0[2] = {acc[ai][0][m][0], acc[ai][0][m][1]}, v1[2] = {acc[ai][1][m][0], acc[ai][1][m][1]};
                if (u.pn == 0) {
                    head_row(v0, v1, g0, g1, r2, (const LAS f32x2*)nullptr, -1, fq);
                    unsigned char* img = ws + WS_KD + ((size_t)(G.b * 4 + wc) * NKT + G.ktile) * 16384 + kk * 16;
                    *(u32x4*)(img + fq * 1024) = pack8(v0[0], v0[1]); *(u32x4*)(img + (4 + fq) * 1024) = pack8(v1[0], v1[1]);
                } else {
                    const float rs = __builtin_amdgcn_sqrtf(r2); const int uu = 4 * (u.pn - 1) + wc, h = uu >> 1, half = uu & 1;
                    unsigned char* img = ws + WS_VD + ((size_t)(G.b * 4 + h) * NKT + G.ktile) * 16384 + (2 * half) * 4096 + m * 1024 + fr * 64 + fq * 16;
                    *(u32x4*)img = pack8(v0[0] * rs, v0[1] * rs); *(u32x4*)(img + 4096) = pack8(v1[0] * rs, v1[1] * rs);
                }
                asm volatile("" ::: "memory"); } }
    }
};

struct EpiNull { static constexpr bool PERM = true, AFTER_DRAIN = false;
    __device__ __forceinline__ void operator()(const f32x4 (&acc)[2][2][4][2], const Unit& u, int wr, int wc, int fr, int fq) const { asm volatile("" :: "v"(acc[0][0][0][0]), "v"(acc[1][1][3][1])); } };
struct UqkvOrder {
    int G, c;
    __device__ void init(int G_, int c_) { G = G_; c = c_; }
    __device__ static void tmpl(int L, int nM, int nN, Unit& u) { const int nwg = nM * nN; int wgid = L; { const int q = nwg / pg8::NXCD, r = nwg % pg8::NXCD, xcd = wgid % pg8::NXCD, off = wgid / pg8::NXCD; wgid = (xcd < r ? xcd * (q + 1) : r * (q + 1) + (xcd - r) * q) + off; }
        const int nig = pg8::WGM * nN, gid = wgid / nig, fm = gid * pg8::WGM, gsz = (nM - fm) < pg8::WGM ? (nM - fm) : pg8::WGM; u.pm = fm + ((wgid % nig) % gsz); u.pn = (wgid % nig) / gsz; }
    __device__ bool next(int i, Unit& u) const { const int L = i * G + c; u.k0 = 0; u.nt = 0;
        if (L < 256) { tmpl(L, MLAT / 256, 2, u); u.aux = 0; return true; }
        if (L < 256 + 408) { tmpl(L - 256, MALL / 256, 3, u); u.pm += 128; u.pn += 2; u.aux = 1; return true; }
        return false; }
    __device__ __forceinline__ void a_ready(const Unit&) const {}
    __device__ __forceinline__ void done(const Unit&) const {}
};
struct EpiUqkv {
    static constexpr bool PERM = true, AFTER_DRAIN = false;
    EpiUq q; EpiUkv kv;
    __device__ __forceinline__ void operator()(const f32x4 (&acc)[2][2][4][2], const Unit& u, int wr, int wc, int fr, int fq) const {
        if (u.aux == 0) q(acc, u, wr, wc, fr, fq);
        else { Unit v = u; v.pm -= 128; v.pn -= 2; kv(acc, v, wr, wc, fr, fq); }
    }
};
struct OddOrder {
    pg8::StaticOrder base;
    __device__ void init(int G, int c) { base.init(MLAT, 1792, G, c); }
    __device__ bool next(int i, Unit& u) const { const long L = (long)i * base.G + base.c; if (L < base.nwg) return base.next(i, u); const int q = (int)(L - base.nwg); if (q >= 16) return false; u.pm = 128 + (q >> 1); u.pn = 5 + (q & 1); u.k0 = 0; u.nt = 0; u.aux = 0; return true; }
    __device__ __forceinline__ void a_ready(const Unit&) const {}
    __device__ __forceinline__ void done(const Unit&) const {}
};

struct SplitOrder {
    pg8::StaticOrder base; int npairs;
    __device__ void init(int K, int G, int c) { base.init(MLAT, DM, G, c); npairs = K / 128; }
    __device__ bool next(int i, Unit& u) const { const long L = (long)i * base.G + base.c; if (L < base.nwg) return base.next(i, u); const int q = (int)(L - base.nwg); if (q >= 32 * NSL) return false;
        const int unit = q / NSL, sl = q % NSL, lo = npairs / NSL, rem = npairs % NSL;
        const int p0 = sl * lo + (sl < rem ? sl : rem), np = lo + (sl < rem ? 1 : 0);
        u.pm = 128 + (unit >> 2); u.pn = unit & 3; u.k0 = 128 * p0; u.nt = 2 * np; u.aux = sl; return true; }
    __device__ __forceinline__ void a_ready(const Unit&) const {}
    __device__ __forceinline__ void done(const Unit&) const {}
};

__device__ __forceinline__ void glds16(const void* gsrc, unsigned lds_dst) { unsigned keep;
    asm volatile("s_mov_b32 %0, m0\n\ts_mov_b32 m0, %2\n\ts_nop 0\n\tglobal_load_lds_dwordx4 %1, off\n\ts_mov_b32 m0, %0" : "=&s"(keep) : "v"(gsrc), "s"(lds_dst) : "memory"); }
#define AT_WAIT_BAR() asm volatile("s_waitcnt vmcnt(0) lgkmcnt(0)\n\ts_barrier" ::: "memory")

template <int DQK, int DV>
__device__ __forceinline__ void attn_pre(lds_ptr lds, const bf16_t* qptr, int ldq, const unsigned char* Kimg, const unsigned char* Vimg, int tile0, bf16x8 (&qr)[DQK / 16]) {
    constexpr int KBY = 64 * DQK * 2, VBY = 64 * DV * 2, NKR = KBY / 8192, NVR = VBY / 8192;
    int tid_ = threadIdx.x; asm volatile("" : "+v"(tid_));
    const int lane = tid_ & 63, r32 = lane & 31, hi = lane >> 5; const int wv = __builtin_amdgcn_readfirstlane(tid_ >> 6);
    const unsigned lds0 = (unsigned)(uintptr_t)lds;
    const unsigned char* gk = Kimg + (size_t)tile0 * KBY + wv * 1024 + lane * 16; const unsigned char* gv = Vimg + (size_t)tile0 * VBY + wv * 1024 + lane * 16;
#pragma unroll
    for (int tt = 0; tt < 2; ++tt) {
#pragma unroll
        for (int i = 0; i < NKR; ++i) glds16(gk + (size_t)tt * KBY + i * 8192, (unsigned)__builtin_amdgcn_readfirstlane(lds0 + tt * (KBY + VBY) + i * 8192 + wv * 1024));
#pragma unroll
        for (int i = 0; i < NVR; ++i) glds16(gv + (size_t)tt * VBY + i * 8192, (unsigned)__builtin_amdgcn_readfirstlane(lds0 + tt * (KBY + VBY) + KBY + i * 8192 + wv * 1024)); }
#pragma unroll
    for (int d0 = 0; d0 < DQK / 16; ++d0) qr[d0] = *(const bf16x8*)(qptr + (size_t)r32 * ldq + d0 * 16 + hi * 8);
}
template <int DQK, int DV, int MODE, int ABL = 0, int KSO = 1, class Pre = int>
__device__ __forceinline__ void attn_unit(lds_ptr lds, const bf16x8 (&qr)[DQK / 16], const unsigned char* Kimg, const unsigned char* Vimg,
                                          int ta0, int ta1, int tb0, int tb1, int qpos0, int win, float negMb, float l_extra, bf16_t* optr, int ldo,
                                          float lam, float dscale, const float* subln, const Pre& pre) {
    const lds_ptr keepl = lds + 73728 + __builtin_amdgcn_readfirstlane((int)threadIdx.x >> 6) * 8192 + (threadIdx.x & 63) * 16;
    constexpr int KBY = 64 * DQK * 2, VBY = 64 * DV * 2, SLOT = KBY + VBY, NKR = KBY / 8192, NVR = VBY / 8192;
    int tid_ = threadIdx.x; asm volatile("" : "+v"(tid_));
    const int tid = tid_, lane = tid & 63, r32 = lane & 31, hi = lane >> 5; const int wv = __builtin_amdgcn_readfirstlane(tid >> 6);
    const unsigned long long ts_in = TS_ATT ? __builtin_amdgcn_s_memrealtime() : 0ull; (void)ts_in;
    const int na = ta1 - ta0, nt = na + (tb1 - tb0);
    const unsigned lds0 = (unsigned)(uintptr_t)lds;
    f32x16 o[DV / 32];
#pragma unroll
    for (int d = 0; d < DV / 32; ++d)
#pragma unroll
        for (int r = 0; r < 16; ++r) o[d][r] = 0.f;
    float lsum = 0.f, lsum2 = 0.f;
#define AT_TILE(tt) ((tt) < na ? ta0 + (tt) : tb0 + ((tt) - na))
#define AT_DMA(tt, slot) do { const int t_ = AT_TILE(tt); const unsigned char* gk_ = Kimg + (size_t)t_ * KBY + wv * 1024 + lane * 16; const unsigned char* gv_ = Vimg + (size_t)t_ * VBY + wv * 1024 + lane * 16; \
        _Pragma("unroll") for (int i = 0; i < NKR; ++i) glds16(gk_ + i * 8192, (unsigned)__builtin_amdgcn_readfirstlane(lds0 + (slot) * SLOT + i * 8192 + wv * 1024)); \
        _Pragma("unroll") for (int i = 0; i < NVR; ++i) glds16(gv_ + i * 8192, (unsigned)__builtin_amdgcn_readfirstlane(lds0 + (slot) * SLOT + KBY + i * 8192 + wv * 1024)); } while (0)
#define AT_KRD(dst, i0, n, slot) do { const lds_cptr kb_ = (lds_cptr)lds + (slot) * SLOT + hi * 1024 + r32 * 16; \
        _Pragma("unroll") for (int i_ = 0; i_ < (n); ++i_) { dst[2 * i_] = *(const LAS bf16x8*)(kb_ + ((i0) + i_) * 2048); dst[2 * i_ + 1] = *(const LAS bf16x8*)(kb_ + ((i0) + i_) * 2048 + 512); } } while (0)
#define AT_QKM(P0, P1, src, i0, n) do { _Pragma("unroll") for (int i_ = 0; i_ < (n); ++i_) { const int d0 = (i0) + i_; \
        P0 = __builtin_amdgcn_mfma_f32_32x32x16_bf16(src[2 * i_], qr[d0], d0 == 0 ? z_ : P0, 0, 0, 0); P1 = __builtin_amdgcn_mfma_f32_32x32x16_bf16(src[2 * i_ + 1], qr[d0], d0 == 0 ? z_ : P1, 0, 0, 0); } } while (0)
#define AT_QK(P0, P1, slot) do { \
        const f32x16 z_ = {0.f, 0.f, 0.f, 0.f, 0.f, 0.f, 0.f, 0.f, 0.f, 0.f, 0.f, 0.f, 0.f, 0.f, 0.f, 0.f}; \
        bf16x8 kx_[4]; AT_KRD(kx_, 2, 2, slot); __builtin_amdgcn_sched_barrier(0);     \
        if constexpr (DQK == 64) { AT_QKM(P0, P1, kp, 0, 2); __builtin_amdgcn_sched_barrier(0); AT_QKM(P0, P1, kx_, 2, 2); __builtin_amdgcn_sched_barrier(0); } \
        else { bf16x8 ky_[8]; AT_QKM(P0, P1, kp, 0, 2); AT_KRD(ky_, 4, 4, slot); __builtin_amdgcn_sched_barrier(0); AT_QKM(P0, P1, kx_, 2, 2); __builtin_amdgcn_sched_barrier(0); AT_QKM(P0, P1, ky_, 4, 4); __builtin_amdgcn_sched_barrier(0); } } while (0)
#define AT_SM(P0, P1, tt) do { \
        if (win && (tt) < na) { const int dq0_ = (qpos0 + r32) - 64 * AT_TILE(tt) + 128; \
            _Pragma("unroll") for (int r = 0; r < 16; ++r) { const int k_ = crow(r, hi); if ((unsigned)(dq0_ - k_) > 256u) P0[r] = -INFINITY; if ((unsigned)(dq0_ - k_ - 32) > 256u) P1[r] = -INFINITY; } } } while (0)
#define AT_SL(P, b, w, LS) do { _Pragma("unroll") for (int r = (b); r < (b) + 8; ++r) { P[r] = __builtin_amdgcn_exp2f(P[r]); LS += P[r]; asm volatile("" : "+v"(LS)); } \
        _Pragma("unroll") for (int q = 0; q < 4; ++q) pw[w][q] = pk2(P[(b) + 2 * q], P[(b) + 2 * q + 1]); } while (0)
#define AT_VLD(slot, nslot, has_next) do { const lds_cptr vp_ = (lds_cptr)lds + (slot) * SLOT + KBY + ((lane >> 4) & 1) * 32 + (lane & 3) * 8 + (4 * hi + ((lane & 15) >> 2)) * 64; \
        _Pragma("unroll") for (int d = 0; d < DV / 32; ++d) _Pragma("unroll") for (int ks = 0; ks < 4; ++ks) { vlo[d * 4 + ks] = vtr(vp_ + d * 4096 + ks * 1024); vhi[d * 4 + ks] = vtr(vp_ + d * 4096 + ks * 1024 + 512); } \
        if (has_next) AT_KRD(kp, 0, 2, nslot);     \
        __builtin_amdgcn_sched_barrier(0); } while (0)
#define AT_PVK(ks) do { _Pragma("unroll") for (int d = 0; d < DV / 32; ++d) { const s16x4 lo_ = vlo[d * 4 + (ks)], hh_ = vhi[d * 4 + (ks)]; \
            const bf16x8 vf_ = (bf16x8){lo_[0], lo_[1], lo_[2], lo_[3], hh_[0], hh_[1], hh_[2], hh_[3]}; \
            o[d] = __builtin_amdgcn_mfma_f32_32x32x16_bf16(vf_, __builtin_bit_cast(bf16x8, pw[ks]), o[d], 0, 0, 0); } } while (0)
#define AT_PVM(P0, P1) do { if constexpr (KSO == 3) { AT_SL(P0, 0, 0, lsum); AT_SL(P0, 8, 1, lsum); AT_PVK(0); AT_PVK(1); AT_SL(P1, 0, 2, lsum2); AT_SL(P1, 8, 3, lsum2); AT_PVK(2); AT_PVK(3); } \
        else { AT_SL(P0, 0, 0, lsum); AT_PVK(0); AT_SL(P0, 8, 1, lsum); AT_PVK(1); AT_SL(P1, 0, 2, lsum2); AT_PVK(2); AT_SL(P1, 8, 3, lsum2); AT_PVK(3); } } while (0)
#define AT_SM_ALL(P0, P1, tt) do { \
        if (win && (tt) < na) { const int dq0_ = (qpos0 + r32) - 64 * AT_TILE(tt) + 128; \
            _Pragma("unroll") for (int r = 0; r < 16; ++r) { const int k_ = crow(r, hi); if ((unsigned)(dq0_ - k_) > 256u) P0[r] = -INFINITY; if ((unsigned)(dq0_ - k_ - 32) > 256u) P1[r] = -INFINITY; } } \
        _Pragma("unroll") for (int r = 0; r < 16; ++r) { P0[r] = __builtin_amdgcn_exp2f(P0[r]); P1[r] = __builtin_amdgcn_exp2f(P1[r]); lsum += P0[r]; asm volatile("" : "+v"(lsum)); lsum2 += P1[r]; asm volatile("" : "+v"(lsum2)); } \
        _Pragma("unroll") for (int q = 0; q < 4; ++q) { pw[0][q] = pk2(P0[2 * q], P0[2 * q + 1]); pw[1][q] = pk2(P0[8 + 2 * q], P0[8 + 2 * q + 1]); pw[2][q] = pk2(P1[2 * q], P1[2 * q + 1]); pw[3][q] = pk2(P1[8 + 2 * q], P1[8 + 2 * q + 1]); } } while (0)
#define AT_PVM_ALL() do { \
        _Pragma("unroll") for (int d = 0; d < DV / 32; ++d) _Pragma("unroll") for (int ks = 0; ks < 4; ++ks) { const s16x4 lo_ = vlo[d * 4 + ks], hh_ = vhi[d * 4 + ks]; \
            const bf16x8 vf_ = (bf16x8){lo_[0], lo_[1], lo_[2], lo_[3], hh_[0], hh_[1], hh_[2], hh_[3]}; \
            o[d] = __builtin_amdgcn_mfma_f32_32x32x16_bf16(vf_, __builtin_bit_cast(bf16x8, pw[ks]), o[d], 0, 0, 0); } } while (0)
#define AT_BAR() asm volatile("s_waitcnt lgkmcnt(0)\n\ts_barrier" ::: "memory")
    f32x16 sa0, sa1; u32x4 pw[4]; s16x4 vlo[DV / 8], vhi[DV / 8];
    unsigned long long ts_a = 0, ts_b = 0, ts_c = 0; (void)ts_a; (void)ts_b; (void)ts_c;
    bf16x8 kp[4];
    int sc = 0, sn = 1, sf = 2;
    for (int t = 0; t < nt; ++t) {
        AT_WAIT_BAR();
        if (TS_ATT && t == 0) ts_a = __builtin_amdgcn_s_memrealtime();
        if (!AT_DMA_LATE) { if (t + 2 < nt) AT_DMA(t + 2, sf); }
        if (t == 0) AT_KRD(kp, 0, 2, sc);
        if (!(ABL & 8)) { AT_QK(sa0, sa1, sc); }
        if (!(ABL & 4)) { AT_VLD(sc, sn, t + 1 < nt); }
        if (AT_DMA_LATE) { if (t + 2 < nt) AT_DMA(t + 2, sf); __builtin_amdgcn_sched_barrier(0); }
        if (!(ABL & 1)) { if constexpr (KSO != 0) { AT_SM(sa0, sa1, t); } else { AT_SM_ALL(sa0, sa1, t); } } else { _Pragma("unroll") for (int q = 0; q < 4; ++q) { pw[0][q] = __builtin_bit_cast(unsigned, sa0[q]); pw[1][q] = __builtin_bit_cast(unsigned, sa0[4 + q]); pw[2][q] = __builtin_bit_cast(unsigned, sa1[q]); pw[3][q] = __builtin_bit_cast(unsigned, sa1[4 + q]); } }
        if (!(ABL & 4)) { if constexpr (KSO != 0) { AT_PVM(sa0, sa1); } else { AT_PVM_ALL(); } }
        { const int s_ = sc; sc = sn; sn = sf; sf = s_; }
    }
    AT_WAIT_BAR();
    if (TS_ATT) ts_b = __builtin_amdgcn_s_memrealtime();
    pre();
#undef AT_TILE
#undef AT_DMA
#undef AT_QK
#undef AT_QKM
#undef AT_KRD
#undef AT_SM
#undef AT_SM_ALL
#undef AT_PVM_ALL
#undef AT_SL
#undef AT_PVK
#undef AT_VLD
#undef AT_PVM
#undef AT_BAR
    lsum += lsum2; lsum += shx<32>(lsum); lsum += l_extra;
    const float linv = 1.0f / lsum;
    bf16_t* orow = optr + (size_t)r32 * ldo + 8 * hi;
#define AT_ROWST(d, gp, e0, e1, e2, e3, e4, e5, e6, e7) do { const unsigned ax_ = pk2(e0, e1), ay_ = pk2(e2, e3), bx_ = pk2(e4, e5), by_ = pk2(e6, e7); \
        const auto sx_ = __builtin_amdgcn_permlane32_swap(ax_, bx_, false, false); const auto sy_ = __builtin_amdgcn_permlane32_swap(ay_, by_, false, false); \
        *(u32x4*)(orow + 32 * (d) + 16 * (gp)) = (u32x4){sx_[0], sy_[0], sx_[1], sy_[1]}; } while (0)
    if (MODE == 0) {
#pragma unroll
        for (int d = 0; d < DV / 32; ++d)
#pragma unroll
            for (int gp = 0; gp < 2; ++gp) AT_ROWST(d, gp, o[d][8 * gp] * linv, o[d][8 * gp + 1] * linv, o[d][8 * gp + 2] * linv, o[d][8 * gp + 3] * linv, o[d][8 * gp + 4] * linv, o[d][8 * gp + 5] * linv, o[d][8 * gp + 6] * linv, o[d][8 * gp + 7] * linv);
    } else if (MODE == 1) {
#pragma unroll
        for (int d = 0; d < DV / 32; ++d)
#pragma unroll
            for (int q4 = 0; q4 < 2; ++q4) { u32x4 kp;
#pragma unroll
                for (int e = 0; e < 4; ++e) { const int r = 8 * q4 + 2 * e; kp[e] = pk2(o[d][r] * linv, o[d][r + 1] * linv); }
                *(LAS u32x4*)(keepl + (d * 2 + q4) * 1024) = kp; }
    } else {
        float ss = 0.f;
#pragma unroll
        for (int d = 0; d < DV / 32; ++d)
#pragma unroll
            for (int q4 = 0; q4 < 2; ++q4) { const u32x4 kp = *(const LAS u32x4*)(keepl + (d * 2 + q4) * 1024);
#pragma unroll
                for (int e = 0; e < 4; ++e) { const int r = 8 * q4 + 2 * e; const float a0 = __builtin_bit_cast(float, kp[e] << 16), a1 = __builtin_bit_cast(float, kp[e] & 0xffff0000u);
                    const float w0 = a0 - lam * (o[d][r] * linv), w1 = a1 - lam * (o[d][r + 1] * linv); o[d][r] = w0; o[d][r + 1] = w1; ss += w0 * w0 + w1 * w1; } }
        ss += shx<32>(ss);
        const float rs = __builtin_amdgcn_rsqf(ss * (1.f / DV) + EPS) * dscale;
#pragma unroll
        for (int d = 0; d < DV / 32; ++d)
#pragma unroll
            for (int gp = 0; gp < 2; ++gp) { const f32x4 ga = *(const f32x4*)(subln + 32 * d + 16 * gp + 4 * hi) * rs, gb = *(const f32x4*)(subln + 32 * d + 16 * gp + 8 + 4 * hi) * rs;
                AT_ROWST(d, gp, o[d][8 * gp] * ga[0], o[d][8 * gp + 1] * ga[1], o[d][8 * gp + 2] * ga[2], o[d][8 * gp + 3] * ga[3], o[d][8 * gp + 4] * gb[0], o[d][8 * gp + 5] * gb[1], o[d][8 * gp + 6] * gb[2], o[d][8 * gp + 7] * gb[3]); }
    }
#undef AT_ROWST
    if (TS_ATT) { asm volatile("s_waitcnt vmcnt(0)" ::: "memory"); ts_c = __builtin_amdgcn_s_memrealtime(); if (blockIdx.x == TS_BLOCK && threadIdx.x == 0) { volatile LAS unsigned long long* ts = (volatile LAS unsigned long long*)(lds + MISC_OFF + 256); ts[24] += (ts_a - ts_in); ts[25] += (ts_b - ts_a); ts[26] += (ts_c - ts_b); ts[27] += 1; } }
}

struct AttCall { int kind  , b, hsel, ta0, ta1, tb0, tb1, qpos0, win; size_t m0; };
__device__ __forceinline__ bool att_call(const Frame& F, int n, AttCall& c) {
    const int w = F.wave; int i, sft;
    if (n < 4) { i = n >> 1; sft = n & 1; } else if (n < 8) { i = n - 2; sft = 0; } else { i = 6; sft = n - 8; }
    c.tb0 = 0; c.tb1 = 0; c.qpos0 = 0; c.win = 0;
    if (i < 2) { const int idx = F.vcu + 256 * i, j = idx >> 4, qb = idx & 15; c.kind = 1 + sft; c.b = j >> 2; c.hsel = j & 3; c.m0 = (size_t)c.b * SEQ + 256 * qb + 32 * w; c.ta0 = 0; c.ta1 = NKT; }
    else if (i < 6) { const int idx = F.vcu + 256 * (i - 2), kvh = (idx >> 6) & 1, nn = (idx >> 1) & 31, hp = idx & 1; c.kind = 0; c.b = idx >> 7; c.hsel = 4 * kvh + 2 * hp + (w >> 2);
        c.m0 = (size_t)c.b * SEQ + 128 * nn + 32 * (w & 3); c.ta0 = max(0, 2 * nn - 2); c.ta1 = min(64, 2 * nn + 4); c.tb0 = 64; c.tb1 = NKT; c.qpos0 = 128 * nn + 32 * (w & 3); c.win = 1; }
    else { if (n > 9 || F.vcu >= 128 || (F.vcu >= 32 && F.vcu < 64)) return false;
        if (F.vcu < 32) { c.kind = 1 + sft; c.b = F.vcu >> 2; c.hsel = F.vcu & 3; } else { if (sft) return false; const int j = F.vcu - 64; c.kind = 0; c.b = j >> 3; c.hsel = j & 7; }
        c.m0 = (size_t)MLAT + c.b * CTXL + 32 * w; c.ta0 = 64; c.ta1 = NKT; }
    return true;
}
__device__ __forceinline__ const unsigned char* att_K(const Frame& F, const AttCall& c) { return c.kind ? F.ws + WS_KB + (size_t)(c.b * 8 + 2 * c.hsel + (c.kind == 2 ? 1 : 0)) * NKT * 8192 : F.ws + WS_KA + (size_t)(c.b * 2 + (c.hsel >> 2)) * NKT * 8192; }
__device__ __forceinline__ const unsigned char* att_V(const Frame& F, const AttCall& c) { return c.kind ? F.ws + WS_VB + (size_t)(c.b * 4 + c.hsel) * NKT * 16384 : F.ws + WS_VA + (size_t)(c.b * 2 + (c.hsel >> 2)) * NKT * 8192; }
__device__ __forceinline__ void att_pre(const Frame& F, const AttCall& c, bf16x8 (&qr)[4]) {
    if (c.kind) attn_pre<64, 128>(F.lds, (const bf16_t*)(F.ws + WS_Q) + c.m0 * DM + 512 + 128 * c.hsel + (c.kind == 2 ? 64 : 0), DM, att_K(F, c), att_V(F, c), c.ta0, qr);
    else        attn_pre<64, 64>(F.lds, (const bf16_t*)(F.ws + WS_Q) + c.m0 * DM + 64 * c.hsel, DM, att_K(F, c), att_V(F, c), c.ta0, qr);
}
__device__ __forceinline__ void phase_attn_even(Frame& F) {
    const float MbA = 8.0f * gain_absmax64(inp(F, I_QNA)) * gain_absmax64(inp(F, I_KNA)) * LOG2E;
    const float MbB = 8.0f * gain_absmax64(inp(F, I_QNB)) * gain_absmax64(inp(F, I_KNB)) * LOG2E;
    const int w = F.wave, lane = ltid() & 63;
    float s1 = inp(F, I_LQ1)[lane] * inp(F, I_LK1)[lane], s2 = inp(F, I_LQ2)[lane] * inp(F, I_LK2)[lane];
    s1 = wave_sum(s1); s2 = wave_sum(s2);
    const float lam_init = 0.8f - 0.6f * 1.0f  , lam = expf(s1) - expf(s2) + lam_init;
    const float* subln = inp(F, I_SUBLN);
    bf16x8 qr[4];
    { AttCall c0; att_call(F, 0, c0); att_pre(F, c0, qr); }
    for (int n = 0; n < 10; ++n) {
        AttCall c; if (!att_call(F, n, c)) break;
        bf16x8 qn[4];
#pragma unroll
        for (int d = 0; d < 4; ++d) qn[d] = qr[d];
        const auto pre = [&]() { AttCall nx; if (att_call(F, n + 1, nx)) att_pre(F, nx, qn); };
        if (c.kind) {
            bf16_t* o = (bf16_t*)(F.ws + WS_MIX) + c.m0 * DM + 512 + 128 * c.hsel;
            if (c.kind == 1) attn_unit<64, 128, 1, 0, AT_KSO_B>(F.lds, qr, att_K(F, c), att_V(F, c), c.ta0, c.ta1, c.tb0, c.tb1, 0, 0, -MbB, 0.f, o, DM, lam, 1.0f - lam_init, subln, pre);
            else             attn_unit<64, 128, 2, 0, AT_KSO_B>(F.lds, qr, att_K(F, c), att_V(F, c), c.ta0, c.ta1, c.tb0, c.tb1, 0, 0, -MbB, 0.f, o, DM, lam, 1.0f - lam_init, subln, pre);
        } else {
            const float lx = __builtin_amdgcn_exp2f(inp(F, I_SINK)[c.hsel] * LOG2E);
            attn_unit<64, 64, 0, 0, AT_KSO_A>(F.lds, qr, att_K(F, c), att_V(F, c), c.ta0, c.ta1, c.tb0, c.tb1, c.qpos0, c.win, -MbA, lx, (bf16_t*)(F.ws + WS_MIX) + c.m0 * DM + 64 * c.hsel, DM, 0.f, 0.f, subln, pre);
        }
#pragma unroll
        for (int d = 0; d < 4; ++d) qr[d] = qn[d];
    }
}
__device__ __forceinline__ void phase_diff_combine(Frame& F) {
    const int lane = ltid() & 63;
    const int gw = F.vcu * NWAVES + F.wave;
    float s1 = inp(F, I_LQ1)[lane] * inp(F, I_LK1)[lane], s2 = inp(F, I_LQ2)[lane] * inp(F, I_LK2)[lane];
    s1 = wave_sum(s1); s2 = wave_sum(s2);
    const float lam_init = 0.8f - 0.6f * 1.0f  , lam = expf(s1) - expf(s2) + lam_init;
    const bf16_t* OB = (const bf16_t*)(F.ws + WS_OB); bf16_t* MIXp = (bf16_t*)(F.ws + WS_MIX);
    const int h = lane >> 4, d8 = (lane & 15) * 8;
    f32x4 g0 = *(const f32x4*)(inp(F, I_SUBLN) + d8), g1 = *(const f32x4*)(inp(F, I_SUBLN) + d8 + 4);
    for (int m = gw * 17; m < gw * 17 + 17; ++m) {
        const u32x4 a = *(const u32x4*)(OB + (size_t)m * DM + (2 * h) * 128 + d8), bq = *(const u32x4*)(OB + (size_t)m * DM + (2 * h + 1) * 128 + d8);
        float v[8]; float ss = 0.f;
#pragma unroll
        for (int j = 0; j < 4; ++j) { const float a0 = __builtin_bit_cast(float, a[j] << 16), a1 = __builtin_bit_cast(float, a[j] & 0xffff0000u), b0 = __builtin_bit_cast(float, bq[j] << 16), b1 = __builtin_bit_cast(float, bq[j] & 0xffff0000u);
            v[2 * j] = a0 - lam * b0; v[2 * j + 1] = a1 - lam * b1; ss += v[2 * j] * v[2 * j] + v[2 * j + 1] * v[2 * j + 1]; }
        ss += shx<1>(ss); ss += shx<2>(ss); ss += shx<4>(ss); ss += shx<8>(ss);
        const float rs = (1.0f - lam_init) / sqrtf(ss * (1.f / 128.f) + EPS);
        const f32x4 o0 = (f32x4){v[0], v[1], v[2], v[3]} * rs * g0, o1 = (f32x4){v[4], v[5], v[6], v[7]} * rs * g1;
        *(u32x4*)(MIXp + (size_t)m * DM + 512 + 128 * h + d8) = pack8(o0, o1);
    }
}

template <int ABL = 0> __device__ __forceinline__ void phase_attn_mla(Frame& F) {
    const float a = gain_absmax64(inp(F, I_QNN)), b2 = gain_absmax64(inp(F, I_QNR)), c = gain_absmax64(inp(F, I_KNN)), d = gain_absmax64(inp(F, I_KNR));
    const float Mb = 0.08838834764831845f * 64.0f * sqrtf((a * a + b2 * b2) * (c * c + d * d)) * LOG2E;
    const bf16_t* Q2 = (const bf16_t*)(F.ws + WS_Q2); bf16_t* MIXp = (bf16_t*)(F.ws + WS_MIX);
    bf16x8 qr[8];
    const auto mla_pre = [&](int i, bf16x8 (&q)[8]) { const int idx = F.vcu + 256 * i, j = idx >> 4, qb = idx & 15, b = j >> 2, h = j & 3; const size_t m0 = (size_t)b * SEQ + 256 * qb + 32 * F.wave;
        attn_pre<128, 128>(F.lds, Q2 + m0 * 512 + 128 * h, 512, F.ws + WS_KD + (size_t)(b * 4 + h) * NKT * 16384, F.ws + WS_VD + (size_t)(b * 4 + h) * NKT * 16384, 0, q); };
    mla_pre(0, qr);
    for (int i = 0; i < 2; ++i) { const int idx = F.vcu + 256 * i, j = idx >> 4, qb = idx & 15, b = j >> 2, h = j & 3;
        const size_t m0 = (size_t)b * SEQ + 256 * qb + 32 * F.wave;
        bf16x8 qn[8];
#pragma unroll
        for (int d = 0; d < 8; ++d) qn[d] = qr[d];
        const auto pre = [&]() { if (i + 1 < 2) mla_pre(i + 1, qn); };
        attn_unit<128, 128, 0, ABL, AT_KSO_MLA>(F.lds, qr, F.ws + WS_KD + (size_t)(b * 4 + h) * NKT * 16384, F.ws + WS_VD + (size_t)(b * 4 + h) * NKT * 16384,
                                   0, NKT, 0, 0, 0, 0, -Mb, 0.f, MIXp + m0 * DM + 512 + 128 * h, DM, 0.f, 0.f, (const float*)nullptr, pre);
#pragma unroll
        for (int d = 0; d < 8; ++d) qr[d] = qn[d]; }
}

__device__ __forceinline__ void phase_spatial(Frame& F) {
    const int tid = ltid(), lane = tid & 63, r32 = lane & 31, hi = lane >> 5, w = F.wave, pb = w >> 1, cb0 = 2 * (w & 1);
    const bf16_t* UACT = (const bf16_t*)(F.ws + WS_UACT); const bf16_t* VACT = (const bf16_t*)(F.ws + WS_VACT); const float* VSS = (const float*)(F.ws + WS_VSS);
    const bf16_t* WS = (const bf16_t*)(F.ws + WS_W_S); bf16_t* MIXp = (bf16_t*)(F.ws + WS_MIX);
    const float* cvn = inp(F, I_CVN); const float* cbs = inp(F, I_CBS);
    LAS float* rsl = (LAS float*)(F.lds + MISC_OFF + 1024);
    LAS float* bsl = (LAS float*)(F.lds + MISC_OFF + 2048);
    bsl[tid] = cbs[tid];
    for (int idx = F.vcu; idx < MLAT / 128; idx += F.G) {
        const size_t m0 = (size_t)idx * 128;
        if (tid < 128) { const f32x4 s0 = *(const f32x4*)(VSS + (m0 + tid) * 8), s1 = *(const f32x4*)(VSS + (m0 + tid) * 8 + 4);
            rsl[tid] = 1.0f / sqrtf((((s0[0] + s0[1]) + (s0[2] + s0[3])) + ((s1[0] + s1[1]) + (s1[2] + s1[3]))) * (1.f / 512.f) + EPS); }
        const int c8 = (tid & 63) * 8, g_ = c8 >> 7, cl = c8 & 127;
        u32x4 raw[16];
#pragma unroll
        for (int i = 0; i < 16; ++i) raw[i] = *(const u32x4*)(VACT + (m0 + w + 8 * i) * 512 + c8);
        const f32x4 g0 = *(const f32x4*)(cvn + c8), g1 = *(const f32x4*)(cvn + c8 + 4);
        const __amdgpu_buffer_rsrc_t urs = __builtin_amdgcn_make_buffer_rsrc((void*)(UACT + m0 * 512), (short)0, 128 * 512 * 2, 0x00020000), ors = __builtin_amdgcn_make_buffer_rsrc((void*)(MIXp + m0 * DM), (short)0, 128 * DM * 2, 0x00020000);
        const unsigned uoff = (unsigned)(((32 * pb + 4 * hi) * 512 + 32 * cb0 + r32) * 2), ooff = (unsigned)(((32 * pb + 4 * hi) * DM + 32 * cb0 + r32) * 2);
        unsigned short uA[32], uB[32];
#define SP_ULOAD(U, g) do { _Pragma("unroll") for (int r = 0; r < 16; ++r) _Pragma("unroll") for (int ci = 0; ci < 2; ++ci) U[r * 2 + ci] = (unsigned short)__builtin_amdgcn_raw_buffer_load_b16(urs, uoff, (((r & 3) + 8 * (r >> 2)) * 512 + 128 * (g) + 32 * ci) * 2, 0); } while (0)
        SP_ULOAD(uA, 0);
        s16x4 wA[16];
#define SP_WLOAD(Wf, g) do { const bf16_t* wrow_ = WS + ((size_t)(g) * 128 + 32 * pb + r32) * 128 + 4 * hi; _Pragma("unroll") for (int ks = 0; ks < 8; ++ks) { Wf[2 * ks] = *(const s16x4*)(wrow_ + 16 * ks); Wf[2 * ks + 1] = *(const s16x4*)(wrow_ + 16 * ks + 8); } } while (0)
        SP_WLOAD(wA, 0);
        __syncthreads();
        const lds_ptr vdst = F.lds + g_ * 32768 + (cl >> 5) * 8192 + w * 64 + (cl & 31) * 2;
#pragma unroll
        for (int i = 0; i < 16; ++i) { const float rs = rsl[w + 8 * i]; f32x4 a, bq; unpack8(raw[i], a, bq);
            *(LAS u32x4*)(vdst + (i >> 1) * 1024 + (i & 1) * 512) = pack8(a * rs * g0, bq * rs * g1); }
        __syncthreads();
#define SP_GROUP(g, UC, UN, WC, WN) do { \
            asm volatile("" ::: "memory");     \
            if ((g) < 3) { SP_ULOAD(UN, (g) + 1); } \
            asm volatile("" ::: "memory"); \
            f32x16 acc[2]; \
            _Pragma("unroll") for (int r = 0; r < 16; ++r) { acc[0][r] = 0.f; acc[1][r] = 0.f; } \
            const lds_cptr vp = (lds_cptr)F.lds + (g) * 32768 + ((lane >> 4) & 1) * 32 + (lane & 3) * 8 + (4 * hi + ((lane & 15) >> 2)) * 64; \
            _Pragma("unroll") for (int ks = 0; ks < 8; ++ks) { const s16x4 alo = WC[2 * ks], ahi = WC[2 * ks + 1]; \
                const bf16x8 af = (bf16x8){alo[0], alo[1], alo[2], alo[3], ahi[0], ahi[1], ahi[2], ahi[3]}; \
                _Pragma("unroll") for (int ci = 0; ci < 2; ++ci) { const s16x4 lo = vtr(vp + (cb0 + ci) * 8192 + ks * 1024), hh = vtr(vp + (cb0 + ci) * 8192 + ks * 1024 + 512); \
                    const bf16x8 vf = (bf16x8){lo[0], lo[1], lo[2], lo[3], hh[0], hh[1], hh[2], hh[3]}; \
                    acc[ci] = __builtin_amdgcn_mfma_f32_32x32x16_bf16(af, vf, acc[ci], 0, 0, 0); } } \
            asm volatile("" ::: "memory"); if ((g) < 3) { SP_WLOAD(WN, (g) + 1); } asm volatile("" ::: "memory"); \
            _Pragma("unroll") for (int r = 0; r < 16; ++r) { const int p = 32 * pb + crow(r, hi); const float bsv = bsl[(g) * 128 + p]; \
                _Pragma("unroll") for (int ci = 0; ci < 2; ++ci) \
                    __builtin_amdgcn_raw_buffer_store_b16((short)f2bf(bf2f(UC[r * 2 + ci]) * (acc[ci][r] + bsv)), ors, ooff, (((r & 3) + 8 * (r >> 2)) * DM + 128 * (g) + 32 * ci) * 2, 0); } } while (0)
        SP_GROUP(0, uA, uB, wA, wA); SP_GROUP(1, uB, uA, wA, wA); SP_GROUP(2, uA, uB, wA, wA); SP_GROUP(3, uB, uA, wA, wA);
#undef SP_GROUP
#undef SP_ULOAD
#undef SP_WLOAD
        __syncthreads();
    }
}

constexpr int N_PHASES = 17;
struct Args { const float* in[34]; float* out; unsigned char* ws; };
#ifndef DBG_PH_END
#define DBG_PH_END 17
#endif
#ifndef DBG_CHK
#define DBG_CHK 0
#endif
__global__ void __launch_bounds__(NTHR, 2) fwd(Args args) {
    extern __shared__ __attribute__((aligned(16))) unsigned char lds_raw[];
    const unsigned long long ts_entry_ = TS_PHASE == 119 ? __builtin_amdgcn_s_memrealtime() : 0ull; (void)ts_entry_;
    const lds_ptr lds = (lds_ptr)lds_raw;
    volatile LAS unsigned* MISC = (volatile LAS unsigned*)(lds + MISC_OFF);
    const int tid0 = threadIdx.x;
    if (tid0 == 0) {
#pragma unroll
        for (int i = 0; i < 34; ++i) ((LAS unsigned long long*)(lds + PTR_OFF))[i] = (unsigned long long)args.in[i];
        ((LAS unsigned long long*)(lds + PTR_OFF))[34] = (unsigned long long)args.ws; ((LAS unsigned long long*)(lds + PTR_OFF))[35] = (unsigned long long)args.out; }
    for (int u = tid0; u < 128; u += NTHR) MISC[u] = 0u;
    LAS f32x2* T = (LAS f32x2*)(lds + ROPE_OFF);
    for (int e = tid0; e < 1024; e += NTHR) { const int pos = e >> 4, fi = e & 15; const float inv = powf(10000.f, -(float)fi / 16.f), ang = (float)pos * inv; T[e] = (f32x2){cosf(ang), sinf(ang)}; }
    __syncthreads();
#if DBG_CHK
    { XcdBarrier b0 = xcd_barrier_post((unsigned*)(args.ws + WS_CTL) + CW_BAR, MISC + 8); (void)b0; }
#else
    if (blockIdx.x == 0) for (int u = tid0; u < XCD_BAR_WORDS; u += NTHR) __hip_atomic_store((unsigned*)(args.ws + WS_CTL) + CW_BAR + u, 0u, __ATOMIC_RELAXED, __HIP_MEMORY_SCOPE_AGENT);
#endif
#if GS_AT_START && !DBG_CHK
    cooperative_groups::this_grid().sync();
    { XcdBarrier b0 = xcd_barrier_post((unsigned*)(args.ws + WS_CTL) + CW_BAR, MISC + 8); (void)b0; }
#endif
    constexpr int lo = 0, hi = DBG_PH_END;
#ifndef PH_MASK
#define PH_MASK 0x1ffff
#endif
#define IN(k) (((PH_MASK >> (k)) & 1) && lo <= (k) && (k) < hi)
#ifndef TS_PHASE
#define TS_PHASE -1
#endif
#ifndef TS_BLOCK
#define TS_BLOCK 0
#endif
#define TSTAMP(k) do { if (TS_PHASE >= 0 && ((TS_PHASE == 99 && ((k) == -1 || (k) == 16)) || (TS_PHASE >= 100 && TS_PHASE < 110 && (k) == 11) || ((k) + 1 >= TS_PHASE && (k) <= TS_PHASE)) && blockIdx.x == TS_BLOCK && threadIdx.x == 0) ((volatile LAS unsigned long long*)(lds + MISC_OFF + 256))[(k) + 1] = TS_CLK ? __builtin_amdgcn_s_memtime() : __builtin_amdgcn_s_memrealtime(); } while (0)
#define SUBTS(i) do { if (TS_PHASE >= 100 && TS_PHASE < 110 && blockIdx.x == TS_BLOCK && threadIdx.x == 0) ((volatile LAS unsigned long long*)(lds + MISC_OFF + 256))[(i)] = __builtin_amdgcn_s_memrealtime(); } while (0)
#define SEAM(k) do { const unsigned long long tsm0_ = (TS_PHASE >= 115 && TS_PHASE <= 118) ? __builtin_amdgcn_s_memrealtime() : 0ull; if (IN(k) && IN((k) + 1)) { if ((k) == 0 && DBG_CHK == 0 && !GS_AT_START) cooperative_groups::this_grid().sync(); else { XcdBarrier bar; bar.bar = (unsigned*)(mkframe().ws + WS_CTL) + CW_BAR; bar.x = xb_xcc_id(); bar.st = (volatile LAS unsigned*)(lds + MISC_OFF) + 8; xcd_barrier(bar); } } asm volatile("" ::: "memory"); if ((TS_PHASE == 115 || (TS_PHASE == 116 && (k) != 0)) && blockIdx.x == TS_BLOCK && threadIdx.x == 0) ((volatile LAS unsigned long long*)(lds + MISC_OFF + 256))[19] += __builtin_amdgcn_s_memrealtime() - tsm0_; if ((TS_PHASE == 117 || TS_PHASE == 118) && (k) >= TS_SEAM_LO && (k) <= TS_SEAM_HI && (k) != TS_SEAM_SKIP && blockIdx.x == TS_BLOCK && threadIdx.x == 0) { volatile LAS unsigned long long* ts_ = (volatile LAS unsigned long long*)(lds + MISC_OFF + 256); const unsigned long long w_ = __builtin_amdgcn_s_memrealtime() - tsm0_; if (w_ > ts_[18]) { ts_[18] = w_; ts_[20] = (unsigned long long)((k) - TS_SEAM_LO + 1); } } } while (0)
#ifndef PH_REP
#define PH_REP 0
#endif
#define REPBAR() do { XcdBarrier bar; bar.bar = (unsigned*)(mkframe().ws + WS_CTL) + CW_BAR; bar.x = xb_xcc_id(); bar.st = (volatile LAS unsigned*)(lds + MISC_OFF) + 8; xcd_barrier(bar); asm volatile("" ::: "memory"); } while (0)
#define FRAME() Frame F = mkframe(); const float* MOD = (const float*)(F.ws + WS_MOD); bf16_t* XR = (bf16_t*)(F.ws + WS_XR); const bf16_t* HN = (const bf16_t*)(F.ws + WS_HN); (void)MOD; (void)XR; (void)HN

    TSTAMP(-1);
    if (TS_PHASE == 119 && blockIdx.x == TS_BLOCK && threadIdx.x == 0) ((volatile LAS unsigned long long*)(lds + MISC_OFF + 256))[21] = __builtin_amdgcn_s_memrealtime() - ts_entry_;
    if (IN(0)) for (int rep_ = 0; rep_ <= ((PH_REP >> (0)) & 1); ++rep_) { if (rep_) REPBAR(); FRAME(); p0_prologue(F); }
    SEAM(0); TSTAMP(0);
#if !DBG_CHK && !GS_AT_START
    { XcdBarrier b0 = xcd_barrier_post((unsigned*)(args.ws + WS_CTL) + CW_BAR, MISC + 8); (void)b0; }
#endif
    if (IN(1)) for (int rep_ = 0; rep_ <= ((PH_REP >> (1)) & 1); ++rep_) { if (rep_) REPBAR(); FRAME(); mod_reduce(F); REPBAR();
        ln_phase<false>(F, 0, 0, inp(F, I_N1G), inp(F, I_X), inp(F, I_CTX), MALL, false, XR + (size_t)MLAT * DM); }
    SEAM(1); TSTAMP(1);
    if (IN(2)) for (int rep_ = 0; rep_ <= ((PH_REP >> (2)) & 1); ++rep_) { if (rep_) REPBAR(); FRAME(); Gemm g{HN, (const bf16_t*)(F.ws + WS_W_EV), MALL, 2304, DM}; pg8::StaticOrder S; S.init(MALL, 2304, F.G, obx());
        EpiEven E{F.ws, F.lds, 0.125f * LOG2E};
        pg8::gemm_phase<EpiEven, pg8::StaticOrder, PG8_ALIGN, PG8_SP2>(F.lds, g, S, E); }
    SEAM(2); TSTAMP(2);
    if (IN(3)) for (int rep_ = 0; rep_ <= ((PH_REP >> (3)) & 1); ++rep_) { if (rep_) REPBAR(); FRAME(); phase_attn_even(F); }
    SEAM(3); TSTAMP(3); TSTAMP(4);
    if (IN(5)) for (int rep_ = 0; rep_ <= ((PH_REP >> (5)) & 1); ++rep_) { if (rep_) REPBAR(); FRAME(); Gemm g{(const bf16_t*)(F.ws + WS_MIX), (const bf16_t*)(F.ws + WS_W_MIX), MALL, DM, DM}; SplitOrder S; S.init(DM, F.G, obx());
        EpiResid<false, true> E{inp(F, I_X), inp(F, I_CTX), XR, XR + (size_t)MLAT * DM, MOD + 2 * DM, (float*)(F.ws + WS_PART)};
        pg8::gemm_phase<EpiResid<false, true>, SplitOrder, PG8_ALIGN, PG8_SP2>(F.lds, g, S, E); }
    SEAM(5); TSTAMP(5);
    if (IN(6)) for (int rep_ = 0; rep_ <= ((PH_REP >> (6)) & 1); ++rep_) { if (rep_) REPBAR(); FRAME(); ln_phase<true>(F, 0, 3, inp(F, I_N2G), XR, XR + (size_t)MLAT * DM, MALL, false, XR + (size_t)MLAT * DM, (const float*)(F.ws + WS_PART)); }
    SEAM(6); TSTAMP(6);
    if (IN(7)) for (int rep_ = 0; rep_ <= ((PH_REP >> (7)) & 1); ++rep_) { if (rep_) REPBAR(); FRAME(); Gemm g{HN, (const bf16_t*)(F.ws + WS_W_FI), MALL, 2 * FFH, DM}; pg8::StaticOrder S; S.init(MALL, 2 * FFH, F.G, obx());
        EpiSwiglu E{(bf16_t*)(F.ws + WS_ACT)};
        pg8::gemm_phase<EpiSwiglu, pg8::StaticOrder, PG8_ALIGN, PG8_SP2>(F.lds, g, S, E); }
    SEAM(7); TSTAMP(7);
    if (IN(8)) for (int rep_ = 0; rep_ <= ((PH_REP >> (8)) & 1); ++rep_) { if (rep_) REPBAR(); FRAME(); int KF = FFH; asm volatile("" : "+s"(KF));
        Gemm g{(const bf16_t*)(F.ws + WS_ACT), (const bf16_t*)(F.ws + WS_W_FO), MALL, DM, KF}; SplitOrder S; S.init(KF, F.G, obx());
        EpiResid<true, true> E{XR, XR + (size_t)MLAT * DM, XR, XR + (size_t)MLAT * DM, MOD + 5 * DM, (float*)(F.ws + WS_PART)};
        pg8::gemm_phase<EpiResid<true, true>, SplitOrder, PG8_ALIGN, PG8_SP2>(F.lds, g, S, E); }
    SEAM(8); TSTAMP(8);
    if (IN(9)) for (int rep_ = 0; rep_ <= ((PH_REP >> (9)) & 1); ++rep_) { if (rep_) REPBAR(); FRAME(); ln_phase<true>(F, 1, 0, inp(F, I_N1G) + DM, XR, XR + (size_t)MLAT * DM, MALL, false, XR + (size_t)MLAT * DM, (const float*)(F.ws + WS_PART)); }
    SEAM(9); TSTAMP(9);
    if (IN(10)) for (int rep_ = 0; rep_ <= ((PH_REP >> (10)) & 1); ++rep_) { if (rep_) REPBAR(); FRAME(); Gemm g{HN, (const bf16_t*)(F.ws + WS_W_OD), MALL, 1792, DM}; OddOrder S; S.init(F.G, obx());
        EpiOdd E{F.ws, F.lds};
        pg8::gemm_phase<EpiOdd, OddOrder, PG8_ALIGN, PG8_SP2>(F.lds, g, S, E); }
    SEAM(10); TSTAMP(10);
    if (IN(11)) for (int rep_ = 0; rep_ <= ((PH_REP >> (11)) & 1); ++rep_) { if (rep_) REPBAR(); FRAME();
        int K256 = 256; asm volatile("" : "+s"(K256));
        SUBTS(20);
        { Gemm g{(const bf16_t*)(F.ws + WS_CQ), (const bf16_t*)(F.ws + WS_W_UQ), MLAT + MALL, 1280, K256}; UqkvOrder S; S.init(F.G, obx());
          EpiUqkv E{EpiUq{F.ws, F.lds, 0.08838834764831845f * LOG2E}, EpiUkv{F.ws, F.lds}};
          pg8::gemm_phase<EpiUqkv, UqkvOrder, PG8_ALIGN, PG8_SP2>(F.lds, g, S, E); }
        SUBTS(21);
        SUBTS(22);
        phase_spatial(F);
        SUBTS(23);
        if ((PH_REP >> 17) & 1) { REPBAR(); phase_spatial(F); }
        if ((PH_REP >> 18) & 1) { REPBAR();
          { Gemm g{(const bf16_t*)(F.ws + WS_CQ), (const bf16_t*)(F.ws + WS_W_UQ), MLAT, 512, K256}; pg8::StaticOrder S; S.init(MLAT, 512, F.G, obx()); EpiUq E{F.ws, F.lds, 0.08838834764831845f * LOG2E}; pg8::gemm_phase<EpiUq, pg8::StaticOrder, PG8_ALIGN, PG8_SP2>(F.lds, g, S, E); }
          { Gemm g{(const bf16_t*)(F.ws + WS_CKV), (const bf16_t*)(F.ws + WS_W_UKV), MALL, 768, K256}; pg8::StaticOrder S; S.init(MALL, 768, F.G, obx()); EpiUkv E{F.ws, F.lds}; pg8::gemm_phase<EpiUkv, pg8::StaticOrder, PG8_ALIGN, PG8_SP2>(F.lds, g, S, E); } }
        if ((PH_REP >> 19) & 1) { REPBAR();
          { Gemm g{(const bf16_t*)(F.ws + WS_CQ), (const bf16_t*)(F.ws + WS_W_UQ), MLAT, 512, K256}; pg8::StaticOrder S; S.init(MLAT, 512, F.G, obx()); EpiNull E; pg8::gemm_phase<EpiNull, pg8::StaticOrder, PG8_ALIGN, PG8_SP2>(F.lds, g, S, E); }
          { Gemm g{(const bf16_t*)(F.ws + WS_CKV), (const bf16_t*)(F.ws + WS_W_UKV), MALL, 768, K256}; pg8::StaticOrder S; S.init(MALL, 768, F.G, obx()); EpiNull E; pg8::gemm_phase<EpiNull, pg8::StaticOrder, PG8_ALIGN, PG8_SP2>(F.lds, g, S, E); } }
    }
    SEAM(11); TSTAMP(11);
#if AT_ABL
    if (IN(12)) { FRAME(); phase_attn_mla<AT_ABL>(F); REPBAR(); if (blockIdx.x == TS_BLOCK && threadIdx.x == 0) ((volatile LAS unsigned long long*)(lds + MISC_OFF + 256))[13] = __builtin_amdgcn_s_memrealtime(); phase_attn_mla<0>(F); }
    SEAM(12);
#else
    if (IN(12)) for (int rep_ = 0; rep_ <= ((PH_REP >> (12)) & 1); ++rep_) { if (rep_) REPBAR(); FRAME(); phase_attn_mla<0>(F); }
    SEAM(12); TSTAMP(12);
#endif
    if (IN(13)) for (int rep_ = 0; rep_ <= ((PH_REP >> (13)) & 1); ++rep_) { if (rep_) REPBAR(); FRAME(); Gemm g{(const bf16_t*)(F.ws + WS_MIX), (const bf16_t*)(F.ws + WS_W_MIX + 2 * MiB), MLAT, DM, DM}; pg8::StaticOrder S; S.init(MLAT, DM, F.G, obx());
        EpiResid<true, true> E{XR, XR, XR, XR, MOD + 9 * 6144 + 2 * DM, nullptr};
        pg8::gemm_phase<EpiResid<true, true>, pg8::StaticOrder, PG8_ALIGN, PG8_SP2>(F.lds, g, S, E); }
    SEAM(13); TSTAMP(13);
    if (IN(14)) for (int rep_ = 0; rep_ <= ((PH_REP >> (14)) & 1); ++rep_) { if (rep_) REPBAR(); FRAME(); ln_phase<true>(F, 1, 3, inp(F, I_N2G) + DM, XR, XR, MLAT, false); }
    SEAM(14); TSTAMP(14);
    if (IN(15)) for (int rep_ = 0; rep_ <= ((PH_REP >> (15)) & 1); ++rep_) { if (rep_) REPBAR(); FRAME(); Gemm g{HN, (const bf16_t*)(F.ws + WS_W_FI + 11 * MiB), MLAT, 2 * FFH, DM}; pg8::StaticOrder S; S.init(MLAT, 2 * FFH, F.G, obx());
        EpiSwiglu E{(bf16_t*)(F.ws + WS_ACT)};
        pg8::gemm_phase<EpiSwiglu, pg8::StaticOrder, PG8_ALIGN, PG8_SP2>(F.lds, g, S, E); }
    SEAM(15); TSTAMP(15);
    if (IN(16)) for (int rep_ = 0; rep_ <= ((PH_REP >> (16)) & 1); ++rep_) { if (rep_) REPBAR(); FRAME(); Gemm g{(const bf16_t*)(F.ws + WS_ACT), (const bf16_t*)(F.ws + WS_W_FO + 6 * MiB), MLAT, DM, FFH}; pg8::StaticOrder S; S.init(MLAT, DM, F.G, obx());
        EpiResid<true, false> E{XR, XR, F.out, F.out, MOD + 9 * 6144 + 5 * DM, nullptr};
        pg8::gemm_phase<EpiResid<true, false>, pg8::StaticOrder, PG8_ALIGN, PG8_SP2>(F.lds, g, S, E); }
    if (TS_PHASE >= 0) { TSTAMP(16); REPBAR();
        if (blockIdx.x == TS_BLOCK && threadIdx.x == 0) { volatile LAS unsigned long long* ts = (volatile LAS unsigned long long*)(lds + MISC_OFF + 256); const float us = TS_PHASE == 119 ? (float)ts[21] * 0.01f : TS_PHASE == 118 ? (float)ts[18] * 0.1f : TS_PHASE == 117 ? ((float)ts[20] * 10.f + fminf((float)ts[18] * 0.001f, 9.f)) * 100.f : TS_PHASE == 113 ? (float)ts[29] * 0.1f : (TS_PHASE == 115 || TS_PHASE == 116) ? (float)ts[19] * 0.01f : TS_PHASE == 110 ? (float)ts[28] * 0.1f : TS_PHASE == 111 ? (float)ts[29] * 0.01f : TS_PHASE == 112 ? (float)ts[30] * 0.01f : TS_PHASE == 105 ? (float)ts[24] * 0.1f : TS_PHASE == 106 ? (float)ts[25] * 0.01f : TS_PHASE == 107 ? (float)ts[26] * 0.1f : TS_PHASE == 108 ? (float)ts[27] * 10.f : TS_PHASE == 99 ? (float)(ts[17] - ts[0]) * 0.01f - 2000.f : TS_PHASE == 101 ? (float)(ts[21] - ts[20]) * 0.1f : TS_PHASE == 102 ? (float)(ts[22] - ts[21]) * 0.1f : TS_PHASE == 103 ? (float)(ts[23] - ts[22]) * 0.1f : TS_PHASE == 104 ? (float)(ts[12] - ts[23]) * 0.1f : (float)(ts[TS_PHASE < 100 ? TS_PHASE + 1 : 0] - ts[TS_PHASE < 100 ? TS_PHASE : 0]) * 0.01f; mkframe().out[0] += (us - (float)TS_SUB) * 0.01f * TS_SCALE; } }
#undef IN
#undef SEAM
#undef FRAME
}
}

#ifndef DBG_CHK
#define DBG_CHK 0
#endif
#ifndef DBG_PH_END
#define DBG_PH_END 17
#endif

#if DBG_CHK
namespace dbg {
using namespace mk;
constexpr int RS = 3, NRS = (nv::R + RS - 1) / RS;
__device__ __forceinline__ size_t mrow(int r) { return r < 4096 ? (size_t)r : (size_t)MLAT + (r - 4096); }
__device__ __forceinline__ float kimg_get(const unsigned char* base, int slot_bytes, int bh, int r, int d) {
    const int kt = r >> 6, kk = r & 63; const unsigned char* img = base + ((size_t)bh * NKT + kt) * slot_bytes; return bf2f(*(const bf16_t*)(img + (d >> 3) * 1024 + kk * 16 + (d & 7) * 2)); }
__device__ __forceinline__ float vimg_get(const unsigned char* base, int slot_bytes, int bh, int r, int dv) {
    const int kt = r >> 6, kk = r & 63; const unsigned char* img = base + ((size_t)bh * NKT + kt) * slot_bytes; return bf2f(*(const bf16_t*)(img + (dv >> 5) * 4096 + (kk >> 4) * 1024 + (kk & 15) * 64 + (dv & 31) * 2)); }
template <int CHK> __device__ __forceinline__ int ncols() { return CHK == 2 ? 2304 : CHK == 6 ? 2048 : 1024; }
template <int CHK> __global__ void k_snap(const unsigned char* ws, float* SNAP) {
    const int NC = ncols<CHK>(); const size_t idx = (size_t)blockIdx.x * 256 + threadIdx.x; if (idx >= (size_t)NRS * NC) return;
    const int rs = (int)(idx / NC), c = (int)(idx % NC), r = rs * RS; const size_t m = mrow(r); float v = 0.f;
    if (CHK == 1) v = bf2f(((const bf16_t*)(ws + WS_HN))[m * DM + c]);
    else if (CHK == 2) {
        if (c < 1024) v = bf2f(((const bf16_t*)(ws + WS_Q))[m * DM + c]) / (0.125f * LOG2E);
        else if (c < 1152) v = kimg_get(ws + WS_KA, 8192, (c - 1024) >> 6, r, c & 63);
        else if (c < 1280) v = vimg_get(ws + WS_VA, 8192, (c - 1152) >> 6, r, c & 63);
        else if (c < 1792) v = kimg_get(ws + WS_KB, 8192, (c - 1280) >> 6, r, c & 63);
        else v = vimg_get(ws + WS_VB, 16384, (c - 1792) >> 7, r, (c - 1792) & 127);
    } else if (CHK == 3 || CHK == 7) v = bf2f(((const bf16_t*)(ws + WS_MIX))[m * DM + c]);
    else if (CHK == 4 || CHK == 5) v = bf2f(((const bf16_t*)(ws + WS_XR))[m * DM + c]);
    else if (CHK == 6) {
        if (c < 512) v = r < 4096 ? bf2f(((const bf16_t*)(ws + WS_Q2))[m * 512 + c]) / (0.08838834764831845f * LOG2E) : 0.f;
        else if (c < 1024) v = kimg_get(ws + WS_KD, 16384, (c - 512) >> 7, r, (c - 512) & 127);
        else if (c < 1536) v = vimg_get(ws + WS_VD, 16384, (c - 1024) >> 7, r, (c - 1024) & 127);
        else v = r < 4096 ? bf2f(((const bf16_t*)(ws + WS_MIX))[m * DM + (c - 1536)]) : 0.f;
    }
    SNAP[idx] = v;
}
template <int CHK> __global__ void k_cmp(nv::Bufs B, const float* SNAP, unsigned* res) {
    const int NC = ncols<CHK>(); const size_t idx = (size_t)blockIdx.x * 256 + threadIdx.x; if (idx >= (size_t)NRS * NC) return;
    const int rs = (int)(idx / NC), c = (int)(idx % NC), r = rs * RS; float ref = 0.f; bool skip = false;
    if (CHK == 1) ref = B.H[(size_t)r * 1024 + c];
    else if (CHK == 2) ref = B.PL[(size_t)r * 2304 + c];
    else if (CHK == 3) ref = B.MIX[(size_t)r * 1024 + c];
    else if (CHK == 7) { ref = B.MIX[(size_t)r * 1024 + c]; skip = r >= 4096; }
    else if (CHK == 4 || CHK == 5) ref = B.X[(size_t)r * 1024 + c];
    else if (CHK == 6) {
        if (c < 512) { ref = B.QU[(size_t)r * 512 + c]; skip = r >= 4096; }
        else if (c < 1024) ref = B.KC[(size_t)r * 512 + (c - 512)];
        else if (c < 1536) { const int h = (c - 1024) >> 7, dv = (c - 1024) & 127; ref = B.KVU[(size_t)r * 768 + h * 192 + 64 + dv]; }
        else { ref = B.MIX[(size_t)r * 1024 + (c - 1536)]; skip = r >= 4096; }
    }
    if (skip) return;
    const float d = fabsf(ref - SNAP[idx]);
    atomicMax(res + 0, __float_as_uint(d == d ? d : INFINITY)); atomicMax(res + 1, __float_as_uint(fabsf(ref)));
}
__global__ void k_cmp_mod(const float* modA, const float* modB, unsigned* res) {
    const int idx = blockIdx.x * 256 + threadIdx.x; if (idx >= 2 * 9 * 6144) return;
    const float d = fabsf(modA[idx] - modB[idx]); atomicMax(res + 0, __float_as_uint(d == d ? d : INFINITY)); atomicMax(res + 1, __float_as_uint(fabsf(modA[idx])));
}
__global__ void k_code(float* out, size_t n, const unsigned* res, float thresh) {
    const float md = __uint_as_float(res[0]), mr = __uint_as_float(res[1]); const float rel = md / fmaxf(mr, 1e-20f);
    float code = 0.f; if (!(rel <= thresh)) code = 10.f + log10f(fminf(fmaxf(rel, 1e-9f), 1e9f));
    if (mr == 0.f) code = 77.f;
    if (code == 0.f) return;
    for (size_t i = (size_t)blockIdx.x * 256 + threadIdx.x; i < n; i += (size_t)gridDim.x * 256) out[i] += code;
}
static float* g_snap; static unsigned* g_res; static const float* g_mod_mk;
static void hook(int k, const nv::Bufs& B, hipStream_t st) {
    if (k != DBG_CHK) return;
    const size_t n = (size_t)NRS * (DBG_CHK == 2 ? 2304 : DBG_CHK == 6 ? 2048 : 1024);
    hipLaunchKernelGGL(k_cmp<DBG_CHK>, dim3((unsigned)((n + 255) / 256)), dim3(256), 0, st, B, (const float*)g_snap, g_res);
    if (DBG_CHK == 1) hipLaunchKernelGGL(k_cmp_mod, dim3((2 * 9 * 6144 + 255) / 256), dim3(256), 0, st, (const float*)B.MOD, g_mod_mk, g_res);
}
}
#endif

extern "C" void kernel_launch(void* const* d_in, const int* in_sizes, int n_in, void* d_out, int out_size, void* d_ws, size_t ws_size, hipStream_t stream) {
    static int grid = 0;
    if (grid == 0) {
        int dev = 0, cus = 0, per_cu = 0;
        hipGetDevice(&dev); hipDeviceGetAttribute(&cus, hipDeviceAttributeMultiprocessorCount, dev);
        if (hipFuncSetAttribute((const void*)mk::fwd, hipFuncAttributeMaxDynamicSharedMemorySize, mk::LDS_BYTES) != hipSuccess) fprintf(stderr, "kernel_launch: hipFuncSetAttribute failed\n");
        if (hipOccupancyMaxActiveBlocksPerMultiprocessor(&per_cu, (const void*)mk::fwd, mk::NTHR, mk::LDS_BYTES) != hipSuccess || per_cu < 1) { fprintf(stderr, "kernel_launch: occupancy query says %d\n", per_cu); per_cu = 1; }
        (void)hipGetLastError();
        grid = cus * per_cu;
        if (grid != 256) fprintf(stderr, "kernel_launch: grid %d (cus %d x %d) != 256: the static work split assumes 256 workgroups\n", grid, cus, per_cu);
        if (n_in != 34 || ws_size < mk::WS_END) fprintf(stderr, "kernel_launch: unexpected n_in %d / ws_size %zu\n", n_in, ws_size);
    }
#if DBG_CHK
    hipMemsetAsync((char*)d_ws + mk::WS_CTL, 0, mk::CTL_ZERO_BYTES, stream);
#endif
    mk::Args a{};
    for (int i = 0; i < 34; ++i) a.in[i] = (const float*)d_in[i];
    a.out = (float*)d_out; a.ws = (unsigned char*)d_ws;
#if DBG_CHK
    {
        hipLaunchKernelGGL(mk::fwd, dim3(grid), dim3(mk::NTHR), mk::LDS_BYTES, stream, a);
        float* SNAP = (float*)((char*)d_ws + mk::WS_SNAP); unsigned* res = (unsigned*)((char*)d_ws + mk::WS_END - 4096);
        const size_t n = (size_t)dbg::NRS * (DBG_CHK == 2 ? 2304 : DBG_CHK == 6 ? 2048 : 1024);
        hipLaunchKernelGGL(dbg::k_snap<DBG_CHK>, dim3((unsigned)((n + 255) / 256)), dim3(256), 0, stream, (const unsigned char*)d_ws, SNAP);
        float* modc = (float*)((char*)d_ws + mk::WS_END - 1024 * 1024);
        hipMemcpyAsync(modc, (char*)d_ws + mk::WS_MOD, 2 * 9 * 6144 * 4, hipMemcpyDeviceToDevice, stream);
        hipMemsetAsync(res, 0, 64, stream);
        dbg::g_snap = SNAP; dbg::g_res = res; dbg::g_mod_mk = modc;
        nv::In I; const float** ip = (const float**)&I; for (int i = 0; i < 34; ++i) ip[i] = (const float*)d_in[i];
        nv::forward(I, (float*)d_out, (float*)d_ws, 0, 8, stream, dbg::hook);
        hipLaunchKernelGGL(dbg::k_code, dim3(1024), dim3(256), 0, stream, (float*)d_out, (size_t)out_size, (const unsigned*)res, 0.03f);
    }
#else
    void* args[] = {&a};
    hipError_t e = hipLaunchCooperativeKernel((const void*)mk::fwd, dim3(grid), dim3(mk::NTHR), args, mk::LDS_BYTES, stream);
    if (e != hipSuccess) fprintf(stderr, "kernel_launch: cooperative launch failed: %s (grid %d)\n", hipGetErrorString(e), grid);
#endif
}
```

```cpp
#define DBG_CHK 0
#define DBG_PH_END 17
#include <hip/hip_runtime.h>
#include <cstdio>
#include <cstdint>
#ifndef TS_PHASE
#define TS_PHASE -1
#endif
#ifndef TS_BLOCK
#define TS_BLOCK 0
#endif
#define TS_GEMM (TS_PHASE >= 110 && TS_PHASE <= 114)
#ifndef TS_GEMM_ID
#define TS_GEMM_ID -1
#endif
#ifndef PG8_PRIO
#define PG8_PRIO 1
#endif
#ifndef PG8_WGM
#define PG8_WGM 8
#endif
namespace pg8 {
#define PG8_LAS __attribute__((address_space(3)))
typedef unsigned short bf16_t;
typedef short bf16x8 __attribute__((ext_vector_type(8)));
typedef float f32x4 __attribute__((ext_vector_type(4)));
typedef unsigned u32x4 __attribute__((ext_vector_type(4)));
constexpr int BM = 256, BK = 64, HALF = 128, HTB = HALF * BK * 2  , STAGE_BYTES = 8 * HTB, NXCD = 8, WGM = PG8_WGM;

__host__ __device__ __forceinline__ int lds_byte(int r, int c) { const int st = (r >> 4) * 2 + (c >> 5), rr = r & 15, cc = c & 31, ob = rr * 64 + cc * 2; return st * 1024 + (ob ^ (((ob >> 9) & 1) << 5)); }
__host__ __device__ __forceinline__ void stage_rc(int b, int& R, int& C) { const int st = b / 1024, sb = b % 1024, swz = sb ^ (((sb >> 9) & 1) << 5); R = (st >> 1) * 16 + swz / 64; C = (st & 1) * 32 + (swz % 64) / 2; }
__host__ __device__ __forceinline__ int perm32(int rho) { const int n = rho >> 4, i = rho & 15; return 8 * (i >> 2) + 4 * n + (i & 3); }

struct Unit { int pm, pn, k0, nt, aux; };
struct Gemm { const bf16_t* A; const bf16_t* Bt; int M, N, K; };

struct StaticOrder {
    int nM, nN, nwg, G, c;
    __host__ __device__ void init(int M, int N, int G_, int c_) { nM = M / BM; nN = N / BM; nwg = nM * nN; G = G_; c = c_; }
    __host__ __device__ bool next(int i, Unit& u) const {
        const long L = (long)i * G + c; if (L >= nwg) return false;
        int wgid = (int)L; { const int q = nwg / NXCD, r = nwg % NXCD, xcd = wgid % NXCD, off = wgid / NXCD; wgid = (xcd < r ? xcd * (q + 1) : r * (q + 1) + (xcd - r) * q) + off; }
        const int nig = WGM * nN, gid = wgid / nig, fm = gid * WGM, gsz = (nM - fm) < WGM ? (nM - fm) : WGM;
        u.pm = fm + ((wgid % nig) % gsz); u.pn = (wgid % nig) / gsz; u.k0 = 0; u.nt = 0; u.aux = 0; return true;
    }
    __device__ __forceinline__ void a_ready(const Unit&) const {}
    __device__ __forceinline__ void done(const Unit&) const {}
};

__device__ __forceinline__ unsigned cvt_pk_bf16(float lo, float hi) { unsigned r; asm volatile("v_cvt_pk_bf16_f32 %0, %1, %2" : "=v"(r) : "v"(lo), "v"(hi)); return r; }
typedef float f32x2 __attribute__((ext_vector_type(2)));
__device__ __forceinline__ f32x2 gelu_pk(f32x2 v) {
    const f32x2 av = __builtin_elementwise_abs(v), d = av * 0.2316418882f + 1.0f;
    f32x2 t; t.x = __builtin_amdgcn_rcpf(d.x); t.y = __builtin_amdgcn_rcpf(d.y);
    f32x2 q = t * 0.5307027145f + (-0.7265760135f); q = q * t + 0.7107068705f; q = q * t + (-0.142248368f); q = q * t + 0.127414796f; q = q * t;
    const f32x2 s = (v * v) * (-0.72134752044f);
    f32x2 e; e.x = __builtin_amdgcn_exp2f(s.x); e.y = __builtin_amdgcn_exp2f(s.y);
    const f32x2 m = v * (q * e), r = v - m;
    f32x2 o; o.x = v.x < 0.f ? m.x : r.x; o.y = v.y < 0.f ? m.y : r.y; return o;
}

template <int ACT  > struct EpiBf16 {
    static constexpr bool PERM = true, AFTER_DRAIN = false; static_assert(ACT == 0 || ACT == 1, "EpiBf16: ACT is 0 (none) or 1 (gelu_pk)");
    bf16_t* O; int ldc; const float* bias; int split_cols; size_t split_stride; float scale0;
    __device__ __forceinline__ void operator()(const f32x4 (&acc)[2][2][4][2], const Unit& u, int wr, int wc, int fr, int fq) const {
        const int row0 = u.pm * BM + wr * 64 + fr; int colt = u.pn * BM; bf16_t* base = O;
        float sc = 1.f; if (split_cols) { const int t = colt / split_cols; base += (size_t)t * split_stride; colt -= t * split_cols; if (t == 0) sc = scale0; }
        const int col0 = colt + wc * 32 + 8 * fq, bcol0 = u.pn * BM + wc * 32 + 8 * fq;
        f32x4 bv[2][2];
#pragma unroll
        for (int bj = 0; bj < 2; ++bj)
#pragma unroll
            for (int n = 0; n < 2; ++n) bv[bj][n] = bias ? *(const f32x4*)(bias + bcol0 + bj * HALF + 4 * n) : (f32x4){0.f, 0.f, 0.f, 0.f};
#pragma unroll
        for (int ai = 0; ai < 2; ++ai)
#pragma unroll
            for (int m = 0; m < 4; ++m) { bf16_t* rowp = base + (size_t)(row0 + ai * HALF + m * 16) * ldc + col0;
#pragma unroll
                for (int bj = 0; bj < 2; ++bj) { f32x4 v0 = acc[ai][bj][m][0] + bv[bj][0], v1 = acc[ai][bj][m][1] + bv[bj][1];
                    if (ACT == 1) { f32x2 a = gelu_pk((f32x2){v0[0], v0[1]}), b = gelu_pk((f32x2){v0[2], v0[3]}), c = gelu_pk((f32x2){v1[0], v1[1]}), d = gelu_pk((f32x2){v1[2], v1[3]});
                        v0 = (f32x4){a.x, a.y, b.x, b.y}; v1 = (f32x4){c.x, c.y, d.x, d.y}; }
                    v0 = v0 * sc; v1 = v1 * sc; u32x4 w; w.x = cvt_pk_bf16(v0[0], v0[1]); w.y = cvt_pk_bf16(v0[2], v0[3]); w.z = cvt_pk_bf16(v1[0], v1[1]); w.w = cvt_pk_bf16(v1[2], v1[3]);
                    *(u32x4*)(rowp + bj * HALF) = w; } }
    }
};

struct PanelStats {
    unsigned* xbuf;
    unsigned* cnt;
    unsigned* tmo;
    int ntn; float eps;
    unsigned code;
    __device__ __forceinline__ bool run(const f32x4 (&v)[2][2][4][2], const Unit& u, int wr, int wc, int fr, int fq, PG8_LAS unsigned char* lds, int wid, int lane) const {
        typedef float f32x2v __attribute__((ext_vector_type(2)));
        PG8_LAS f32x2v* P = (PG8_LAS f32x2v*)lds;
        PG8_LAS f32x2v* S = (PG8_LAS f32x2v*)(lds + 8192);
        PG8_LAS unsigned* flag = (PG8_LAS unsigned*)(lds + 8192 + 2048);
#pragma unroll
        for (int ai = 0; ai < 2; ++ai)
#pragma unroll
            for (int m = 0; m < 4; ++m) {
                float s = 0.f;
#pragma unroll
                for (int bj = 0; bj < 2; ++bj)
#pragma unroll
                    for (int n = 0; n < 2; ++n) { const f32x4 x = v[ai][bj][m][n]; s += (x[0] + x[1]) + (x[2] + x[3]); }
                s += __shfl_xor(s, 16); s += __shfl_xor(s, 32);
                const float mw = s * (1.0f / 64.0f); float q = 0.f;
#pragma unroll
                for (int bj = 0; bj < 2; ++bj)
#pragma unroll
                    for (int n = 0; n < 2; ++n) { const f32x4 d = v[ai][bj][m][n] - mw; q += (d[0] * d[0] + d[1] * d[1]) + (d[2] * d[2] + d[3] * d[3]); }
                q += __shfl_xor(q, 16); q += __shfl_xor(q, 32);
                if (fq == 0) P[(ai * HALF + wr * 64 + m * 16 + fr) * 4 + wc] = (f32x2v){mw, q};
            }
        asm volatile("s_waitcnt lgkmcnt(0)" ::: "memory"); __builtin_amdgcn_s_barrier(); asm volatile("" ::: "memory");
#if defined(BROKEN_EXCHANGE_NO_WAIT)
#warning BROKEN CONTROL BUILD: the row-statistics exchange does not wait; results are wrong by design
        if (blockIdx.x >= 64) { const long long t0_ = clock64(); while (clock64() - t0_ < 60000) __builtin_amdgcn_s_sleep(8); }
#endif
        const int row = wid * 32 + (lane & 31);
        if (lane < 32) {
            const f32x2v a = P[row * 4 + 0], b = P[row * 4 + 1], c = P[row * 4 + 2], d = P[row * 4 + 3];
            const float mt = (a.x + b.x + c.x + d.x) * 0.25f;
            const float da = a.x - mt, db = b.x - mt, dc = c.x - mt, dd = d.x - mt;
            const float m2 = (a.y + b.y) + (c.y + d.y) + 64.0f * ((da * da + db * db) + (dc * dc + dd * dd));
            unsigned long long* slot = (unsigned long long*)xbuf + ((size_t)(u.pm * BM + row) * 4 + u.pn);
            __hip_atomic_store(slot, ((unsigned long long)__float_as_uint(m2) << 32) | __float_as_uint(mt), __ATOMIC_RELAXED, __HIP_MEMORY_SCOPE_AGENT);
        }
        asm volatile("s_waitcnt vmcnt(0)" ::: "memory");
        if (lane == 0) __hip_atomic_fetch_add(cnt + 64 * u.pm, 1u, __ATOMIC_RELAXED, __HIP_MEMORY_SCOPE_AGENT);
        if (wid == 0) {
            bool dead = false; const unsigned long long t0 = __builtin_amdgcn_s_memrealtime(); const unsigned want = 8u * (unsigned)ntn;
            for (;;) {
#if defined(BROKEN_EXCHANGE_NO_WAIT)
                break;
#endif
                if ((unsigned)__builtin_amdgcn_readfirstlane(__hip_atomic_load(cnt + 64 * u.pm, __ATOMIC_RELAXED, __HIP_MEMORY_SCOPE_AGENT)) >= want) break;
                if (__builtin_amdgcn_s_memrealtime() - t0 > 2000000ull) {
                    if (lane == 0) { unsigned expect = 0u; __hip_atomic_compare_exchange_strong(tmo + 1, &expect, code | (unsigned)(u.pm & 0xff), __ATOMIC_RELAXED, __ATOMIC_RELAXED, __HIP_MEMORY_SCOPE_AGENT);
                                     __hip_atomic_store(tmo, 1u, __ATOMIC_RELAXED, __HIP_MEMORY_SCOPE_AGENT); }
                    dead = true; break; }
                __builtin_amdgcn_s_sleep(2);
            }
            __builtin_amdgcn_fence(__ATOMIC_ACQUIRE, "agent");
            if (lane == 0) flag[0] = dead ? 1u : 0u;
        }
        asm volatile("s_waitcnt vmcnt(0) lgkmcnt(0)" ::: "memory"); __builtin_amdgcn_s_barrier(); asm volatile("" ::: "memory");
        const bool bad = flag[0] != 0u;
        if (lane < 32) {
            const unsigned long long* slot = (const unsigned long long*)xbuf + (size_t)(u.pm * BM + row) * 4; float mt[4], m2[4]; float ms = 0.f;
#pragma unroll
            for (int t = 0; t < 4; ++t) { if (t < ntn) { const unsigned long long w = __hip_atomic_load(slot + t, __ATOMIC_RELAXED, __HIP_MEMORY_SCOPE_AGENT); mt[t] = __uint_as_float((unsigned)w); m2[t] = __uint_as_float((unsigned)(w >> 32)); } else { mt[t] = 0.f; m2[t] = 0.f; } ms += mt[t]; }
            const float mean = ms / (float)ntn; float q = 0.f;
#pragma unroll
            for (int t = 0; t < 4; ++t) if (t < ntn) { const float dm = mt[t] - mean; q += m2[t] + 256.0f * dm * dm; }
            S[row] = (f32x2v){mean, 1.0f / sqrtf(q / (256.0f * (float)ntn) + eps)};
        }
        asm volatile("s_waitcnt lgkmcnt(0)" ::: "memory"); __builtin_amdgcn_s_barrier(); asm volatile("" ::: "memory");
        return bad;
    }
};
struct EpiLnRes {
    static constexpr bool PERM = false, AFTER_DRAIN = true;
    const float* base; float* out; int ldc; const float* bias; PanelStats st; unsigned poison;
    __device__ __forceinline__ void fused(f32x4 (&acc)[2][2][4][2], const Unit& u, int wr, int wc, int fr, int fq, PG8_LAS unsigned char* lds, int wid, int lane) const {
        typedef float f32x2v __attribute__((ext_vector_type(2)));
        const PG8_LAS f32x2v* S = (const PG8_LAS f32x2v*)(lds + 8192);
        const int col0 = u.pn * BM + wc * 32 + 4 * fq;
#pragma unroll
        for (int bj = 0; bj < 2; ++bj)
#pragma unroll
            for (int n = 0; n < 2; ++n) { const f32x4 bv = bias ? *(const f32x4*)(bias + col0 + bj * HALF + n * 16) : (f32x4){0.f, 0.f, 0.f, 0.f};
#pragma unroll
                for (int ai = 0; ai < 2; ++ai)
#pragma unroll
                    for (int m = 0; m < 4; ++m) acc[ai][bj][m][n] += bv; }
        f32x4 pre[4][2][2];
#pragma unroll
        for (int m = 0; m < 4; ++m) { const size_t off = (size_t)(u.pm * BM + wr * 64 + m * 16 + fr) * ldc + col0;
#pragma unroll
            for (int bj = 0; bj < 2; ++bj)
#pragma unroll
                for (int n = 0; n < 2; ++n) pre[m][bj][n] = *(const f32x4*)(base + off + bj * HALF + n * 16); }
        const bool bad = st.run(acc, u, wr, wc, fr, fq, lds, wid, lane) || poison != 0u;
        const float qnan = __builtin_nanf("");
#pragma unroll
        for (int ai = 0; ai < 2; ++ai)
#pragma unroll
            for (int m = 0; m < 4; ++m) { const int r = ai * HALF + wr * 64 + m * 16 + fr; const f32x2v sr = S[r]; const size_t off = (size_t)(u.pm * BM + r) * ldc + col0;
#pragma unroll
                for (int bj = 0; bj < 2; ++bj)
#pragma unroll
                    for (int n = 0; n < 2; ++n) { const f32x4 bs = ai == 0 ? pre[m][bj][n] : *(const f32x4*)(base + off + bj * HALF + n * 16); f32x4 o = bs + (acc[ai][bj][m][n] - sr.x) * sr.y;
                        if (bad) o = (f32x4){qnan, qnan, qnan, qnan}; *(f32x4*)(out + off + bj * HALF + n * 16) = o; }
                if (m & 1) asm volatile("" ::: "memory"); }
    }
};
struct EpiLnResLn {
    static constexpr bool PERM = false, AFTER_DRAIN = true;
    const float* base; float* out; bf16_t* xn; int ldc; const float* bias; PanelStats st1, st2; unsigned poison;
    __device__ __forceinline__ void fused(f32x4 (&acc)[2][2][4][2], const Unit& u, int wr, int wc, int fr, int fq, PG8_LAS unsigned char* lds, int wid, int lane) const {
        typedef float f32x2v __attribute__((ext_vector_type(2))); typedef unsigned u32x2v __attribute__((ext_vector_type(2)));
        const PG8_LAS f32x2v* S = (const PG8_LAS f32x2v*)(lds + 8192);
        const int col0 = u.pn * BM + wc * 32 + 4 * fq;
#pragma unroll
        for (int bj = 0; bj < 2; ++bj)
#pragma unroll
            for (int n = 0; n < 2; ++n) { const f32x4 bv = bias ? *(const f32x4*)(bias + col0 + bj * HALF + n * 16) : (f32x4){0.f, 0.f, 0.f, 0.f};
#pragma unroll
                for (int ai = 0; ai < 2; ++ai)
#pragma unroll
                    for (int m = 0; m < 4; ++m) acc[ai][bj][m][n] += bv; }
        bool bad = st1.run(acc, u, wr, wc, fr, fq, lds, wid, lane) || poison != 0u;
        const float qnan = __builtin_nanf("");
#pragma unroll
        for (int ai = 0; ai < 2; ++ai)
#pragma unroll
            for (int m = 0; m < 4; ++m) { const int r = ai * HALF + wr * 64 + m * 16 + fr; const f32x2v sr = S[r]; const size_t off = (size_t)(u.pm * BM + r) * ldc + col0;
#pragma unroll
                for (int bj = 0; bj < 2; ++bj)
#pragma unroll
                    for (int n = 0; n < 2; ++n) { const f32x4 bs = *(const f32x4*)(base + off + bj * HALF + n * 16); acc[ai][bj][m][n] = bs + (acc[ai][bj][m][n] - sr.x) * sr.y; }
                asm volatile("" : "+v"(acc[ai][0][m][0]), "+v"(acc[ai][0][m][1]), "+v"(acc[ai][1][m][0]), "+v"(acc[ai][1][m][1]));
                if (m & 1) asm volatile("" ::: "memory"); }
        const bool bad1 = bad;
        bad = st2.run(acc, u, wr, wc, fr, fq, lds, wid, lane) || bad;
#pragma unroll
        for (int ai = 0; ai < 2; ++ai)
#pragma unroll
            for (int m = 0; m < 4; ++m) { const int r = ai * HALF + wr * 64 + m * 16 + fr; const f32x2v sr = S[r]; const size_t off = (size_t)(u.pm * BM + r) * ldc + col0;
#pragma unroll
                for (int bj = 0; bj < 2; ++bj)
#pragma unroll
                    for (int n = 0; n < 2; ++n) { const f32x4 x1 = acc[ai][bj][m][n]; *(f32x4*)(out + off + bj * HALF + n * 16) = bad1 ? (f32x4){qnan, qnan, qnan, qnan} : x1;
                        const f32x4 o = (x1 - sr.x) * sr.y; u32x2v w; w.x = cvt_pk_bf16(o[0], o[1]); w.y = cvt_pk_bf16(o[2], o[3]);
                        if (bad) { w.x = 0x7fc07fc0u; w.y = 0x7fc07fc0u; } *(u32x2v*)(xn + off + bj * HALF + n * 16) = w; }
                asm volatile("" ::: "memory"); }
    }
};

template <class Epi, class Sched, bool ALIGN_EPI = false, bool SP2 = false>
__device__ __forceinline__ void gemm_phase(PG8_LAS unsigned char* lds, const Gemm g, const Sched& S, const Epi& E) {
    int tid_ = threadIdx.x; asm volatile("" : "+v"(tid_));
    const int tid = tid_, wid = __builtin_amdgcn_readfirstlane(tid >> 6), lane = tid & 63, wr = wid >> 2, wc = wid & 3, fr = lane & 15, fq = lane >> 4;
    const int K = g.K, ntf = K / BK;
    unsigned voffA[2], voffB[2];
#pragma unroll
    for (int i = 0; i < 2; ++i) { int R, C; stage_rc(tid * 16 + i * 8192, R, C); const int Rb = Epi::PERM ? ((R & ~31) + perm32(R & 31)) : R;
        voffA[i] = (unsigned)(R * K + C) * 2u; voffB[i] = (unsigned)(Rb * K + C) * 2u; }
    const size_t kstep = (size_t)(BK * 2);
    const size_t hstep = (size_t)HALF * K * 2;
    const size_t tstep = 2 * hstep;
    const unsigned ldsw = (unsigned)wid * 1024u;
    const int aoff = lds_byte(wr * 64 + fr, fq * 8), boff = lds_byte(wc * 32 + fr, fq * 8);
#define PG8_SA(b, h) (((b) * 2 + (h)) * HTB)
#define PG8_SB(b, h) ((4 + (b) * 2 + (h)) * HTB)
#define PG8_STAGE(bufoff, gbase, voff) do { _Pragma("unroll") for (int _i = 0; _i < 2; ++_i) \
        __builtin_amdgcn_global_load_lds((const unsigned*)((const char*)(gbase) + (voff)[_i]), (PG8_LAS unsigned*)(lds + (bufoff) + ldsw + _i * 8192), 16, 0, 0); } while (0)
#define PG8_LDA(dst, b, h) do { _Pragma("unroll") for (int m = 0; m < 4; ++m) _Pragma("unroll") for (int k = 0; k < 2; ++k) dst[m][k] = *(const PG8_LAS bf16x8*)(lds + PG8_SA(b, h) + aoff + m * 2048 + k * 1024); } while (0)
#define PG8_LDB(dst, b, h) do { _Pragma("unroll") for (int n = 0; n < 2; ++n) _Pragma("unroll") for (int k = 0; k < 2; ++k) dst[n][k] = *(const PG8_LAS bf16x8*)(lds + PG8_SB(b, h) + boff + n * 2048 + k * 1024); } while (0)
#define PG8_MMA(ai, bj, At, Bt) do { if (PG8_PRIO) __builtin_amdgcn_s_setprio(PG8_PRIO); _Pragma("unroll") for (int m = 0; m < 4; ++m) _Pragma("unroll") for (int n = 0; n < 2; ++n) _Pragma("unroll") for (int k = 0; k < 2; ++k) \
        acc[ai][bj][m][n] = __builtin_amdgcn_mfma_f32_16x16x32_bf16(Bt[n][k], At[m][k], acc[ai][bj][m][n], 0, 0, 0); if (PG8_PRIO) __builtin_amdgcn_s_setprio(0); } while (0)
#define PG8_WAIT_V(n) asm volatile("s_waitcnt vmcnt(" #n ")" ::: "memory")
#define PG8_WAIT_L(n) asm volatile("s_waitcnt lgkmcnt(" #n ")" ::: "memory")
#define PG8_BAR __builtin_amdgcn_s_barrier()
#define PG8_SCHED __builtin_amdgcn_sched_barrier(0)
    const unsigned long long tg_in = TS_GEMM ? __builtin_amdgcn_s_memrealtime() : 0ull; unsigned long long tg_ep = 0, tg_l0 = 0; (void)tg_in; (void)tg_ep; (void)tg_l0;
    Unit cur, nxt; int ui = 0;
    if (!S.next(0, cur)) return;
    f32x4 acc[2][2][4][2];
#pragma unroll
    for (int a = 0; a < 2; ++a)
#pragma unroll
        for (int b = 0; b < 2; ++b)
#pragma unroll
            for (int m = 0; m < 4; ++m)
#pragma unroll
                for (int n = 0; n < 2; ++n) acc[a][b][m][n] = (f32x4){0.f, 0.f, 0.f, 0.f};
    bf16x8 At[4][2], B0[2][2], B1[2][2];
    const char* cA = (const char*)g.A + (size_t)cur.pm * tstep + (size_t)cur.k0 * 2; const char* cB = (const char*)g.Bt + (size_t)cur.pn * tstep + (size_t)cur.k0 * 2;
    S.a_ready(cur);
    if constexpr (SP2) {
        PG8_STAGE(PG8_SB(0, 0), cB, voffB); PG8_STAGE(PG8_SB(0, 1), cB + hstep, voffB); PG8_STAGE(PG8_SA(0, 0), cA, voffA); PG8_STAGE(PG8_SA(0, 1), cA + hstep, voffA);
        if (wr == 1) PG8_BAR;
        PG8_WAIT_V(2); PG8_BAR;
        PG8_STAGE(PG8_SB(1, 0), cB + kstep, voffB); PG8_STAGE(PG8_SA(1, 0), cA + kstep, voffA); PG8_STAGE(PG8_SB(1, 1), cB + hstep + kstep, voffB);
        PG8_WAIT_V(6); PG8_BAR;
    } else {
        PG8_STAGE(PG8_SB(0, 0), cB, voffB); PG8_STAGE(PG8_SA(0, 0), cA, voffA); PG8_STAGE(PG8_SB(0, 1), cB + hstep, voffB); PG8_STAGE(PG8_SA(0, 1), cA + hstep, voffA);
        if (wr == 1) PG8_BAR;
        PG8_WAIT_V(4); PG8_BAR;
        PG8_STAGE(PG8_SB(1, 0), cB + kstep, voffB); PG8_STAGE(PG8_SA(1, 0), cA + kstep, voffA); PG8_STAGE(PG8_SB(1, 1), cB + hstep + kstep, voffB);
        PG8_WAIT_V(6); PG8_BAR;
    }
    if (TS_GEMM) tg_l0 = __builtin_amdgcn_s_memrealtime();
    for (;;) {
        const bool has_next = S.next(ui + 1, nxt);
        const char* nA = has_next ? (const char*)g.A + (size_t)nxt.pm * tstep + (size_t)nxt.k0 * 2 : cA; const char* nB = has_next ? (const char*)g.Bt + (size_t)nxt.pn * tstep + (size_t)nxt.k0 * 2 : cB;
        const int nt = cur.nt ? cur.nt : ntf;
        for (int t = 0; t < nt; t += 2) {
            const bool last = (t == nt - 2);
            const char* a1 = cA + (size_t)(t + 1) * kstep;
            const char* a2 = last ? nA : cA + (size_t)(t + 2) * kstep; const char* b2 = last ? nB : cB + (size_t)(t + 2) * kstep;
            const char* a3 = a2 + kstep; const char* b3 = b2 + kstep;
            if (last && has_next) S.a_ready(nxt);
            if constexpr (SP2) {
            PG8_LDB(B0, 0, 0); PG8_LDB(B1, 0, 1); PG8_SCHED; PG8_LDA(At, 0, 0); PG8_STAGE(PG8_SA(1, 1), a1 + hstep, voffA);
            PG8_WAIT_V(8); PG8_WAIT_L(0); PG8_BAR; PG8_MMA(0, 0, At, B0); PG8_MMA(0, 1, At, B1); PG8_BAR; PG8_SCHED;
            PG8_LDA(At, 0, 1); PG8_STAGE(PG8_SB(0, 0), b2, voffB); PG8_STAGE(PG8_SB(0, 1), b2 + hstep, voffB); PG8_STAGE(PG8_SA(0, 0), a2, voffA);
            PG8_WAIT_V(8); PG8_WAIT_L(0); PG8_BAR; PG8_MMA(1, 0, At, B0); PG8_MMA(1, 1, At, B1); PG8_BAR; PG8_SCHED;
            PG8_LDB(B0, 1, 0); PG8_LDB(B1, 1, 1); PG8_SCHED; PG8_LDA(At, 1, 0); PG8_STAGE(PG8_SA(0, 1), a2 + hstep, voffA);
            PG8_WAIT_V(8); PG8_WAIT_L(0); PG8_BAR; PG8_MMA(0, 0, At, B0); PG8_MMA(0, 1, At, B1); PG8_BAR; PG8_SCHED;
            PG8_LDA(At, 1, 1); PG8_STAGE(PG8_SB(1, 0), b3, voffB); PG8_STAGE(PG8_SB(1, 1), b3 + hstep, voffB); PG8_STAGE(PG8_SA(1, 0), a3, voffA);
            PG8_WAIT_V(8); PG8_WAIT_L(0); PG8_BAR; PG8_MMA(1, 0, At, B0); PG8_MMA(1, 1, At, B1); PG8_BAR; PG8_SCHED;
            } else {
            PG8_LDB(B0, 0, 0); PG8_SCHED; PG8_LDA(At, 0, 0); PG8_STAGE(PG8_SA(1, 1), a1 + hstep, voffA);
            PG8_WAIT_L(8); PG8_BAR; PG8_WAIT_L(0); PG8_MMA(0, 0, At, B0); PG8_BAR; PG8_SCHED;
            PG8_LDB(B1, 0, 1); PG8_STAGE(PG8_SB(0, 0), b2, voffB);
            PG8_BAR; PG8_WAIT_L(0); PG8_MMA(0, 1, At, B1); PG8_BAR;
            PG8_LDA(At, 0, 1); PG8_STAGE(PG8_SA(0, 0), a2, voffA);
            PG8_BAR; PG8_WAIT_L(0); PG8_MMA(1, 0, At, B0); PG8_BAR; PG8_SCHED;
            PG8_STAGE(PG8_SB(0, 1), b2 + hstep, voffB);
            PG8_WAIT_V(6); PG8_BAR; PG8_MMA(1, 1, At, B1); PG8_BAR;
            PG8_LDB(B0, 1, 0); PG8_SCHED; PG8_LDA(At, 1, 0); PG8_STAGE(PG8_SA(0, 1), a2 + hstep, voffA);
            PG8_WAIT_L(8); PG8_BAR; PG8_WAIT_L(0); PG8_MMA(0, 0, At, B0); PG8_BAR; PG8_SCHED;
            PG8_LDB(B1, 1, 1); PG8_STAGE(PG8_SB(1, 0), b3, voffB);
            PG8_BAR; PG8_WAIT_L(0); PG8_MMA(0, 1, At, B1); PG8_BAR;
            PG8_LDA(At, 1, 1); PG8_STAGE(PG8_SA(1, 0), a3, voffA);
            PG8_BAR; PG8_WAIT_L(0); PG8_MMA(1, 0, At, B0); PG8_BAR; PG8_SCHED;
            PG8_STAGE(PG8_SB(1, 1), b3 + hstep, voffB);
            PG8_WAIT_V(6); PG8_BAR; PG8_MMA(1, 1, At, B1); PG8_BAR;
            }
        }
        if constexpr (ALIGN_EPI) { if (wr == 0) PG8_BAR; }
        { const unsigned long long te0 = TS_GEMM ? __builtin_amdgcn_s_memrealtime() : 0ull;
        if constexpr (!Epi::AFTER_DRAIN) { E(acc, cur, wr, wc, fr, fq); S.done(cur); }
        if (TS_GEMM) tg_ep += __builtin_amdgcn_s_memrealtime() - te0; }
        if (!has_next) break;
#pragma unroll
        for (int a = 0; a < 2; ++a)
#pragma unroll
            for (int b = 0; b < 2; ++b)
#pragma unroll
                for (int m = 0; m < 4; ++m)
#pragma unroll
                    for (int n = 0; n < 2; ++n) acc[a][b][m][n] = (f32x4){0.f, 0.f, 0.f, 0.f};
        cur = nxt; cA = nA; cB = nB; ++ui;
        if constexpr (ALIGN_EPI) { if (wr == 1) PG8_BAR; }
    }
    PG8_WAIT_V(0);
    if constexpr (!ALIGN_EPI) { if (wr == 0) PG8_BAR; }
    PG8_BAR;
    if constexpr (Epi::AFTER_DRAIN) { E.fused(acc, cur, wr, wc, fr, fq, lds, wid, lane); S.done(cur); }
    if (TS_GEMM && blockIdx.x == TS_BLOCK && threadIdx.x == 0) { volatile PG8_LAS unsigned long long* ts = (volatile PG8_LAS unsigned long long*)(lds + 139264 + 8192 + 256); const unsigned long long te = __builtin_amdgcn_s_memrealtime(); const unsigned long long cid = ts[31]; ts[31] = cid + 1; if ((TS_PHASE != 113 && TS_PHASE != 114) || (int)cid == TS_GEMM_ID) { ts[28] += tg_l0 - tg_in; ts[29] += tg_ep; ts[30] += te - tg_in; } }
#undef PG8_SA
#undef PG8_SB
#undef PG8_STAGE
#undef PG8_LDA
#undef PG8_LDB
#undef PG8_MMA
#undef PG8_WAIT_V
#undef PG8_WAIT_L
#undef PG8_BAR
#undef PG8_SCHED
}
}

#ifndef PG8_SP2
#define PG8_SP2 true
#endif
#ifndef PG8_ALIGN
#define PG8_ALIGN true
#endif

#include <hip/hip_cooperative_groups.h>
namespace mk {
using pg8::bf16_t; using pg8::bf16x8; using pg8::f32x4; using pg8::u32x4; using pg8::f32x2; using pg8::Unit; using pg8::Gemm; using pg8::cvt_pk_bf16; using pg8::gelu_pk;
typedef float f32x16 __attribute__((ext_vector_type(16)));
typedef short s16x4 __attribute__((ext_vector_type(4)));
typedef short v4i16_t __attribute__((ext_vector_type(4)));
typedef __bf16 bf16x2_t __attribute__((ext_vector_type(2)));
typedef __attribute__((address_space(3))) const unsigned char* lds_cptr;
typedef __attribute__((address_space(3))) unsigned char* lds_ptr;

constexpr int DM = 1024, SEQ = 4096, CTXL = 256, NB = 8, MLAT = NB * SEQ, MCTX = NB * CTXL, MALL = MLAT + MCTX, FFH = 2816, NKT = 68;
constexpr float EPS = 1e-6f, LOG2E = 1.4426950408889634f;
constexpr int NWAVES = 8, NTHR = 512;
constexpr int NSL = 8;
constexpr size_t MiB = 1u << 20;
constexpr size_t WS_CTL = 0, CTL_ZERO_BYTES = 1 * MiB;
constexpr size_t WS_W_EV = 1 * MiB, WS_W_OD = 6 * MiB, WS_W_MIX = 10 * MiB  , WS_W_FI = 14 * MiB  , WS_W_FO = 36 * MiB  ;
constexpr size_t WS_W_UQ = 48 * MiB, WS_W_UKV = 48 * MiB + 256 * 1024, WS_W_S = 48 * MiB + 640 * 1024;
constexpr size_t WS_MODP = 49 * MiB;
constexpr size_t WS_MOD = WS_MODP + 7 * MiB - 256 * 1024;
constexpr size_t WS_VSS = 56 * MiB + 512 * 1024, WS_CQS = WS_VSS + 1152 * 1024, WS_CKS = WS_CQS + 1152 * 1024;
constexpr size_t WS_XR = 60 * MiB;
constexpr size_t WS_HN = 196 * MiB;
constexpr size_t WS_MIX = 264 * MiB;
constexpr size_t WS_S = 332 * MiB;
constexpr size_t WS_Q = WS_S, WS_KA = 400 * MiB, WS_VA = WS_KA + 8704 * 1024, WS_KB = 417 * MiB, WS_VB = 451 * MiB;
constexpr size_t WS_UACT = WS_S, WS_VACT = 364 * MiB, WS_CQ = 396 * MiB, WS_CKV = 412 * MiB, WS_KD = 429 * MiB, WS_VD = 463 * MiB;
constexpr size_t WS_OB = WS_HN, WS_Q2 = WS_HN;
constexpr size_t WS_PART = 451 * MiB;
constexpr size_t WS_ACT = WS_MIX;
constexpr size_t WS_SNAP = 498 * MiB, WS_END = 512 * MiB;
static_assert(WS_CQ + (size_t)MLAT * 256 * 2 == WS_CKV && WS_W_UQ + 512 * 256 * 2 == WS_W_UKV, "the combined MLA up-projection GEMM needs CQ | CKV and W_UQ | W_UKV contiguous");
static_assert(WS_MOD + 2 * 9 * 6144 * 4 <= WS_VSS && WS_CKS + 1152 * 1024 <= WS_XR, "ws map");
static_assert(WS_VA + 8704 * 1024 <= WS_KB && WS_VB + 34 * MiB <= WS_SNAP && WS_VD + 34 * MiB <= WS_SNAP && WS_ACT + (size_t)MALL * FFH * 2 <= WS_SNAP, "ws map 2");
constexpr int CW_BAR = 4096;
constexpr int RING_BYTES = 139264  , ROPE_OFF = RING_BYTES, MISC_OFF = ROPE_OFF + 8192, PTR_OFF = MISC_OFF + 512  , LDS_BYTES = RING_BYTES + 16384;

#ifndef TS_PHASE
#define TS_PHASE -1
#endif
#ifndef TS_BLOCK
#define TS_BLOCK 0
#endif
#define TS_ATT (TS_PHASE >= 105 && TS_PHASE <= 108)
#ifndef TS_SUB
#define TS_SUB 0
#endif
#ifndef TS_SCALE
#define TS_SCALE 1.0f
#endif
#ifndef AT_ABL
#define AT_ABL 0
#endif
#ifndef TS_CLK
#define TS_CLK 0
#endif
#ifndef TS_SEAM_LO
#define TS_SEAM_LO 1
#endif
#ifndef TS_SEAM_HI
#define TS_SEAM_HI 9
#endif
#ifndef TS_SEAM_SKIP
#define TS_SEAM_SKIP -1
#endif
#ifndef AT_KSO_B
#define AT_KSO_B 1
#endif
#ifndef AT_KSO_A
#define AT_KSO_A 0
#endif
#ifndef AT_KSO_MLA
#define AT_KSO_MLA 0
#endif
#ifndef AT_DMA_LATE
#define AT_DMA_LATE 0
#endif
#ifndef AT_KSO_A
#define AT_KSO_A 0
#endif
#ifndef GS_AT_START
#define GS_AT_START 1
#endif
#ifndef NT_LOADS
#define NT_LOADS 1
#endif
#ifndef TS_BASE
#define TS_BASE 2250
#endif
#define GAS __attribute__((address_space(1)))
#define LAS __attribute__((address_space(3)))
typedef GAS unsigned gu32;
#define RLX_AGENT __ATOMIC_RELAXED, __HIP_MEMORY_SCOPE_AGENT

#define XB_TMO      128
#define XB_XCNT(j)  (256  + 64 * (j))
#define XB_XSUB(j)  (1280 + 64 * (j))
#define XB_XGEN(j)  (2304 + 64 * (j))
#define XB_TOP      3328
#define XB_TOPGEN   3392
#define XCD_BAR_WORDS 3456
#define XB_SPIN_CAP (1u << 18)
__device__ __forceinline__ unsigned xb_ld(unsigned* p)              { return __hip_atomic_load(p, __ATOMIC_RELAXED, __HIP_MEMORY_SCOPE_AGENT); }
__device__ __forceinline__ unsigned xb_add(unsigned* p, unsigned v) { return __hip_atomic_fetch_add(p, v, __ATOMIC_RELAXED, __HIP_MEMORY_SCOPE_AGENT); }
__device__ __forceinline__ unsigned xb_xcc_id() { return (unsigned)__builtin_amdgcn_s_getreg((3 << 11) | 20) & 0xFu; }
#define XB_SPIN(cond, bar) do { unsigned _sp = 0; while (cond) { __builtin_amdgcn_s_sleep(1); \
    if ((++_sp & 255u) == 0u) { if (xb_ld(&(bar)[XB_TMO])) break; if (_sp > XB_SPIN_CAP) { atomicAdd(&(bar)[XB_TMO], 1u); break; } } } } while (0)
struct XcdBarrier { unsigned* bar; unsigned x; volatile LAS unsigned* st; };
__device__ __forceinline__ XcdBarrier xcd_barrier_post(unsigned* bar, volatile LAS unsigned* st) {
    XcdBarrier b; b.bar = bar; b.x = xb_xcc_id(); b.st = st;
    if (threadIdx.x == 0) (void)xb_add(&bar[XB_XCNT(b.x)], 1u);
    return b;
}
__device__ __forceinline__ void xcd_barrier_complete(unsigned* bar, unsigned x, unsigned& nloc, unsigned& nx) {
    const unsigned G = gridDim.x * gridDim.y * gridDim.z;
    unsigned sum, cnt, mine, sp = 0u;
    for (;;) {
        sum = 0u; cnt = 0u; mine = 0u;
#pragma unroll
        for (unsigned j = 0; j < 16; ++j) { const unsigned c = xb_ld(&bar[XB_XCNT(j)]); sum += c; cnt += (c > 0u) ? 1u : 0u; mine = (j == x) ? c : mine; }
        if (sum == G) break;
        __builtin_amdgcn_s_sleep(1);
        if ((++sp & 255u) == 0u) { if (xb_ld(&bar[XB_TMO])) break; if (sp > XB_SPIN_CAP) { atomicAdd(&bar[XB_TMO], 1u); break; } }
    }
    nloc = mine > 0u ? mine : 1u; nx = cnt > 0u ? cnt : 1u;
}
__device__ __forceinline__ void xcd_barrier(const XcdBarrier& b) {
    asm volatile("s_waitcnt vmcnt(0)" ::: "memory");
    __syncthreads();
    if (threadIdx.x == 0) {
        unsigned* bar = b.bar;
        __builtin_amdgcn_s_waitcnt(0);
        unsigned nloc = b.st[0], nx = b.st[1];
        if (nloc == 0u) { xcd_barrier_complete(bar, b.x, nloc, nx); b.st[0] = nloc; b.st[1] = nx; }
        const unsigned old = xb_add(&bar[XB_XSUB(b.x)], 1u);
        const unsigned gen = old / nloc;
        if (old + 1u == (gen + 1u) * nloc) {
            __builtin_amdgcn_fence(__ATOMIC_RELEASE, "agent");
            asm volatile("s_waitcnt vmcnt(0)" ::: "memory");
            const unsigned og = xb_add(&bar[XB_TOP], 1u);
            const unsigned tg = og / nx;
            if (og + 1u == (tg + 1u) * nx) xb_add(&bar[XB_TOPGEN], 1u);
            else XB_SPIN(xb_ld(&bar[XB_TOPGEN]) == tg, bar);
            __builtin_amdgcn_fence(__ATOMIC_ACQUIRE, "agent");
            xb_add(&bar[XB_XGEN(b.x)], 1u);
            asm volatile("s_waitcnt vmcnt(0)" ::: "memory");
        } else {
            XB_SPIN(xb_ld(&bar[XB_XGEN(b.x)]) == gen, bar);
            __builtin_amdgcn_fence(__ATOMIC_ACQUIRE, "agent");
            asm volatile("s_waitcnt vmcnt(0)" ::: "memory");
        }
    }
    __syncthreads();
}

__device__ __forceinline__ unsigned f2bf(float f) { unsigned u = __builtin_bit_cast(unsigned, f); return (u + 0x7fffu + ((u >> 16) & 1u)) >> 16; }
__device__ __forceinline__ unsigned pk2(float lo, float hi) { f32x2 v = {lo, hi}; bf16x2_t b = __builtin_convertvector(v, bf16x2_t); return __builtin_bit_cast(unsigned, b); }
__device__ __forceinline__ float bf2f(unsigned short h) { return __builtin_bit_cast(float, (unsigned)h << 16); }
template <int M> __device__ __forceinline__ float shx(float v) {
    if (M == 32) { auto rr = __builtin_amdgcn_permlane32_swap(__float_as_uint(v), __float_as_uint(v), false, false); const bool up = (threadIdx.x & 32) != 0; return __uint_as_float(up ? rr[0] : rr[1]); }
    else return __uint_as_float((unsigned)__builtin_amdgcn_ds_swizzle((int)__float_as_uint(v), 0x1F | (M << 10)));
}
__device__ __forceinline__ float wave_sum(float v) { v += shx<1>(v); v += shx<2>(v); v += shx<4>(v); v += shx<8>(v); v += shx<16>(v); v += shx<32>(v); return v; }
__device__ __forceinline__ float wave_max(float v) { v = fmaxf(v, shx<1>(v)); v = fmaxf(v, shx<2>(v)); v = fmaxf(v, shx<4>(v)); v = fmaxf(v, shx<8>(v)); v = fmaxf(v, shx<16>(v)); v = fmaxf(v, shx<32>(v)); return v; }
__device__ __forceinline__ int ltid() { int t = threadIdx.x; asm volatile("" : "+v"(t)); return t; }
__device__ __forceinline__ int obx() { int b = blockIdx.x; asm volatile("" : "+s"(b)); return b; }
__device__ __forceinline__ int crow(int r, int hi) { return (r & 3) + 8 * (r >> 2) + 4 * hi; }
__device__ __forceinline__ s16x4 vtr(lds_cptr p) { return __builtin_bit_cast(s16x4, __builtin_amdgcn_ds_read_tr16_b64_v4i16((LAS v4i16_t*)p)); }
__device__ __forceinline__ float fast_rcp(float x) { return __builtin_amdgcn_rcpf(x); }
__device__ __forceinline__ float silu_f(float g) { return g * fast_rcp(1.f + __builtin_amdgcn_exp2f(-g * LOG2E)); }
__device__ __forceinline__ float gain_absmax64(const float* g) { return wave_max(fabsf(g[threadIdx.x & 63])); }

struct Frame { lds_ptr lds; unsigned char* ws; float* out; int wave, vcu, G; };
__device__ __forceinline__ const float* inp(const Frame& F, int i) {
    const unsigned long long v = ((const LAS unsigned long long*)(F.lds + PTR_OFF))[i];
    const unsigned lo = __builtin_amdgcn_readfirstlane((unsigned)v), hi = __builtin_amdgcn_readfirstlane((unsigned)(v >> 32));
    return (const float*)(const GAS float*)(((unsigned long long)hi << 32) | lo);
}
__device__ __forceinline__ Frame mkframe() {
    Frame F; asm volatile("" ::: "memory");
    extern __shared__ __attribute__((aligned(16))) unsigned char lds_raw[];
    F.lds = (lds_ptr)lds_raw;
    F.ws = (unsigned char*)inp(F, 34); F.out = (float*)inp(F, 35);
    F.wave = __builtin_amdgcn_readfirstlane(ltid() >> 6);
    F.G = gridDim.x; { const int bx = blockIdx.x; F.vcu = (F.G % 8 == 0) ? (bx % 8) * (F.G / 8) + bx / 8 : bx; }
    return F;
}
enum { I_X = 0, I_C, I_CTX, I_CCTX, I_N1G, I_N2G, I_ADAW, I_ADAB, I_MIXW, I_FIW, I_FOW, I_EVW, I_QNA, I_KNA, I_SINK, I_QNB, I_KNB, I_LQ1, I_LK1, I_LQ2, I_LK2, I_SUBLN,
       I_ODW, I_CVN, I_CWS, I_CBS, I_QAN, I_KVAN, I_WUQ, I_WUKV, I_QNN, I_KNN, I_QNR, I_KNR };

__device__ __forceinline__ int map_head(int R) { const int pn = R >> 8, bj = (R >> 7) & 1, wc = (R >> 5) & 3, rho = R & 31; return 256 * pn + 64 * wc + 32 * bj + rho; }
__device__ __forceinline__ int map_od(int R) { if (R < 1536) return R; const int q = R - 1536, bj = (q >> 7) & 1, wc = (q >> 5) & 3, rho = q & 31; return wc == 0 ? 1536 + 32 * bj + rho : -1; }
__device__ __forceinline__ int map_fi(int R) { const int pn = R >> 8, bj = (R >> 7) & 1, q = R & 127; return bj * FFH + 128 * pn + q; }
__device__ __forceinline__ int map_ukv(int R) { const int pn = R >> 8, bj = (R >> 7) & 1, wc = (R >> 5) & 3, rho = R & 31;
    if (pn == 0) return 192 * wc + 32 * bj + rho; const int u = 4 * (pn - 1) + wc; return 192 * (u >> 1) + 64 + 64 * (u & 1) + 32 * bj + rho; }

__device__ __forceinline__ void transpose_item(const float* W, int K, int ldn, bf16_t* WT, int n0, int cs, int k0, const float* kscale, LAS float* scr, int lane) {
    float tv[32];
#pragma unroll
    for (int i = 0; i < 32; ++i) { const int kk = 2 * i + (lane >> 5); tv[i] = cs >= 0 ? (NT_LOADS ? __builtin_nontemporal_load(&W[(size_t)(k0 + kk) * ldn + cs + (lane & 31)]) : W[(size_t)(k0 + kk) * ldn + cs + (lane & 31)]) : 0.f; }
#pragma unroll
    for (int i = 0; i < 32; ++i) { const int kk = 2 * i + (lane >> 5); float v = tv[i]; if (kscale) v *= kscale[k0 + kk]; scr[kk * 33 + (lane & 31)] = v; }
    asm volatile("s_waitcnt lgkmcnt(0)" ::: "memory");
    const int c = lane & 7;
#pragma unroll
    for (int j = 0; j < 4; ++j) { const int n = (lane >> 3) + 8 * j; const LAS float* s = scr + (8 * c) * 33 + n;
        u32x4 o; o.x = pk2(s[0 * 33], s[1 * 33]); o.y = pk2(s[2 * 33], s[3 * 33]); o.z = pk2(s[4 * 33], s[5 * 33]); o.w = pk2(s[6 * 33], s[7 * 33]);
        *(u32x4*)(WT + (size_t)(n0 + n) * K + k0 + 8 * c) = o; }
    asm volatile("s_waitcnt lgkmcnt(0)" ::: "memory");
}

__device__ __forceinline__ void p0_prologue(Frame& F) {
    LAS float* scr = (LAS float*)(F.lds + F.wave * 16384);
    const int lane = ltid() & 63;
    const int gw = F.vcu * NWAVES + F.wave, NGW = F.G * NWAVES;
    constexpr int N_ADA = 2 * 16 * 24;
    constexpr int I_EV = 16 * 72, I_ODD = 16 * 56, I_MIX1 = 16 * 32, I_FI1 = 16 * 176, I_FO1 = 44 * 32, I_UQ = 4 * 16, I_UKV = 4 * 24;
    constexpr int N_TR = I_EV + I_ODD + 2 * I_MIX1 + 2 * I_FI1 + 2 * I_FO1 + I_UQ + I_UKV;
    constexpr int N_WS = 16;
    static_assert(N_ADA == 256 * 3, "three adaLN items per workgroup");
    if (ltid() == 0) *((volatile LAS unsigned*)(F.lds + MISC_OFF) + 16) = 0u;
    __syncthreads();
    (void)gw; (void)NGW;
    if (F.wave < 3) { const int it = F.vcu * 3 + F.wave;
        {
            const int i = it / (16 * 24), ks = (it / 24) % 16, cc = it % 24;
            for (int idx = lane; idx < 9 * 64; idx += 64) { const int r = idx >> 6, k = idx & 63; const float v = r < 8 ? inp(F, I_C)[r * DM + ks * 64 + k] : inp(F, I_CCTX)[ks * 64 + k]; scr[idx] = v / (1.f + expf(-v)); }
            asm volatile("s_waitcnt lgkmcnt(0)" ::: "memory");
            f32x4 acc[9];
#pragma unroll
            for (int r = 0; r < 9; ++r) acc[r] = (f32x4){0.f, 0.f, 0.f, 0.f};
            const float* w = inp(F, I_ADAW) + ((size_t)i * DM + ks * 64) * 6144 + cc * 256 + lane * 4;
#pragma unroll 8
            for (int k = 0; k < 64; ++k) { const f32x4 wv = NT_LOADS ? __builtin_nontemporal_load((const f32x4*)(w + (size_t)k * 6144)) : *(const f32x4*)(w + (size_t)k * 6144);
#pragma unroll
                for (int r = 0; r < 9; ++r) acc[r] += wv * scr[r * 64 + k]; }
            float* mp = (float*)(F.ws + WS_MODP) + ((size_t)(i * 16 + ks) * 9) * 6144 + cc * 256 + lane * 4;
#pragma unroll
            for (int r = 0; r < 9; ++r) *(f32x4*)(mp + (size_t)r * 6144) = acc[r];
            asm volatile("s_waitcnt lgkmcnt(0)" ::: "memory");
        }
    }
    volatile LAS unsigned* ticket = (volatile LAS unsigned*)(F.lds + MISC_OFF) + 16;
    for (;;) {
        unsigned jj = 0; if (lane == 0) jj = __hip_atomic_fetch_add((LAS unsigned*)ticket, 1u, __ATOMIC_RELAXED, __HIP_MEMORY_SCOPE_WORKGROUP);
        jj = __builtin_amdgcn_readfirstlane(jj);
        const int it = F.vcu + F.G * (int)jj; if (it >= N_TR + N_WS) break;
        int r = it;
        if (r < I_EV) { const int kb = r / 72, nb = r % 72; transpose_item(inp(F, I_EVW), DM, 2304, (bf16_t*)(F.ws + WS_W_EV), 32 * nb, map_head(32 * nb), 64 * kb, nullptr, scr, lane); continue; } r -= I_EV;
        if (r < I_ODD) { const int kb = r / 56, nb = r % 56; transpose_item(inp(F, I_ODW), DM, 1600, (bf16_t*)(F.ws + WS_W_OD), 32 * nb, map_od(32 * nb), 64 * kb, nullptr, scr, lane); continue; } r -= I_ODD;
        if (r < 2 * I_MIX1) { const int l = r / I_MIX1, q = r % I_MIX1, kb = q / 32, nb = q % 32; transpose_item(inp(F, I_MIXW) + (size_t)l * DM * DM, DM, DM, (bf16_t*)(F.ws + WS_W_MIX + l * 2 * MiB), 32 * nb, 32 * nb, 64 * kb, nullptr, scr, lane); continue; } r -= 2 * I_MIX1;
        if (r < 2 * I_FI1) { const int l = r / I_FI1, q = r % I_FI1, kb = q / 176, nb = q % 176; transpose_item(inp(F, I_FIW) + (size_t)l * DM * 2 * FFH, DM, 2 * FFH, (bf16_t*)(F.ws + WS_W_FI + l * 11 * MiB), 32 * nb, map_fi(32 * nb), 64 * kb, nullptr, scr, lane); continue; } r -= 2 * I_FI1;
        if (r < 2 * I_FO1) { const int l = r / I_FO1, q = r % I_FO1, kb = q / 32, nb = q % 32; transpose_item(inp(F, I_FOW) + (size_t)l * FFH * DM, FFH, DM, (bf16_t*)(F.ws + WS_W_FO + l * 6 * MiB), 32 * nb, 32 * nb, 64 * kb, nullptr, scr, lane); continue; } r -= 2 * I_FO1;
        if (r < I_UQ) { const int kb = r / 16, nb = r % 16; transpose_item(inp(F, I_WUQ), 256, 512, (bf16_t*)(F.ws + WS_W_UQ), 32 * nb, map_head(32 * nb), 64 * kb, inp(F, I_QAN), scr, lane); continue; } r -= I_UQ;
        if (r < I_UKV) { const int kb = r / 24, nb = r % 24; transpose_item(inp(F, I_WUKV), 256, 768, (bf16_t*)(F.ws + WS_W_UKV), 32 * nb, map_ukv(32 * nb), 64 * kb, inp(F, I_KVAN), scr, lane); continue; } r -= I_UKV;
        { bf16_t* d = (bf16_t*)(F.ws + WS_W_S); const float* s = inp(F, I_CWS);
#pragma unroll 4
          for (int j = 0; j < 64; ++j) { const int e = r * 4096 + j * 64 + lane; d[e] = (bf16_t)f2bf(s[e]); } }
    }
}

__device__ __forceinline__ void load_mod16(Frame& F, int lane, int layer, int mr, int chunk, bool from_partials, f32x4 (&dst)[4]) {
    if (from_partials) {
        const float* mp = (const float*)(F.ws + WS_MODP) + ((size_t)(layer * 16) * 9 + mr) * 6144 + chunk * DM + lane * 4;
        const float* bias = inp(F, I_ADAB) + layer * 6144 + chunk * DM + lane * 4;
#pragma unroll
        for (int j = 0; j < 4; ++j) { f32x4 a = *(const f32x4*)(bias + 256 * j);
            for (int ks = 0; ks < 16; ++ks) a += *(const f32x4*)(mp + (size_t)ks * 9 * 6144 + 256 * j);
            dst[j] = a; }
    } else {
        const float* m = (const float*)(F.ws + WS_MOD) + ((size_t)layer * 9 + mr) * 6144 + chunk * DM + lane * 4;
#pragma unroll
        for (int j = 0; j < 4; ++j) dst[j] = *(const f32x4*)(m + 256 * j);
    }
}
template <bool SRC_BF16>
__device__ __forceinline__ void ln_phase(Frame& F, int layer, int chunk, const float* gain, const void* src_lat, const void* src_ctx, int mrows, bool from_partials, bf16_t* ctx_out = nullptr, const float* parts = nullptr) {
    const int lane = ltid() & 63;
    const int gw = F.vcu * NWAVES + F.wave;
    bf16_t* HN = (bf16_t*)(F.ws + WS_HN);
    f32x4 gv[4], sh[4], sc[4];
#pragma unroll
    for (int j = 0; j < 4; ++j) gv[j] = *(const f32x4*)(gain + lane * 4 + 256 * j);
#define LN_LOAD(V, SS, XB, RO) do { SS = 0.f; _Pragma("unroll") for (int j = 0; j < 4; ++j) { \
            if (SRC_BF16) { const unsigned long long w_ = *(const unsigned long long*)((XB) + ((RO) + 256 * j) * 2); const unsigned lo_ = (unsigned)w_, hi_ = (unsigned)(w_ >> 32); \
                V[j] = (f32x4){__builtin_bit_cast(float, lo_ << 16), __builtin_bit_cast(float, lo_ & 0xffff0000u), __builtin_bit_cast(float, hi_ << 16), __builtin_bit_cast(float, hi_ & 0xffff0000u)}; } \
            else V[j] = NT_LOADS ? __builtin_nontemporal_load((const f32x4*)((XB) + ((RO) + 256 * j) * 4)) : *(const f32x4*)((XB) + ((RO) + 256 * j) * 4); \
            SS += (V[j].x * V[j].x + V[j].y * V[j].y) + (V[j].z * V[j].z + V[j].w * V[j].w); } } while (0)
#define LN_STORE(V, RS, M) do { unsigned long long* o8_ = (unsigned long long*)(HN + (size_t)(M) * DM) + lane; _Pragma("unroll") for (int j = 0; j < 4; ++j) { const f32x4 y_ = V[j] * (RS) * gv[j] * (sc[j] + 1.0f) + sh[j]; \
            o8_[64 * j] = (unsigned long long)pk2(y_.x, y_.y) | ((unsigned long long)pk2(y_.z, y_.w) << 32); } } while (0)
    { const int m0 = gw * 16; if (m0 < mrows) { const int mr = m0 >> 12; load_mod16(F, lane, layer, mr, chunk, from_partials, sh); load_mod16(F, lane, layer, mr, chunk + 1, from_partials, sc);
        const unsigned char* xb = (const unsigned char*)src_lat;
#pragma unroll 1
        for (int q = 0; q < 4; ++q) { f32x4 va[4], vb[4], vc[4], vd[4]; float sa, sb, sc2, sd; const size_t ro = (size_t)(m0 + 4 * q) * DM + lane * 4;
            LN_LOAD(va, sa, xb, ro); LN_LOAD(vb, sb, xb, ro + DM); LN_LOAD(vc, sc2, xb, ro + 2 * DM); LN_LOAD(vd, sd, xb, ro + 3 * DM);
            sa = wave_sum(sa); sb = wave_sum(sb); sc2 = wave_sum(sc2); sd = wave_sum(sd);
            const float ra = 1.0f / sqrtf(sa * (1.f / DM) + EPS), rb = 1.0f / sqrtf(sb * (1.f / DM) + EPS), rc = 1.0f / sqrtf(sc2 * (1.f / DM) + EPS), rd = 1.0f / sqrtf(sd * (1.f / DM) + EPS);
            LN_STORE(va, ra, m0 + 4 * q); LN_STORE(vb, rb, m0 + 4 * q + 1); LN_STORE(vc, rc, m0 + 4 * q + 2); LN_STORE(vd, rd, m0 + 4 * q + 3); } } }
    { const int m = MLAT + gw; if (m < mrows) { load_mod16(F, lane, layer, 8, chunk, from_partials, sh); load_mod16(F, lane, layer, 8, chunk + 1, from_partials, sc);
        const size_t ro = (size_t)(m - MLAT) * DM + lane * 4; f32x4 v[4]; float ss; LN_LOAD(v, ss, (const unsigned char*)src_ctx, ro);
        if (ctx_out) {
            if (parts) { ss = 0.f;
#pragma unroll
                for (int j = 0; j < 4; ++j) {
#pragma unroll
                    for (int sl = 0; sl < NSL; ++sl) { const unsigned long long w_ = *(const unsigned long long*)((const bf16_t*)parts + ((size_t)sl * MCTX + (m - MLAT)) * DM + lane * 4 + 256 * j); const unsigned lo_ = (unsigned)w_, hi_ = (unsigned)(w_ >> 32);
                        v[j] += (f32x4){__builtin_bit_cast(float, lo_ << 16), __builtin_bit_cast(float, lo_ & 0xffff0000u), __builtin_bit_cast(float, hi_ << 16), __builtin_bit_cast(float, hi_ & 0xffff0000u)}; }
                    ss += (v[j].x * v[j].x + v[j].y * v[j].y) + (v[j].z * v[j].z + v[j].w * v[j].w); } }
            unsigned long long* x8 = (unsigned long long*)(ctx_out + (size_t)(m - MLAT) * DM) + lane;
#pragma unroll
            for (int j = 0; j < 4; ++j) x8[64 * j] = (unsigned long long)pk2(v[j].x, v[j].y) | ((unsigned long long)pk2(v[j].z, v[j].w) << 32); }
        const float rs = 1.0f / sqrtf(wave_sum(ss) * (1.f / DM) + EPS);
        LN_STORE(v, rs, m); } }
#undef LN_LOAD
#undef LN_STORE
}
__device__ __forceinline__ void mod_reduce(Frame& F) {
    const int gt = F.vcu * NTHR + ltid();
    if (gt < 2 * 9 * 6144) { const int i = gt / (9 * 6144), rem = gt % (9 * 6144), r = rem / 6144, n = rem % 6144;
        float a = inp(F, I_ADAB)[i * 6144 + n]; const float* mp = (const float*)(F.ws + WS_MODP) + ((size_t)(i * 16) * 9 + r) * 6144 + n;
        for (int ks = 0; ks < 16; ++ks) a += mp[(size_t)ks * 9 * 6144];
        ((float*)(F.ws + WS_MOD))[gt] = a; }
}

__device__ __forceinline__ u32x4 pack8(const f32x4 a, const f32x4 b) { u32x4 w; w.x = pk2(a[0], a[1]); w.y = pk2(a[2], a[3]); w.z = pk2(b[0], b[1]); w.w = pk2(b[2], b[3]); return w; }
struct RowGrp { int b, ktile, is_ctx; };
__device__ __forceinline__ RowGrp rowgrp(int rb) { RowGrp g; if (rb < MLAT) { g.b = rb >> 12; g.ktile = (rb & 4095) >> 6; g.is_ctx = 0; } else { const int rc = rb - MLAT; g.b = rc >> 8; g.ktile = 64 + ((rc & 255) >> 6); g.is_ctx = 1; } return g; }
__device__ __forceinline__ void rope8(f32x4 (&v0)[2], f32x4 (&v1)[2], const LAS f32x2* T, int pos, int fq) {
    const LAS f32x2* t = T + pos * 16 + 8 * (fq & 1);
#pragma unroll
    for (int n = 0; n < 2; ++n)
#pragma unroll
        for (int j = 0; j < 4; ++j) { const f32x2 cs = t[4 * n + j]; const float x1 = v0[n][j], x2 = v1[n][j]; v0[n][j] = x1 * cs.x - x2 * cs.y; v1[n][j] = x2 * cs.x + x1 * cs.y; }
}

__device__ __forceinline__ void head_row(f32x4 (&v0)[2], f32x4 (&v1)[2], const f32x4 (&g0)[2], const f32x4 (&g1)[2], float r2, const LAS f32x2* T, int pos, int fq) {
    float ss = 0.f;
#pragma unroll
    for (int n = 0; n < 2; ++n) { ss += (v0[n][0] * v0[n][0] + v0[n][1] * v0[n][1]) + (v0[n][2] * v0[n][2] + v0[n][3] * v0[n][3]); ss += (v1[n][0] * v1[n][0] + v1[n][1] * v1[n][1]) + (v1[n][2] * v1[n][2] + v1[n][3] * v1[n][3]); }
    ss += shx<16>(ss); ss += shx<32>(ss);
    const float rs = __builtin_amdgcn_sqrtf(r2) * __builtin_amdgcn_rsqf(r2 * ss * (1.f / 64.f) + EPS);
#pragma unroll
    for (int n = 0; n < 2; ++n) {
        v0[n] = v0[n] * rs * g0[n]; v1[n] = v1[n] * rs * g1[n];
        if (pos >= 0) { const LAS f32x2* t = T + pos * 16 + 8 * (fq & 1) + 4 * n;
#pragma unroll
            for (int j = 0; j < 4; ++j) { const f32x2 cs = t[j]; const float x1 = v0[n][j], x2 = v1[n][j]; v0[n][j] = x1 * cs.x - x2 * cs.y; v1[n][j] = x2 * cs.x + x1 * cs.y; } }
    }
}
__device__ __forceinline__ void load_gains(const float* gp, int fq, f32x4 (&g0)[2], f32x4 (&g1)[2]) {
#pragma unroll
    for (int n = 0; n < 2; ++n) { g0[n] = *(const f32x4*)(gp + 8 * fq + 4 * n); g1[n] = *(const f32x4*)(gp + 32 + 8 * fq + 4 * n); }
}

struct EpiEven {
    static constexpr bool PERM = true, AFTER_DRAIN = false;
    unsigned char* ws; lds_ptr lds; float qscale;
    __device__ __forceinline__ void operator()(const f32x4 (&acc)[2][2][4][2], const Unit& u, int wr, int wc, int fr_, int fq_) const {
        int fr = fr_, fq = fq_; asm volatile("" : "+v"(fr), "+v"(fq));
        const int unit = 4 * u.pn + wc;
        const LAS f32x2* T = (const LAS f32x2*)(lds + ROPE_OFF); Frame Fq; Fq.lds = lds;
        const int gi = unit < 8 ? I_QNA : unit < 16 ? I_QNB : unit < 18 ? I_KNA : unit < 20 ? -1 : unit < 28 ? I_KNB : -1;
        const float* gp = gi >= 0 ? inp(Fq, gi) : nullptr;
        f32x4 g0[2], g1[2]; if (gp) load_gains(gp, fq, g0, g1);
#pragma unroll
        for (int ai = 0; ai < 2; ++ai) {
            const int rb = u.pm * 256 + ai * 128 + wr * 64; const RowGrp G = rowgrp(rb);
#pragma unroll
            for (int m = 0; m < 4; ++m) {
                const int kk = 16 * m + fr; const size_t row = (size_t)rb + kk;
                f32x4 v0[2] = {acc[ai][0][m][0], acc[ai][0][m][1]}, v1[2] = {acc[ai][1][m][0], acc[ai][1][m][1]};
                if (gp) head_row(v0, v1, g0, g1, 1.0f, T, G.is_ctx ? -1 : (fq < 2 ? G.ktile : kk), fq);
                if (unit < 16) {
                    bf16_t* q = (bf16_t*)(ws + WS_Q) + row * DM + 64 * unit + 8 * fq;
                    *(u32x4*)q = pack8(v0[0] * qscale, v0[1] * qscale); *(u32x4*)(q + 32) = pack8(v1[0] * qscale, v1[1] * qscale);
                } else if (unit < 18 || (unit >= 20 && unit < 28)) {
                    unsigned char* img = unit < 18 ? ws + WS_KA + ((size_t)(G.b * 2 + (unit - 16)) * NKT + G.ktile) * 8192 : ws + WS_KB + ((size_t)(G.b * 8 + (unit - 20)) * NKT + G.ktile) * 8192;
                    *(u32x4*)(img + fq * 1024 + kk * 16) = pack8(v0[0], v0[1]); *(u32x4*)(img + (4 + fq) * 1024 + kk * 16) = pack8(v1[0], v1[1]);
                } else if (unit < 20) {
                    unsigned char* img = ws + WS_VA + ((size_t)(G.b * 2 + (unit - 18)) * NKT + G.ktile) * 8192 + m * 1024 + fr * 64 + fq * 16;
                    *(u32x4*)img = pack8(v0[0], v0[1]); *(u32x4*)(img + 4096) = pack8(v1[0], v1[1]);
                } else {
                    const int j = unit - 28, h = j >> 1, half = j & 1;
                    unsigned char* img = ws + WS_VB + ((size_t)(G.b * 4 + h) * NKT + G.ktile) * 16384 + (2 * half) * 4096 + m * 1024 + fr * 64 + fq * 16;
                    *(u32x4*)img = pack8(v0[0], v0[1]); *(u32x4*)(img + 4096) = pack8(v1[0], v1[1]);
                }
                asm volatile("" ::: "memory");
            }
        }
    }
};

__device__ __forceinline__ void unpack8(const u32x4 w, f32x4& a, f32x4& b) {
#pragma unroll
    for (int j = 0; j < 2; ++j) { a[2 * j] = __builtin_bit_cast(float, w[j] << 16); a[2 * j + 1] = __builtin_bit_cast(float, w[j] & 0xffff0000u); b[2 * j] = __builtin_bit_cast(float, w[2 + j] << 16); b[2 * j + 1] = __builtin_bit_cast(float, w[2 + j] & 0xffff0000u); }
}
template <bool IN_BF16, bool OUT_BF16> struct EpiResid {
    static constexpr bool PERM = true, AFTER_DRAIN = false;
    const void* xin_lat; const void* xin_ctx; void* out_lat; void* out_ctx; const float* gate  ; float* part;
    __device__ __forceinline__ void operator()(const f32x4 (&acc)[2][2][4][2], const Unit& u, int wr, int wc, int fr_, int fq_) const {
        int fr = fr_, fq = fq_; asm volatile("" : "+v"(fr), "+v"(fq));
        const int rb0 = u.pm * 256; const bool ctx = rb0 >= MLAT; const int mr = ctx ? 8 : (rb0 >> 12);
        if (u.nt) {
            bf16_t* pp = (bf16_t*)part + ((size_t)u.aux * MCTX + (rb0 - MLAT)) * DM + u.pn * 256 + wc * 32 + 8 * fq;
#pragma unroll
            for (int bj = 0; bj < 2; ++bj) { const f32x4 ga = *(const f32x4*)(gate + (size_t)8 * 6144 + u.pn * 256 + wc * 32 + 8 * fq + 128 * bj), gb = *(const f32x4*)(gate + (size_t)8 * 6144 + u.pn * 256 + wc * 32 + 8 * fq + 128 * bj + 4);
#pragma unroll
                for (int ai = 0; ai < 2; ++ai)
#pragma unroll
                    for (int m = 0; m < 4; ++m) *(u32x4*)(pp + (size_t)(ai * 128 + wr * 64 + 16 * m + fr) * DM + 128 * bj) = pack8(ga * acc[ai][bj][m][0], gb * acc[ai][bj][m][1]); }
            return; }
        const size_t ro = (size_t)(ctx ? rb0 - MLAT : rb0) * DM;
        const unsigned char* xin = (const unsigned char*)(ctx ? xin_ctx : xin_lat) + ro * (IN_BF16 ? 2 : 4); unsigned char* out = (unsigned char*)(ctx ? out_ctx : out_lat) + ro * (OUT_BF16 ? 2 : 4);
        const int c0 = u.pn * 256 + wc * 32 + 8 * fq;
        f32x4 gt[2][2];
#pragma unroll
        for (int bj = 0; bj < 2; ++bj)
#pragma unroll
            for (int n = 0; n < 2; ++n) gt[bj][n] = *(const f32x4*)(gate + (size_t)mr * 6144 + c0 + 128 * bj + 4 * n);
#pragma unroll
        for (int ai = 0; ai < 2; ++ai) {
            u32x4 xb[4][2]; f32x4 xf[4][2][2];
#pragma unroll
            for (int m = 0; m < 4; ++m) { const size_t off = (size_t)(ai * 128 + wr * 64 + 16 * m + fr) * DM + c0;
#pragma unroll
                for (int bj = 0; bj < 2; ++bj) {
                    if (IN_BF16) xb[m][bj] = *(const u32x4*)(xin + (off + 128 * bj) * 2);
                    else { xf[m][bj][0] = *(const f32x4*)(xin + (off + 128 * bj) * 4); xf[m][bj][1] = *(const f32x4*)(xin + (off + 128 * bj + 4) * 4); } } }
            asm volatile("" ::: "memory");
#pragma unroll
            for (int m = 0; m < 4; ++m) { const size_t off = (size_t)(ai * 128 + wr * 64 + 16 * m + fr) * DM + c0;
#pragma unroll
                for (int bj = 0; bj < 2; ++bj) { f32x4 x0, x1;
                    if (IN_BF16) unpack8(xb[m][bj], x0, x1); else { x0 = xf[m][bj][0]; x1 = xf[m][bj][1]; }
                    x0 += gt[bj][0] * acc[ai][bj][m][0]; x1 += gt[bj][1] * acc[ai][bj][m][1];
                    if (OUT_BF16) *(u32x4*)(out + (off + 128 * bj) * 2) = pack8(x0, x1);
                    else { *(f32x4*)(out + (off + 128 * bj) * 4) = x0; *(f32x4*)(out + (off + 128 * bj + 4) * 4) = x1; } } }
            asm volatile("" ::: "memory");
        }
    }
};

struct EpiSwiglu {
    static constexpr bool PERM = true, AFTER_DRAIN = false;
    bf16_t* act;
    __device__ __forceinline__ void operator()(const f32x4 (&acc)[2][2][4][2], const Unit& u, int wr, int wc, int fr_, int fq_) const {
        int fr = fr_, fq = fq_; asm volatile("" : "+v"(fr), "+v"(fq));
#pragma unroll
        for (int ai = 0; ai < 2; ++ai)
#pragma unroll
            for (int m = 0; m < 4; ++m) { const size_t row = (size_t)u.pm * 256 + ai * 128 + wr * 64 + 16 * m + fr; f32x4 o[2];
#pragma unroll
                for (int n = 0; n < 2; ++n)
#pragma unroll
                    for (int j = 0; j < 4; ++j) o[n][j] = silu_f(acc[ai][0][m][n][j]) * acc[ai][1][m][n][j];
                *(u32x4*)(act + row * FFH + u.pn * 128 + wc * 32 + 8 * fq) = pack8(o[0], o[1]); }
    }
};

struct EpiOdd {
    static constexpr bool PERM = true, AFTER_DRAIN = false;
    unsigned char* ws; lds_ptr lds;
    __device__ __forceinline__ void operator()(const f32x4 (&acc)[2][2][4][2], const Unit& u, int wr, int wc, int fr_, int fq_) const {
        int fr = fr_, fq = fq_; asm volatile("" : "+v"(fr), "+v"(fq));
        const int pn = u.pn;
        if (pn == 6) {
            if (wc != 0) return;
            const LAS f32x2* T = (const LAS f32x2*)(lds + ROPE_OFF); Frame Fq; Fq.lds = lds; const float* knr = inp(Fq, I_KNR);
            f32x4 g0[2], g1[2]; load_gains(knr, fq, g0, g1);
#pragma unroll
            for (int ai = 0; ai < 2; ++ai) { const int rb = u.pm * 256 + ai * 128 + wr * 64; const RowGrp G = rowgrp(rb);
#pragma unroll
                for (int m = 0; m < 4; ++m) { const int kk = 16 * m + fr;
                    f32x4 v0[2] = {acc[ai][0][m][0], acc[ai][0][m][1]}, v1[2] = {acc[ai][1][m][0], acc[ai][1][m][1]};
                    head_row(v0, v1, g0, g1, 1.0f, T, G.is_ctx ? -1 : (fq < 2 ? G.ktile : kk), fq);
                    const u32x4 w0 = pack8(v0[0], v0[1]), w1 = pack8(v1[0], v1[1]);
#pragma unroll
                    for (int h = 0; h < 4; ++h) { unsigned char* img = ws + WS_KD + ((size_t)(G.b * 4 + h) * NKT + G.ktile) * 16384 + kk * 16;
                        *(u32x4*)(img + (8 + fq) * 1024) = w0; *(u32x4*)(img + (12 + fq) * 1024) = w1; }
                    asm volatile("" ::: "memory"); } }
            return;
        }
        const bool act = pn < 4; bf16_t* dbase; int ldd; float* sbase = nullptr;
        if (pn < 2) { dbase = (bf16_t*)(ws + WS_UACT) + 256 * pn; ldd = 512; }
        else if (pn < 4) { dbase = (bf16_t*)(ws + WS_VACT) + 256 * (pn - 2); ldd = 512; sbase = (float*)(ws + WS_VSS) + (pn - 2) * 4 + wc; }
        else if (pn == 4) { dbase = (bf16_t*)(ws + WS_CQ); ldd = 256; sbase = (float*)(ws + WS_CQS) + wc; }
        else { dbase = (bf16_t*)(ws + WS_CKV); ldd = 256; sbase = (float*)(ws + WS_CKS) + wc; }
        const int c0 = 32 * wc + 8 * fq;
#pragma unroll
        for (int ai = 0; ai < 2; ++ai)
#pragma unroll
            for (int m = 0; m < 4; ++m) { const size_t row = (size_t)u.pm * 256 + ai * 128 + wr * 64 + 16 * m + fr; float ss = 0.f;
#pragma unroll
                for (int bj = 0; bj < 2; ++bj) { f32x4 a = acc[ai][bj][m][0], b = acc[ai][bj][m][1];
                    if (act) { f32x2 t0 = gelu_pk((f32x2){a[0], a[1]}), t1 = gelu_pk((f32x2){a[2], a[3]}), t2 = gelu_pk((f32x2){b[0], b[1]}), t3 = gelu_pk((f32x2){b[2], b[3]});
                        a = (f32x4){t0.x, t0.y, t1.x, t1.y}; b = (f32x4){t2.x, t2.y, t3.x, t3.y}; }
                    ss += (a[0] * a[0] + a[1] * a[1]) + (a[2] * a[2] + a[3] * a[3]) + (b[0] * b[0] + b[1] * b[1]) + (b[2] * b[2] + b[3] * b[3]);
                    *(u32x4*)(dbase + row * ldd + 128 * bj + c0) = pack8(a, b); }
                if (sbase) { ss += shx<16>(ss); ss += shx<32>(ss); if (fq == 0) sbase[row * 8] = ss; }
                asm volatile("" ::: "memory"); }
    }
};

struct EpiUq {
    static constexpr bool PERM = true, AFTER_DRAIN = false;
    unsigned char* ws; lds_ptr lds; float qscale;
    __device__ __forceinline__ void operator()(const f32x4 (&acc)[2][2][4][2], const Unit& u, int wr, int wc, int fr_, int fq_) const {
        int fr = fr_, fq = fq_; asm volatile("" : "+v"(fr), "+v"(fq));
        const LAS f32x2* T = (const LAS f32x2*)(lds + ROPE_OFF); Frame Fq; Fq.lds = lds;
        const int unit = 4 * u.pn + wc, part = unit & 1; const float* gp = inp(Fq, part ? I_QNR : I_QNN);
        f32x4 g0[2], g1[2]; load_gains(gp, fq, g0, g1);
        float r2s[8];
#pragma unroll
        for (int i = 0; i < 8; ++i) { const size_t row = (size_t)u.pm * 256 + (i >> 2) * 128 + wr * 64 + 16 * (i & 3) + fr; const f32x4 sq = *(const f32x4*)((const float*)(ws + WS_CQS) + row * 8); r2s[i] = __builtin_amdgcn_rcpf(((sq[0] + sq[1]) + (sq[2] + sq[3])) * (1.f / 256.f) + EPS); }
#pragma unroll
        for (int ai = 0; ai < 2; ++ai) { const int rb = u.pm * 256 + ai * 128 + wr * 64; const RowGrp G = rowgrp(rb);
#pragma unroll
            for (int m = 0; m < 4; ++m) { const int kk = 16 * m + fr; const size_t row = (size_t)rb + kk; const float r2 = r2s[ai * 4 + m];
                f32x4 v0[2] = {acc[ai][0][m][0], acc[ai][0][m][1]}, v1[2] = {acc[ai][1][m][0], acc[ai][1][m][1]};
                head_row(v0, v1, g0, g1, r2, T, (part && !G.is_ctx) ? (fq < 2 ? G.ktile : kk) : -1, fq);
                bf16_t* q = (bf16_t*)(ws + WS_Q2) + row * 512 + 64 * unit + 8 * fq;
                *(u32x4*)q = pack8(v0[0] * qscale, v0[1] * qscale); *(u32x4*)(q + 32) = pack8(v1[0] * qscale, v1[1] * qscale);
                asm volatile("" ::: "memory"); } }
    }
};
struct EpiUkv {
    static constexpr bool PERM = true, AFTER_DRAIN = false;
    unsigned char* ws; lds_ptr lds;
    __device__ __forceinline__ void operator()(const f32x4 (&acc)[2][2][4][2], const Unit& u, int wr, int wc, int fr_, int fq_) const {
        int fr = fr_, fq = fq_; asm volatile("" : "+v"(fr), "+v"(fq));
        const float* knn = nullptr; if (u.pn == 0) { Frame Fq; Fq.lds = lds; knn = inp(Fq, I_KNN); }
        f32x4 g0[2], g1[2]; if (u.pn == 0) load_gains(knn, fq, g0, g1);
        float r2s[8];
#pragma unroll
        for (int i = 0; i < 8; ++i) { const size_t row = (size_t)u.pm * 256 + (i >> 2) * 128 + wr * 64 + 16 * (i & 3) + fr; const f32x4 sq = *(const f32x4*)((const float*)(ws + WS_CKS) + row * 8); r2s[i] = __builtin_amdgcn_rcpf(((sq[0] + sq[1]) + (sq[2] + sq[3])) * (1.f / 256.f) + EPS); }
#pragma unroll
        for (int ai = 0; ai < 2; ++ai) { const int rb = u.pm * 256 + ai * 128 + wr * 64; const RowGrp G = rowgrp(rb);
#pragma unroll
            for (int m = 0; m < 4; ++m) { const int kk = 16 * m + fr; const size_t row = (size_t)rb + kk; const float r2 = r2s[ai * 4 + m];
                f32x4 v0[2] = {acc[ai][0][m][0], acc[ai][0][m][1]}, v1[2] = {acc[ai][1][m][0], acc[ai][1][m][1]};
                if (u.pn == 0) {
                    head_row(v0, v1, g0, g1, r2, (const LAS f32x2*)nullptr, -1, fq);
                    unsigned char* img = ws + WS_KD + ((size_t)(G.b * 4 + wc) * NKT + G.ktile) * 16384 + kk * 16;
                    *(u32x4*)(img + fq * 1024) = pack8(v0[0], v0[1]); *(u32x4*)(img + (4 + fq) * 1024) = pack8(v1[0], v1[1]);
                } else {
                    const float rs = __builtin_amdgcn_sqrtf(r2); const int uu = 4 * (u.pn - 1) + wc, h = uu >> 1, half = uu & 1;
                    unsigned char* img = ws + WS_VD + ((size_t)(G.b * 4 + h) * NKT + G.ktile) * 16384 + (2 * half) * 4096 + m * 1024 + fr * 64 + fq * 16;
                    *(u32x4*)img = pack8(v0[0] * rs, v0[1] * rs); *(u32x4*)(img + 4096) = pack8(v1[0] * rs, v1[1] * rs);
                }
                asm volatile("" ::: "memory"); } }
    }
};

struct EpiNull { static constexpr bool PERM = true, AFTER_DRAIN = false;
    __device__ __forceinline__ void operator()(const f32x4 (&acc)[2][2][4][2], const Unit& u, int wr, int wc, int fr, int fq) const { asm volatile("" :: "v"(acc[0][0][0][0]), "v"(acc[1][1][3][1])); } };
struct UqkvOrder {
    int G, c;
    __device__ void init(int G_, int c_) { G = G_; c = c_; }
    __device__ static void tmpl(int L, int nM, int nN, Unit& u) { const int nwg = nM * nN; int wgid = L; { const int q = nwg / pg8::NXCD, r = nwg % pg8::NXCD, xcd = wgid % pg8::NXCD, off = wgid / pg8::NXCD; wgid = (xcd < r ? xcd * (q + 1) : r * (q + 1) + (xcd - r) * q) + off; }
        const int nig = pg8::WGM * nN, gid = wgid / nig, fm = gid * pg8::WGM, gsz = (nM - fm) < pg8::WGM ? (nM - fm) : pg8::WGM; u.pm = fm + ((wgid % nig) % gsz); u.pn = (wgid % nig) / gsz; }
    __device__ bool next(int i, Unit& u) const { const int L = i * G + c; u.k0 = 0; u.nt = 0;
        if (L < 256) { tmpl(L, MLAT / 256, 2, u); u.aux = 0; return true; }
        if (L < 256 + 408) { tmpl(L - 256, MALL / 256, 3, u); u.pm += 128; u.pn += 2; u.aux = 1; return true; }
        return false; }
    __device__ __forceinline__ void a_ready(const Unit&) const {}
    __device__ __forceinline__ void done(const Unit&) const {}
};
struct EpiUqkv {
    static constexpr bool PERM = true, AFTER_DRAIN = false;
    EpiUq q; EpiUkv kv;
    __device__ __forceinline__ void operator()(const f32x4 (&acc)[2][2][4][2], const Unit& u, int wr, int wc, int fr, int fq) const {
        if (u.aux == 0) q(acc, u, wr, wc, fr, fq);
        else { Unit v = u; v.pm -= 128; v.pn -= 2; kv(acc, v, wr, wc, fr, fq); }
    }
};
struct OddOrder {
    pg8::StaticOrder base;
    __device__ void init(int G, int c) { base.init(MLAT, 1792, G, c); }
    __device__ bool next(int i, Unit& u) const { const long L = (long)i * base.G + base.c; if (L < base.nwg) return base.next(i, u); const int q = (int)(L - base.nwg); if (q >= 16) return false; u.pm = 128 + (q >> 1); u.pn = 5 + (q & 1); u.k0 = 0; u.nt = 0; u.aux = 0; return true; }
    __device__ __forceinline__ void a_ready(const Unit&) const {}
    __device__ __forceinline__ void done(const Unit&) const {}
};

struct SplitOrder {
    pg8::StaticOrder base; int npairs;
    __device__ void init(int K, int G, int c) { base.init(MLAT, DM, G, c); npairs = K / 128; }
    __device__ bool next(int i, Unit& u) const { const long L = (long)i * base.G + base.c; if (L < base.nwg) return base.next(i, u); const int q = (int)(L - base.nwg); if (q >= 32 * NSL) return false;
        const int unit = q / NSL, sl = q % NSL, lo = npairs / NSL, rem = npairs % NSL;
        const int p0 = sl * lo + (sl < rem ? sl : rem), np = lo + (sl < rem ? 1 : 0);
        u.pm = 128 + (unit >> 2); u.pn = unit & 3; u.k0 = 128 * p0; u.nt = 2 * np; u.aux = sl; return true; }
    __device__ __forceinline__ void a_ready(const Unit&) const {}
    __device__ __forceinline__ void done(const Unit&) const {}
};

__device__ __forceinline__ void glds16(const void* gsrc, unsigned lds_dst) { unsigned keep;
    asm volatile("s_mov_b32 %0, m0\n\ts_mov_b32 m0, %2\n\ts_nop 0\n\tglobal_load_lds_dwordx4 %1, off\n\ts_mov_b32 m0, %0" : "=&s"(keep) : "v"(gsrc), "s"(lds_dst) : "memory"); }
#define AT_WAIT_BAR() asm volatile("s_waitcnt vmcnt(0) lgkmcnt(0)\n\ts_barrier" ::: "memory")

template <int DQK, int DV>
__device__ __forceinline__ void attn_pre(lds_ptr lds, const bf16_t* qptr, int ldq, const unsigned char* Kimg, const unsigned char* Vimg, int tile0, bf16x8 (&qr)[DQK / 16]) {
    constexpr int KBY = 64 * DQK * 2, VBY = 64 * DV * 2, NKR = KBY / 8192, NVR = VBY / 8192;
    int tid_ = threadIdx.x; asm volatile("" : "+v"(tid_));
    const int lane = tid_ & 63, r32 = lane & 31, hi = lane >> 5; const int wv = __builtin_amdgcn_readfirstlane(tid_ >> 6);
    const unsigned lds0 = (unsigned)(uintptr_t)lds;
    const unsigned char* gk = Kimg + (size_t)tile0 * KBY + wv * 1024 + lane * 16; const unsigned char* gv = Vimg + (size_t)tile0 * VBY + wv * 1024 + lane * 16;
#pragma unroll
    for (int tt = 0; tt < 2; ++tt) {
#pragma unroll
        for (int i = 0; i < NKR; ++i) glds16(gk + (size_t)tt * KBY + i * 8192, (unsigned)__builtin_amdgcn_readfirstlane(lds0 + tt * (KBY + VBY) + i * 8192 + wv * 1024));
#pragma unroll
        for (int i = 0; i < NVR; ++i) glds16(gv + (size_t)tt * VBY + i * 8192, (unsigned)__builtin_amdgcn_readfirstlane(lds0 + tt * (KBY + VBY) + KBY + i * 8192 + wv * 1024)); }
#pragma unroll
    for (int d0 = 0; d0 < DQK / 16; ++d0) qr[d0] = *(const bf16x8*)(qptr + (size_t)r32 * ldq + d0 * 16 + hi * 8);
}
template <int DQK, int DV, int MODE, int ABL = 0, int KSO = 1, class Pre = int>
__device__ __forceinline__ void attn_unit(lds_ptr lds, const bf16x8 (&qr)[DQK / 16], const unsigned char* Kimg, const unsigned char* Vimg,
                                          int ta0, int ta1, int tb0, int tb1, int qpos0, int win, float negMb, float l_extra, bf16_t* optr, int ldo,
                                          float lam, float dscale, const float* subln, const Pre& pre) {
    const lds_ptr keepl = lds + 73728 + __builtin_amdgcn_readfirstlane((int)threadIdx.x >> 6) * 8192 + (threadIdx.x & 63) * 16;
    constexpr int KBY = 64 * DQK * 2, VBY = 64 * DV * 2, SLOT = KBY + VBY, NKR = KBY / 8192, NVR = VBY / 8192;
    int tid_ = threadIdx.x; asm volatile("" : "+v"(tid_));
    const int tid = tid_, lane = tid & 63, r32 = lane & 31, hi = lane >> 5; const int wv = __builtin_amdgcn_readfirstlane(tid >> 6);
    const unsigned long long ts_in = TS_ATT ? __builtin_amdgcn_s_memrealtime() : 0ull; (void)ts_in;
    const int na = ta1 - ta0, nt = na + (tb1 - tb0);
    const unsigned lds0 = (unsigned)(uintptr_t)lds;
    f32x16 o[DV / 32];
#pragma unroll
    for (int d = 0; d < DV / 32; ++d)
#pragma unroll
        for (int r = 0; r < 16; ++r) o[d][r] = 0.f;
    float lsum = 0.f, lsum2 = 0.f;
#define AT_TILE(tt) ((tt) < na ? ta0 + (tt) : tb0 + ((tt) - na))
#define AT_DMA(tt, slot) do { const int t_ = AT_TILE(tt); const unsigned char* gk_ = Kimg + (size_t)t_ * KBY + wv * 1024 + lane * 16; const unsigned char* gv_ = Vimg + (size_t)t_ * VBY + wv * 1024 + lane * 16; \
        _Pragma("unroll") for (int i = 0; i < NKR; ++i) glds16(gk_ + i * 8192, (unsigned)__builtin_amdgcn_readfirstlane(lds0 + (slot) * SLOT + i * 8192 + wv * 1024)); \
        _Pragma("unroll") for (int i = 0; i < NVR; ++i) glds16(gv_ + i * 8192, (unsigned)__builtin_amdgcn_readfirstlane(lds0 + (slot) * SLOT + KBY + i * 8192 + wv * 1024)); } while (0)
#define AT_KRD(dst, i0, n, slot) do { const lds_cptr kb_ = (lds_cptr)lds + (slot) * SLOT + hi * 1024 + r32 * 16; \
        _Pragma("unroll") for (int i_ = 0; i_ < (n); ++i_) { dst[2 * i_] = *(const LAS bf16x8*)(kb_ + ((i0) + i_) * 2048); dst[2 * i_ + 1] = *(const LAS bf16x8*)(kb_ + ((i0) + i_) * 2048 + 512); } } while (0)
#define AT_QKM(P0, P1, src, i0, n) do { _Pragma("unroll") for (int i_ = 0; i_ < (n); ++i_) { const int d0 = (i0) + i_; \
        P0 = __builtin_amdgcn_mfma_f32_32x32x16_bf16(src[2 * i_], qr[d0], d0 == 0 ? z_ : P0, 0, 0, 0); P1 = __builtin_amdgcn_mfma_f32_32x32x16_bf16(src[2 * i_ + 1], qr[d0], d0 == 0 ? z_ : P1, 0, 0, 0); } } while (0)
#define AT_QK(P0, P1, slot) do { \
        const f32x16 z_ = {0.f, 0.f, 0.f, 0.f, 0.f, 0.f, 0.f, 0.f, 0.f, 0.f, 0.f, 0.f, 0.f, 0.f, 0.f, 0.f}; \
        bf16x8 kx_[4]; AT_KRD(kx_, 2, 2, slot); __builtin_amdgcn_sched_barrier(0);     \
        if constexpr (DQK == 64) { AT_QKM(P0, P1, kp, 0, 2); __builtin_amdgcn_sched_barrier(0); AT_QKM(P0, P1, kx_, 2, 2); __builtin_amdgcn_sched_barrier(0); } \
        else { bf16x8 ky_[8]; AT_QKM(P0, P1, kp, 0, 2); AT_KRD(ky_, 4, 4, slot); __builtin_amdgcn_sched_barrier(0); AT_QKM(P0, P1, kx_, 2, 2); __builtin_amdgcn_sched_barrier(0); AT_QKM(P0, P1, ky_, 4, 4); __builtin_amdgcn_sched_barrier(0); } } while (0)
#define AT_SM(P0, P1, tt) do { \
        if (win && (tt) < na) { const int dq0_ = (qpos0 + r32) - 64 * AT_TILE(tt) + 128; \
            _Pragma("unroll") for (int r = 0; r < 16; ++r) { const int k_ = crow(r, hi); if ((unsigned)(dq0_ - k_) > 256u) P0[r] = -INFINITY; if ((unsigned)(dq0_ - k_ - 32) > 256u) P1[r] = -INFINITY; } } } while (0)
#define AT_SL(P, b, w, LS) do { _Pragma("unroll") for (int r = (b); r < (b) + 8; ++r) { P[r] = __builtin_amdgcn_exp2f(P[r]); LS += P[r]; asm volatile("" : "+v"(LS)); } \
        _Pragma("unroll") for (int q = 0; q < 4; ++q) pw[w][q] = pk2(P[(b) + 2 * q], P[(b) + 2 * q + 1]); } while (0)
#define AT_VLD(slot, nslot, has_next) do { const lds_cptr vp_ = (lds_cptr)lds + (slot) * SLOT + KBY + ((lane >> 4) & 1) * 32 + (lane & 3) * 8 + (4 * hi + ((lane & 15) >> 2)) * 64; \
        _Pragma("unroll") for (int d = 0; d < DV / 32; ++d) _Pragma("unroll") for (int ks = 0; ks < 4; ++ks) { vlo[d * 4 + ks] = vtr(vp_ + d * 4096 + ks * 1024); vhi[d * 4 + ks] = vtr(vp_ + d * 4096 + ks * 1024 + 512); } \
        if (has_next) AT_KRD(kp, 0, 2, nslot);     \
        __builtin_amdgcn_sched_barrier(0); } while (0)
#define AT_PVK(ks) do { _Pragma("unroll") for (int d = 0; d < DV / 32; ++d) { const s16x4 lo_ = vlo[d * 4 + (ks)], hh_ = vhi[d * 4 + (ks)]; \
            const bf16x8 vf_ = (bf16x8){lo_[0], lo_[1], lo_[2], lo_[3], hh_[0], hh_[1], hh_[2], hh_[3]}; \
            o[d] = __builtin_amdgcn_mfma_f32_32x32x16_bf16(vf_, __builtin_bit_cast(bf16x8, pw[ks]), o[d], 0, 0, 0); } } while (0)
#define AT_PVM(P0, P1) do { if constexpr (KSO == 3) { AT_SL(P0, 0, 0, lsum); AT_SL(P0, 8, 1, lsum); AT_PVK(0); AT_PVK(1); AT_SL(P1, 0, 2, lsum2); AT_SL(P1, 8, 3, lsum2); AT_PVK(2); AT_PVK(3); } \
        else { AT_SL(P0, 0, 0, lsum); AT_PVK(0); AT_SL(P0, 8, 1, lsum); AT_PVK(1); AT_SL(P1, 0, 2, lsum2); AT_PVK(2); AT_SL(P1, 8, 3, lsum2); AT_PVK(3); } } while (0)
#define AT_SM_ALL(P0, P1, tt) do { \
        if (win && (tt) < na) { const int dq0_ = (qpos0 + r32) - 64 * AT_TILE(tt) + 128; \
            _Pragma("unroll") for (int r = 0; r < 16; ++r) { const int k_ = crow(r, hi); if ((unsigned)(dq0_ - k_) > 256u) P0[r] = -INFINITY; if ((unsigned)(dq0_ - k_ - 32) > 256u) P1[r] = -INFINITY; } } \
        _Pragma("unroll") for (int r = 0; r < 16; ++r) { P0[r] = __builtin_amdgcn_exp2f(P0[r]); P1[r] = __builtin_amdgcn_exp2f(P1[r]); lsum += P0[r]; asm volatile("" : "+v"(lsum)); lsum2 += P1[r]; asm volatile("" : "+v"(lsum2)); } \
        _Pragma("unroll") for (int q = 0; q < 4; ++q) { pw[0][q] = pk2(P0[2 * q], P0[2 * q + 1]); pw[1][q] = pk2(P0[8 + 2 * q], P0[8 + 2 * q + 1]); pw[2][q] = pk2(P1[2 * q], P1[2 * q + 1]); pw[3][q] = pk2(P1[8 + 2 * q], P1[8 + 2 * q + 1]); } } while (0)
#define AT_PVM_ALL() do { \
        _Pragma("unroll") for (int d = 0; d < DV / 32; ++d) _Pragma("unroll") for (int ks = 0; ks < 4; ++ks) { const s16x4 lo_ = vlo[d * 4 + ks], hh_ = vhi[d * 4 + ks]; \
            const bf16x8 vf_ = (bf16x8){lo_[0], lo_[1], lo_[2], lo_[3], hh_[0], hh_[1], hh_[2], hh_[3]}; \
            o[d] = __builtin_amdgcn_mfma_f32_32x32x16_bf16(vf_, __builtin_bit_cast(bf16x8, pw[ks]), o[d], 0, 0, 0); } } while (0)
#define AT_BAR() asm volatile("s_waitcnt lgkmcnt(0)\n\ts_barrier" ::: "memory")
    f32x16 sa0, sa1; u32x4 pw[4]; s16x4 vlo[DV / 8], vhi[DV / 8];
    unsigned long long ts_a = 0, ts_b = 0, ts_c = 0; (void)ts_a; (void)ts_b; (void)ts_c;
    bf16x8 kp[4];
    int sc = 0, sn = 1, sf = 2;
    for (int t = 0; t < nt; ++t) {
        AT_WAIT_BAR();
        if (TS_ATT && t == 0) ts_a = __builtin_amdgcn_s_memrealtime();
        if (!AT_DMA_LATE) { if (t + 2 < nt) AT_DMA(t + 2, sf); }
        if (t == 0) AT_KRD(kp, 0, 2, sc);
        if (!(ABL & 8)) { AT_QK(sa0, sa1, sc); }
        if (!(ABL & 4)) { AT_VLD(sc, sn, t + 1 < nt); }
        if (AT_DMA_LATE) { if (t + 2 < nt) AT_DMA(t + 2, sf); __builtin_amdgcn_sched_barrier(0); }
        if (!(ABL & 1)) { if constexpr (KSO != 0) { AT_SM(sa0, sa1, t); } else { AT_SM_ALL(sa0, sa1, t); } } else { _Pragma("unroll") for (int q = 0; q < 4; ++q) { pw[0][q] = __builtin_bit_cast(unsigned, sa0[q]); pw[1][q] = __builtin_bit_cast(unsigned, sa0[4 + q]); pw[2][q] = __builtin_bit_cast(unsigned, sa1[q]); pw[3][q] = __builtin_bit_cast(unsigned, sa1[4 + q]); } }
        if (!(ABL & 4)) { if constexpr (KSO != 0) { AT_PVM(sa0, sa1); } else { AT_PVM_ALL(); } }
        { const int s_ = sc; sc = sn; sn = sf; sf = s_; }
    }
    AT_WAIT_BAR();
    if (TS_ATT) ts_b = __builtin_amdgcn_s_memrealtime();
    pre();
#undef AT_TILE
#undef AT_DMA
#undef AT_QK
#undef AT_QKM
#undef AT_KRD
#undef AT_SM
#undef AT_SM_ALL
#undef AT_PVM_ALL
#undef AT_SL
#undef AT_PVK
#undef AT_VLD
#undef AT_PVM
#undef AT_BAR
    lsum += lsum2; lsum += shx<32>(lsum); lsum += l_extra;
    const float linv = 1.0f / lsum;
    bf16_t* orow = optr + (size_t)r32 * ldo + 8 * hi;
#define AT_ROWST(d, gp, e0, e1, e2, e3, e4, e5, e6, e7) do { const unsigned ax_ = pk2(e0, e1), ay_ = pk2(e2, e3), bx_ = pk2(e4, e5), by_ = pk2(e6, e7); \
        const auto sx_ = __builtin_amdgcn_permlane32_swap(ax_, bx_, false, false); const auto sy_ = __builtin_amdgcn_permlane32_swap(ay_, by_, false, false); \
        *(u32x4*)(orow + 32 * (d) + 16 * (gp)) = (u32x4){sx_[0], sy_[0], sx_[1], sy_[1]}; } while (0)
    if (MODE == 0) {
#pragma unroll
        for (int d = 0; d < DV / 32; ++d)
#pragma unroll
            for (int gp = 0; gp < 2; ++gp) AT_ROWST(d, gp, o[d][8 * gp] * linv, o[d][8 * gp + 1] * linv, o[d][8 * gp + 2] * linv, o[d][8 * gp + 3] * linv, o[d][8 * gp + 4] * linv, o[d][8 * gp + 5] * linv, o[d][8 * gp + 6] * linv, o[d][8 * gp + 7] * linv);
    } else if (MODE == 1) {
#pragma unroll
        for (int d = 0; d < DV / 32; ++d)
#pragma unroll
            for (int q4 = 0; q4 < 2; ++q4) { u32x4 kp;
#pragma unroll
                for (int e = 0; e < 4; ++e) { const int r = 8 * q4 + 2 * e; kp[e] = pk2(o[d][r] * linv, o[d][r + 1] * linv); }
                *(LAS u32x4*)(keepl + (d * 2 + q4) * 1024) = kp; }
    } else {
        float ss = 0.f;
#pragma unroll
        for (int d = 0; d < DV / 32; ++d)
#pragma unroll
            for (int q4 = 0; q4 < 2; ++q4) { const u32x4 kp = *(const LAS u32x4*)(keepl + (d * 2 + q4) * 1024);
#pragma unroll
                for (int e = 0; e < 4; ++e) { const int r = 8 * q4 + 2 * e; const float a0 = __builtin_bit_cast(float, kp[e] << 16), a1 = __builtin_bit_cast(float, kp[e] & 0xffff0000u);
                    const float w0 = a0 - lam * (o[d][r] * linv), w1 = a1 - lam * (o[d][r + 1] * linv); o[d][r] = w0; o[d][r + 1] = w1; ss += w0 * w0 + w1 * w1; } }
        ss += shx<32>(ss);
        const float rs = __builtin_amdgcn_rsqf(ss * (1.f / DV) + EPS) * dscale;
#pragma unroll
        for (int d = 0; d < DV / 32; ++d)
#pragma unroll
            for (int gp = 0; gp < 2; ++gp) { const f32x4 ga = *(const f32x4*)(subln + 32 * d + 16 * gp + 4 * hi) * rs, gb = *(const f32x4*)(subln + 32 * d + 16 * gp + 8 + 4 * hi) * rs;
                AT_ROWST(d, gp, o[d][8 * gp] * ga[0], o[d][8 * gp + 1] * ga[1], o[d][8 * gp + 2] * ga[2], o[d][8 * gp + 3] * ga[3], o[d][8 * gp + 4] * gb[0], o[d][8 * gp + 5] * gb[1], o[d][8 * gp + 6] * gb[2], o[d][8 * gp + 7] * gb[3]); }
    }
#undef AT_ROWST
    if (TS_ATT) { asm volatile("s_waitcnt vmcnt(0)" ::: "memory"); ts_c = __builtin_amdgcn_s_memrealtime(); if (blockIdx.x == TS_BLOCK && threadIdx.x == 0) { volatile LAS unsigned long long* ts = (volatile LAS unsigned long long*)(lds + MISC_OFF + 256); ts[24] += (ts_a - ts_in); ts[25] += (ts_b - ts_a); ts[26] += (ts_c - ts_b); ts[27] += 1; } }
}

struct AttCall { int kind  , b, hsel, ta0, ta1, tb0, tb1, qpos0, win; size_t m0; };
__device__ __forceinline__ bool att_call(const Frame& F, int n, AttCall& c) {
    const int w = F.wave; int i, sft;
    if (n < 4) { i = n >> 1; sft = n & 1; } else if (n < 8) { i = n - 2; sft = 0; } else { i = 6; sft = n - 8; }
    c.tb0 = 0; c.tb1 = 0; c.qpos0 = 0; c.win = 0;
    if (i < 2) { const int idx = F.vcu + 256 * i, j = idx >> 4, qb = idx & 15; c.kind = 1 + sft; c.b = j >> 2; c.hsel = j & 3; c.m0 = (size_t)c.b * SEQ + 256 * qb + 32 * w; c.ta0 = 0; c.ta1 = NKT; }
    else if (i < 6) { const int idx = F.vcu + 256 * (i - 2), kvh = (idx >> 6) & 1, nn = (idx >> 1) & 31, hp = idx & 1; c.kind = 0; c.b = idx >> 7; c.hsel = 4 * kvh + 2 * hp + (w >> 2);
        c.m0 = (size_t)c.b * SEQ + 128 * nn + 32 * (w & 3); c.ta0 = max(0, 2 * nn - 2); c.ta1 = min(64, 2 * nn + 4); c.tb0 = 64; c.tb1 = NKT; c.qpos0 = 128 * nn + 32 * (w & 3); c.win = 1; }
    else { if (n > 9 || F.vcu >= 128 || (F.vcu >= 32 && F.vcu < 64)) return false;
        if (F.vcu < 32) { c.kind = 1 + sft; c.b = F.vcu >> 2; c.hsel = F.vcu & 3; } else { if (sft) return false; const int j = F.vcu - 64; c.kind = 0; c.b = j >> 3; c.hsel = j & 7; }
        c.m0 = (size_t)MLAT + c.b * CTXL + 32 * w; c.ta0 = 64; c.ta1 = NKT; }
    return true;
}
__device__ __forceinline__ const unsigned char* att_K(const Frame& F, const AttCall& c) { return c.kind ? F.ws + WS_KB + (size_t)(c.b * 8 + 2 * c.hsel + (c.kind == 2 ? 1 : 0)) * NKT * 8192 : F.ws + WS_KA + (size_t)(c.b * 2 + (c.hsel >> 2)) * NKT * 8192; }
__device__ __forceinline__ const unsigned char* att_V(const Frame& F, const AttCall& c) { return c.kind ? F.ws + WS_VB + (size_t)(c.b * 4 + c.hsel) * NKT * 16384 : F.ws + WS_VA + (size_t)(c.b * 2 + (c.hsel >> 2)) * NKT * 8192; }
__device__ __forceinline__ void att_pre(const Frame& F, const AttCall& c, bf16x8 (&qr)[4]) {
    if (c.kind) attn_pre<64, 128>(F.lds, (const bf16_t*)(F.ws + WS_Q) + c.m0 * DM + 512 + 128 * c.hsel + (c.kind == 2 ? 64 : 0), DM, att_K(F, c), att_V(F, c), c.ta0, qr);
    else        attn_pre<64, 64>(F.lds, (const bf16_t*)(F.ws + WS_Q) + c.m0 * DM + 64 * c.hsel, DM, att_K(F, c), att_V(F, c), c.ta0, qr);
}
__device__ __forceinline__ void phase_attn_even(Frame& F) {
    const float MbA = 8.0f * gain_absmax64(inp(F, I_QNA)) * gain_absmax64(inp(F, I_KNA)) * LOG2E;
    const float MbB = 8.0f * gain_absmax64(inp(F, I_QNB)) * gain_absmax64(inp(F, I_KNB)) * LOG2E;
    const int w = F.wave, lane = ltid() & 63;
    float s1 = inp(F, I_LQ1)[lane] * inp(F, I_LK1)[lane], s2 = inp(F, I_LQ2)[lane] * inp(F, I_LK2)[lane];
    s1 = wave_sum(s1); s2 = wave_sum(s2);
    const float lam_init = 0.8f - 0.6f * 1.0f  , lam = expf(s1) - expf(s2) + lam_init;
    const float* subln = inp(F, I_SUBLN);
    bf16x8 qr[4];
    { AttCall c0; att_call(F, 0, c0); att_pre(F, c0, qr); }
    for (int n = 0; n < 10; ++n) {
        AttCall c; if (!att_call(F, n, c)) break;
        bf16x8 qn[4];
#pragma unroll
        for (int d = 0; d < 4; ++d) qn[d] = qr[d];
        const auto pre = [&]() { AttCall nx; if (att_call(F, n + 1, nx)) att_pre(F, nx, qn); };
        if (c.kind) {
            bf16_t* o = (bf16_t*)(F.ws + WS_MIX) + c.m0 * DM + 512 + 128 * c.hsel;
            if (c.kind == 1) attn_unit<64, 128, 1, 0, AT_KSO_B>(F.lds, qr, att_K(F, c), att_V(F, c), c.ta0, c.ta1, c.tb0, c.tb1, 0, 0, -MbB, 0.f, o, DM, lam, 1.0f - lam_init, subln, pre);
            else             attn_unit<64, 128, 2, 0, AT_KSO_B>(F.lds, qr, att_K(F, c), att_V(F, c), c.ta0, c.ta1, c.tb0, c.tb1, 0, 0, -MbB, 0.f, o, DM, lam, 1.0f - lam_init, subln, pre);
        } else {
            const float lx = __builtin_amdgcn_exp2f(inp(F, I_SINK)[c.hsel] * LOG2E);
            attn_unit<64, 64, 0, 0, AT_KSO_A>(F.lds, qr, att_K(F, c), att_V(F, c), c.ta0, c.ta1, c.tb0, c.tb1, c.qpos0, c.win, -MbA, lx, (bf16_t*)(F.ws + WS_MIX) + c.m0 * DM + 64 * c.hsel, DM, 0.f, 0.f, subln, pre);
        }
#pragma unroll
        for (int d = 0; d < 4; ++d) qr[d] = qn[d];
    }
}
__device__ __forceinline__ void phase_diff_combine(Frame& F) {
    const int lane = ltid() & 63;
    const int gw = F.vcu * NWAVES + F.wave;
    float s1 = inp(F, I_LQ1)[lane] * inp(F, I_LK1)[lane], s2 = inp(F, I_LQ2)[lane] * inp(F, I_LK2)[lane];
    s1 = wave_sum(s1); s2 = wave_sum(s2);
    const float lam_init = 0.8f - 0.6f * 1.0f  , lam = expf(s1) - expf(s2) + lam_init;
    const bf16_t* OB = (const bf16_t*)(F.ws + WS_OB); bf16_t* MIXp = (bf16_t*)(F.ws + WS_MIX);
    const int h = lane >> 4, d8 = (lane & 15) * 8;
    f32x4 g0 = *(const f32x4*)(inp(F, I_SUBLN) + d8), g1 = *(const f32x4*)(inp(F, I_SUBLN) + d8 + 4);
    for (int m = gw * 17; m < gw * 17 + 17; ++m) {
        const u32x4 a = *(const u32x4*)(OB + (size_t)m * DM + (2 * h) * 128 + d8), bq = *(const u32x4*)(OB + (size_t)m * DM + (2 * h + 1) * 128 + d8);
        float v[8]; float ss = 0.f;
#pragma unroll
        for (int j = 0; j < 4; ++j) { const float a0 = __builtin_bit_cast(float, a[j] << 16), a1 = __builtin_bit_cast(float, a[j] & 0xffff0000u), b0 = __builtin_bit_cast(float, bq[j] << 16), b1 = __builtin_bit_cast(float, bq[j] & 0xffff0000u);
            v[2 * j] = a0 - lam * b0; v[2 * j + 1] = a1 - lam * b1; ss += v[2 * j] * v[2 * j] + v[2 * j + 1] * v[2 * j + 1]; }
        ss += shx<1>(ss); ss += shx<2>(ss); ss += shx<4>(ss); ss += shx<8>(ss);
        const float rs = (1.0f - lam_init) / sqrtf(ss * (1.f / 128.f) + EPS);
        const f32x4 o0 = (f32x4){v[0], v[1], v[2], v[3]} * rs * g0, o1 = (f32x4){v[4], v[5], v[6], v[7]} * rs * g1;
        *(u32x4*)(MIXp + (size_t)m * DM + 512 + 128 * h + d8) = pack8(o0, o1);
    }
}

template <int ABL = 0> __device__ __forceinline__ void phase_attn_mla(Frame& F) {
    const float a = gain_absmax64(inp(F, I_QNN)), b2 = gain_absmax64(inp(F, I_QNR)), c = gain_absmax64(inp(F, I_KNN)), d = gain_absmax64(inp(F, I_KNR));
    const float Mb = 0.08838834764831845f * 64.0f * sqrtf((a * a + b2 * b2) * (c * c + d * d)) * LOG2E;
    const bf16_t* Q2 = (const bf16_t*)(F.ws + WS_Q2); bf16_t* MIXp = (bf16_t*)(F.ws + WS_MIX);
    bf16x8 qr[8];
    const auto mla_pre = [&](int i, bf16x8 (&q)[8]) { const int idx = F.vcu + 256 * i, j = idx >> 4, qb = idx & 15, b = j >> 2, h = j & 3; const size_t m0 = (size_t)b * SEQ + 256 * qb + 32 * F.wave;
        attn_pre<128, 128>(F.lds, Q2 + m0 * 512 + 128 * h, 512, F.ws + WS_KD + (size_t)(b * 4 + h) * NKT * 16384, F.ws + WS_VD + (size_t)(b * 4 + h) * NKT * 16384, 0, q); };
    mla_pre(0, qr);
    for (int i = 0; i < 2; ++i) { const int idx = F.vcu + 256 * i, j = idx >> 4, qb = idx & 15, b = j >> 2, h = j & 3;
        const size_t m0 = (size_t)b * SEQ + 256 * qb + 32 * F.wave;
        bf16x8 qn[8];
#pragma unroll
        for (int d = 0; d < 8; ++d) qn[d] = qr[d];
        const auto pre = [&]() { if (i + 1 < 2) mla_pre(i + 1, qn); };
        attn_unit<128, 128, 0, ABL, AT_KSO_MLA>(F.lds, qr, F.ws + WS_KD + (size_t)(b * 4 + h) * NKT * 16384, F.ws + WS_VD + (size_t)(b * 4 + h) * NKT * 16384,
                                   0, NKT, 0, 0, 0, 0, -Mb, 0.f, MIXp + m0 * DM + 512 + 128 * h, DM, 0.f, 0.f, (const float*)nullptr, pre);
#pragma unroll
        for (int d = 0; d < 8; ++d) qr[d] = qn[d]; }
}

__device__ __forceinline__ void phase_spatial(Frame& F) {
    const int tid = ltid(), lane = tid & 63, r32 = lane & 31, hi = lane >> 5, w = F.wave, pb = w >> 1, cb0 = 2 * (w & 1);
    const bf16_t* UACT = (const bf16_t*)(F.ws + WS_UACT); const bf16_t* VACT = (const bf16_t*)(F.ws + WS_VACT); const float* VSS = (const float*)(F.ws + WS_VSS);
    const bf16_t* WS = (const bf16_t*)(F.ws + WS_W_S); bf16_t* MIXp = (bf16_t*)(F.ws + WS_MIX);
    const float* cvn = inp(F, I_CVN); const float* cbs = inp(F, I_CBS);
    LAS float* rsl = (LAS float*)(F.lds + MISC_OFF + 1024);
    LAS float* bsl = (LAS float*)(F.lds + MISC_OFF + 2048);
    bsl[tid] = cbs[tid];
    for (int idx = F.vcu; idx < MLAT / 128; idx += F.G) {
        const size_t m0 = (size_t)idx * 128;
        if (tid < 128) { const f32x4 s0 = *(const f32x4*)(VSS + (m0 + tid) * 8), s1 = *(const f32x4*)(VSS + (m0 + tid) * 8 + 4);
            rsl[tid] = 1.0f / sqrtf((((s0[0] + s0[1]) + (s0[2] + s0[3])) + ((s1[0] + s1[1]) + (s1[2] + s1[3]))) * (1.f / 512.f) + EPS); }
        const int c8 = (tid & 63) * 8, g_ = c8 >> 7, cl = c8 & 127;
        u32x4 raw[16];
#pragma unroll
        for (int i = 0; i < 16; ++i) raw[i] = *(const u32x4*)(VACT + (m0 + w + 8 * i) * 512 + c8);
        const f32x4 g0 = *(const f32x4*)(cvn + c8), g1 = *(const f32x4*)(cvn + c8 + 4);
        const __amdgpu_buffer_rsrc_t urs = __builtin_amdgcn_make_buffer_rsrc((void*)(UACT + m0 * 512), (short)0, 128 * 512 * 2, 0x00020000), ors = __builtin_amdgcn_make_buffer_rsrc((void*)(MIXp + m0 * DM), (short)0, 128 * DM * 2, 0x00020000);
        const unsigned uoff = (unsigned)(((32 * pb + 4 * hi) * 512 + 32 * cb0 + r32) * 2), ooff = (unsigned)(((32 * pb + 4 * hi) * DM + 32 * cb0 + r32) * 2);
        unsigned short uA[32], uB[32];
#define SP_ULOAD(U, g) do { _Pragma("unroll") for (int r = 0; r < 16; ++r) _Pragma("unroll") for (int ci = 0; ci < 2; ++ci) U[r * 2 + ci] = (unsigned short)__builtin_amdgcn_raw_buffer_load_b16(urs, uoff, (((r & 3) + 8 * (r >> 2)) * 512 + 128 * (g) + 32 * ci) * 2, 0); } while (0)
        SP_ULOAD(uA, 0);
        s16x4 wA[16];
#define SP_WLOAD(Wf, g) do { const bf16_t* wrow_ = WS + ((size_t)(g) * 128 + 32 * pb + r32) * 128 + 4 * hi; _Pragma("unroll") for (int ks = 0; ks < 8; ++ks) { Wf[2 * ks] = *(const s16x4*)(wrow_ + 16 * ks); Wf[2 * ks + 1] = *(const s16x4*)(wrow_ + 16 * ks + 8); } } while (0)
        SP_WLOAD(wA, 0);
        __syncthreads();
        const lds_ptr vdst = F.lds + g_ * 32768 + (cl >> 5) * 8192 + w * 64 + (cl & 31) * 2;
#pragma unroll
        for (int i = 0; i < 16; ++i) { const float rs = rsl[w + 8 * i]; f32x4 a, bq; unpack8(raw[i], a, bq);
            *(LAS u32x4*)(vdst + (i >> 1) * 1024 + (i & 1) * 512) = pack8(a * rs * g0, bq * rs * g1); }
        __syncthreads();
#define SP_GROUP(g, UC, UN, WC, WN) do { \
            asm volatile("" ::: "memory");     \
            if ((g) < 3) { SP_ULOAD(UN, (g) + 1); } \
            asm volatile("" ::: "memory"); \
            f32x16 acc[2]; \
            _Pragma("unroll") for (int r = 0; r < 16; ++r) { acc[0][r] = 0.f; acc[1][r] = 0.f; } \
            const lds_cptr vp = (lds_cptr)F.lds + (g) * 32768 + ((lane >> 4) & 1) * 32 + (lane & 3) * 8 + (4 * hi + ((lane & 15) >> 2)) * 64; \
            _Pragma("unroll") for (int ks = 0; ks < 8; ++ks) { const s16x4 alo = WC[2 * ks], ahi = WC[2 * ks + 1]; \
                const bf16x8 af = (bf16x8){alo[0], alo[1], alo[2], alo[3], ahi[0], ahi[1], ahi[2], ahi[3]}; \
                _Pragma("unroll") for (int ci = 0; ci < 2; ++ci) { const s16x4 lo = vtr(vp + (cb0 + ci) * 8192 + ks * 1024), hh = vtr(vp + (cb0 + ci) * 8192 + ks * 1024 + 512); \
                    const bf16x8 vf = (bf16x8){lo[0], lo[1], lo[2], lo[3], hh[0], hh[1], hh[2], hh[3]}; \
                    acc[ci] = __builtin_amdgcn_mfma_f32_32x32x16_bf16(af, vf, acc[ci], 0, 0, 0); } } \
            asm volatile("" ::: "memory"); if ((g) < 3) { SP_WLOAD(WN, (g) + 1); } asm volatile("" ::: "memory"); \
            _Pragma("unroll") for (int r = 0; r < 16; ++r) { const int p = 32 * pb + crow(r, hi); const float bsv = bsl[(g) * 128 + p]; \
                _Pragma("unroll") for (int ci = 0; ci < 2; ++ci) \
                    __builtin_amdgcn_raw_buffer_store_b16((short)f2bf(bf2f(UC[r * 2 + ci]) * (acc[ci][r] + bsv)), ors, ooff, (((r & 3) + 8 * (r >> 2)) * DM + 128 * (g) + 32 * ci) * 2, 0); } } while (0)
        SP_GROUP(0, uA, uB, wA, wA); SP_GROUP(1, uB, uA, wA, wA); SP_GROUP(2, uA, uB, wA, wA); SP_GROUP(3, uB, uA, wA, wA);
#undef SP_GROUP
#undef SP_ULOAD
#undef SP_WLOAD
        __syncthreads();
    }
}

constexpr int N_PHASES = 17;
struct Args { const float* in[34]; float* out; unsigned char* ws; };
#ifndef DBG_PH_END
#define DBG_PH_END 17
#endif
#ifndef DBG_CHK
#define DBG_CHK 0
#endif
__global__ void __launch_bounds__(NTHR, 2) fwd(Args args) {
    extern __shared__ __attribute__((aligned(16))) unsigned char lds_raw[];
    const unsigned long long ts_entry_ = TS_PHASE == 119 ? __builtin_amdgcn_s_memrealtime() : 0ull; (void)ts_entry_;
    const lds_ptr lds = (lds_ptr)lds_raw;
    volatile LAS unsigned* MISC = (volatile LAS unsigned*)(lds + MISC_OFF);
    const int tid0 = threadIdx.x;
    if (tid0 == 0) {
#pragma unroll
        for (int i = 0; i < 34; ++i) ((LAS unsigned long long*)(lds + PTR_OFF))[i] = (unsigned long long)args.in[i];
        ((LAS unsigned long long*)(lds + PTR_OFF))[34] = (unsigned long long)args.ws; ((LAS unsigned long long*)(lds + PTR_OFF))[35] = (unsigned long long)args.out; }
    for (int u = tid0; u < 128; u += NTHR) MISC[u] = 0u;
    LAS f32x2* T = (LAS f32x2*)(lds + ROPE_OFF);
    for (int e = tid0; e < 1024; e += NTHR) { const int pos = e >> 4, fi = e & 15; const float inv = powf(10000.f, -(float)fi / 16.f), ang = (float)pos * inv; T[e] = (f32x2){cosf(ang), sinf(ang)}; }
    __syncthreads();
#if DBG_CHK
    { XcdBarrier b0 = xcd_barrier_post((unsigned*)(args.ws + WS_CTL) + CW_BAR, MISC + 8); (void)b0; }
#else
    if (blockIdx.x == 0) for (int u = tid0; u < XCD_BAR_WORDS; u += NTHR) __hip_atomic_store((unsigned*)(args.ws + WS_CTL) + CW_BAR + u, 0u, __ATOMIC_RELAXED, __HIP_MEMORY_SCOPE_AGENT);
#endif
#if GS_AT_START && !DBG_CHK
    cooperative_groups::this_grid().sync();
    { XcdBarrier b0 = xcd_barrier_post((unsigned*)(args.ws + WS_CTL) + CW_BAR, MISC + 8); (void)b0; }
#endif
    constexpr int lo = 0, hi = DBG_PH_END;
#ifndef PH_MASK
#define PH_MASK 0x1ffff
#endif
#define IN(k) (((PH_MASK >> (k)) & 1) && lo <= (k) && (k) < hi)
#ifndef TS_PHASE
#define TS_PHASE -1
#endif
#ifndef TS_BLOCK
#define TS_BLOCK 0
#endif
#define TSTAMP(k) do { if (TS_PHASE >= 0 && ((TS_PHASE == 99 && ((k) == -1 || (k) == 16)) || (TS_PHASE >= 100 && TS_PHASE < 110 && (k) == 11) || ((k) + 1 >= TS_PHASE && (k) <= TS_PHASE)) && blockIdx.x == TS_BLOCK && threadIdx.x == 0) ((volatile LAS unsigned long long*)(lds + MISC_OFF + 256))[(k) + 1] = TS_CLK ? __builtin_amdgcn_s_memtime() : __builtin_amdgcn_s_memrealtime(); } while (0)
#define SUBTS(i) do { if (TS_PHASE >= 100 && TS_PHASE < 110 && blockIdx.x == TS_BLOCK && threadIdx.x == 0) ((volatile LAS unsigned long long*)(lds + MISC_OFF + 256))[(i)] = __builtin_amdgcn_s_memrealtime(); } while (0)
#define SEAM(k) do { const unsigned long long tsm0_ = (TS_PHASE >= 115 && TS_PHASE <= 118) ? __builtin_amdgcn_s_memrealtime() : 0ull; if (IN(k) && IN((k) + 1)) { if ((k) == 0 && DBG_CHK == 0 && !GS_AT_START) cooperative_groups::this_grid().sync(); else { XcdBarrier bar; bar.bar = (unsigned*)(mkframe().ws + WS_CTL) + CW_BAR; bar.x = xb_xcc_id(); bar.st = (volatile LAS unsigned*)(lds + MISC_OFF) + 8; xcd_barrier(bar); } } asm volatile("" ::: "memory"); if ((TS_PHASE == 115 || (TS_PHASE == 116 && (k) != 0)) && blockIdx.x == TS_BLOCK && threadIdx.x == 0) ((volatile LAS unsigned long long*)(lds + MISC_OFF + 256))[19] += __builtin_amdgcn_s_memrealtime() - tsm0_; if ((TS_PHASE == 117 || TS_PHASE == 118) && (k) >= TS_SEAM_LO && (k) <= TS_SEAM_HI && (k) != TS_SEAM_SKIP && blockIdx.x == TS_BLOCK && threadIdx.x == 0) { volatile LAS unsigned long long* ts_ = (volatile LAS unsigned long long*)(lds + MISC_OFF + 256); const unsigned long long w_ = __builtin_amdgcn_s_memrealtime() - tsm0_; if (w_ > ts_[18]) { ts_[18] = w_; ts_[20] = (unsigned long long)((k) - TS_SEAM_LO + 1); } } } while (0)
#ifndef PH_REP
#define PH_REP 0
#endif
#define REPBAR() do { XcdBarrier bar; bar.bar = (unsigned*)(mkframe().ws + WS_CTL) + CW_BAR; bar.x = xb_xcc_id(); bar.st = (volatile LAS unsigned*)(lds + MISC_OFF) + 8; xcd_barrier(bar); asm volatile("" ::: "memory"); } while (0)
#define FRAME() Frame F = mkframe(); const float* MOD = (const float*)(F.ws + WS_MOD); bf16_t* XR = (bf16_t*)(F.ws + WS_XR); const bf16_t* HN = (const bf16_t*)(F.ws + WS_HN); (void)MOD; (void)XR; (void)HN

    TSTAMP(-1);
    if (TS_PHASE == 119 && blockIdx.x == TS_BLOCK && threadIdx.x == 0) ((volatile LAS unsigned long long*)(lds + MISC_OFF + 256))[21] = __builtin_amdgcn_s_memrealtime() - ts_entry_;
    if (IN(0)) for (int rep_ = 0; rep_ <= ((PH_REP >> (0)) & 1); ++rep_) { if (rep_) REPBAR(); FRAME(); p0_prologue(F); }
    SEAM(0); TSTAMP(0);
#if !DBG_CHK && !GS_AT_START
    { XcdBarrier b0 = xcd_barrier_post((unsigned*)(args.ws + WS_CTL) + CW_BAR, MISC + 8); (void)b0; }
#endif
    if (IN(1)) for (int rep_ = 0; rep_ <= ((PH_REP >> (1)) & 1); ++rep_) { if (rep_) REPBAR(); FRAME(); mod_reduce(F); REPBAR();
        ln_phase<false>(F, 0, 0, inp(F, I_N1G), inp(F, I_X), inp(F, I_CTX), MALL, false, XR + (size_t)MLAT * DM); }
    SEAM(1); TSTAMP(1);
    if (IN(2)) for (int rep_ = 0; rep_ <= ((PH_REP >> (2)) & 1); ++rep_) { if (rep_) REPBAR(); FRAME(); Gemm g{HN, (const bf16_t*)(F.ws + WS_W_EV), MALL, 2304, DM}; pg8::StaticOrder S; S.init(MALL, 2304, F.G, obx());
        EpiEven E{F.ws, F.lds, 0.125f * LOG2E};
        pg8::gemm_phase<EpiEven, pg8::StaticOrder, PG8_ALIGN, PG8_SP2>(F.lds, g, S, E); }
    SEAM(2); TSTAMP(2);
    if (IN(3)) for (int rep_ = 0; rep_ <= ((PH_REP >> (3)) & 1); ++rep_) { if (rep_) REPBAR(); FRAME(); phase_attn_even(F); }
    SEAM(3); TSTAMP(3); TSTAMP(4);
    if (IN(5)) for (int rep_ = 0; rep_ <= ((PH_REP >> (5)) & 1); ++rep_) { if (rep_) REPBAR(); FRAME(); Gemm g{(const bf16_t*)(F.ws + WS_MIX), (const bf16_t*)(F.ws + WS_W_MIX), MALL, DM, DM}; SplitOrder S; S.init(DM, F.G, obx());
        EpiResid<false, true> E{inp(F, I_X), inp(F, I_CTX), XR, XR + (size_t)MLAT * DM, MOD + 2 * DM, (float*)(F.ws + WS_PART)};
        pg8::gemm_phase<EpiResid<false, true>, SplitOrder, PG8_ALIGN, PG8_SP2>(F.lds, g, S, E); }
    SEAM(5); TSTAMP(5);
    if (IN(6)) for (int rep_ = 0; rep_ <= ((PH_REP >> (6)) & 1); ++rep_) { if (rep_) REPBAR(); FRAME(); ln_phase<true>(F, 0, 3, inp(F, I_N2G), XR, XR + (size_t)MLAT * DM, MALL, false, XR + (size_t)MLAT * DM, (const float*)(F.ws + WS_PART)); }
    SEAM(6); TSTAMP(6);
    if (IN(7)) for (int rep_ = 0; rep_ <= ((PH_REP >> (7)) & 1); ++rep_) { if (rep_) REPBAR(); FRAME(); Gemm g{HN, (const bf16_t*)(F.ws + WS_W_FI), MALL, 2 * FFH, DM}; pg8::StaticOrder S; S.init(MALL, 2 * FFH, F.G, obx());
        EpiSwiglu E{(bf16_t*)(F.ws + WS_ACT)};
        pg8::gemm_phase<EpiSwiglu, pg8::StaticOrder, PG8_ALIGN, PG8_SP2>(F.lds, g, S, E); }
    SEAM(7); TSTAMP(7);
    if (IN(8)) for (int rep_ = 0; rep_ <= ((PH_REP >> (8)) & 1); ++rep_) { if (rep_) REPBAR(); FRAME(); int KF = FFH; asm volatile("" : "+s"(KF));
        Gemm g{(const bf16_t*)(F.ws + WS_ACT), (const bf16_t*)(F.ws + WS_W_FO), MALL, DM, KF}; SplitOrder S; S.init(KF, F.G, obx());
        EpiResid<true, true> E{XR, XR + (size_t)MLAT * DM, XR, XR + (size_t)MLAT * DM, MOD + 5 * DM, (float*)(F.ws + WS_PART)};
        pg8::gemm_phase<EpiResid<true, true>, SplitOrder, PG8_ALIGN, PG8_SP2>(F.lds, g, S, E); }
    SEAM(8); TSTAMP(8);
    if (IN(9)) for (int rep_ = 0; rep_ <= ((PH_REP >> (9)) & 1); ++rep_) { if (rep_) REPBAR(); FRAME(); ln_phase<true>(F, 1, 0, inp(F, I_N1G) + DM, XR, XR + (size_t)MLAT * DM, MALL, false, XR + (size_t)MLAT * DM, (const float*)(F.ws + WS_PART)); }
    SEAM(9); TSTAMP(9);
    if (IN(10)) for (int rep_ = 0; rep_ <= ((PH_REP >> (10)) & 1); ++rep_) { if (rep_) REPBAR(); FRAME(); Gemm g{HN, (const bf16_t*)(F.ws + WS_W_OD), MALL, 1792, DM}; OddOrder S; S.init(F.G, obx());
        EpiOdd E{F.ws, F.lds};
        pg8::gemm_phase<EpiOdd, OddOrder, PG8_ALIGN, PG8_SP2>(F.lds, g, S, E); }
    SEAM(10); TSTAMP(10);
    if (IN(11)) for (int rep_ = 0; rep_ <= ((PH_REP >> (11)) & 1); ++rep_) { if (rep_) REPBAR(); FRAME();
        int K256 = 256; asm volatile("" : "+s"(K256));
        SUBTS(20);
        { Gemm g{(const bf16_t*)(F.ws + WS_CQ), (const bf16_t*)(F.ws + WS_W_UQ), MLAT + MALL, 1280, K256}; UqkvOrder S; S.init(F.G, obx());
          EpiUqkv E{EpiUq{F.ws, F.lds, 0.08838834764831845f * LOG2E}, EpiUkv{F.ws, F.lds}};
          pg8::gemm_phase<EpiUqkv, UqkvOrder, PG8_ALIGN, PG8_SP2>(F.lds, g, S, E); }
        SUBTS(21);
        SUBTS(22);
        phase_spatial(F);
        SUBTS(23);
        if ((PH_REP >> 17) & 1) { REPBAR(); phase_spatial(F); }
        if ((PH_REP >> 18) & 1) { REPBAR();
          { Gemm g{(const bf16_t*)(F.ws + WS_CQ), (const bf16_t*)(F.ws + WS_W_UQ), MLAT, 512, K256}; pg8::StaticOrder S; S.init(MLAT, 512, F.G, obx()); EpiUq E{F.ws, F.lds, 0.08838834764831845f * LOG2E}; pg8::gemm_phase<EpiUq, pg8::StaticOrder, PG8_ALIGN, PG8_SP2>(F.lds, g, S, E); }
          { Gemm g{(const bf16_t*)(F.ws + WS_CKV), (const bf16_t*)(F.ws + WS_W_UKV), MALL, 768, K256}; pg8::StaticOrder S; S.init(MALL, 768, F.G, obx()); EpiUkv E{F.ws, F.lds}; pg8::gemm_phase<EpiUkv, pg8::StaticOrder, PG8_ALIGN, PG8_SP2>(F.lds, g, S, E); } }
        if ((PH_REP >> 19) & 1) { REPBAR();
          { Gemm g{(const bf16_t*)(F.ws + WS_CQ), (const bf16_t*)(F.ws + WS_W_UQ), MLAT, 512, K256}; pg8::StaticOrder S; S.init(MLAT, 512, F.G, obx()); EpiNull E; pg8::gemm_phase<EpiNull, pg8::StaticOrder, PG8_ALIGN, PG8_SP2>(F.lds, g, S, E); }
          { Gemm g{(const bf16_t*)(F.ws + WS_CKV), (const bf16_t*)(F.ws + WS_W_UKV), MALL, 768, K256}; pg8::StaticOrder S; S.init(MALL, 768, F.G, obx()); EpiNull E; pg8::gemm_phase<EpiNull, pg8::StaticOrder, PG8_ALIGN, PG8_SP2>(F.lds, g, S, E); } }
    }
    SEAM(11); TSTAMP(11);
#if AT_ABL
    if (IN(12)) { FRAME(); phase_attn_mla<AT_ABL>(F); REPBAR(); if (blockIdx.x == TS_BLOCK && threadIdx.x == 0) ((volatile LAS unsigned long long*)(lds + MISC_OFF + 256))[13] = __builtin_amdgcn_s_memrealtime(); phase_attn_mla<0>(F); }
    SEAM(12);
#else
    if (IN(12)) for (int rep_ = 0; rep_ <= ((PH_REP >> (12)) & 1); ++rep_) { if (rep_) REPBAR(); FRAME(); phase_attn_mla<0>(F); }
    SEAM(12); TSTAMP(12);
#endif
    if (IN(13)) for (int rep_ = 0; rep_ <= ((PH_REP >> (13)) & 1); ++rep_) { if (rep_) REPBAR(); FRAME(); Gemm g{(const bf16_t*)(F.ws + WS_MIX), (const bf16_t*)(F.ws + WS_W_MIX + 2 * MiB), MLAT, DM, DM}; pg8::StaticOrder S; S.init(MLAT, DM, F.G, obx());
        EpiResid<true, true> E{XR, XR, XR, XR, MOD + 9 * 6144 + 2 * DM, nullptr};
        pg8::gemm_phase<EpiResid<true, true>, pg8::StaticOrder, PG8_ALIGN, PG8_SP2>(F.lds, g, S, E); }
    SEAM(13); TSTAMP(13);
    if (IN(14)) for (int rep_ = 0; rep_ <= ((PH_REP >> (14)) & 1); ++rep_) { if (rep_) REPBAR(); FRAME(); ln_phase<true>(F, 1, 3, inp(F, I_N2G) + DM, XR, XR, MLAT, false); }
    SEAM(14); TSTAMP(14);
    if (IN(15)) for (int rep_ = 0; rep_ <= ((PH_REP >> (15)) & 1); ++rep_) { if (rep_) REPBAR(); FRAME(); Gemm g{HN, (const bf16_t*)(F.ws + WS_W_FI + 11 * MiB), MLAT, 2 * FFH, DM}; pg8::StaticOrder S; S.init(MLAT, 2 * FFH, F.G, obx());
        EpiSwiglu E{(bf16_t*)(F.ws + WS_ACT)};
        pg8::gemm_phase<EpiSwiglu, pg8::StaticOrder, PG8_ALIGN, PG8_SP2>(F.lds, g, S, E); }
    SEAM(15); TSTAMP(15);
    if (IN(16)) for (int rep_ = 0; rep_ <= ((PH_REP >> (16)) & 1); ++rep_) { if (rep_) REPBAR(); FRAME(); Gemm g{(const bf16_t*)(F.ws + WS_ACT), (const bf16_t*)(F.ws + WS_W_FO + 6 * MiB), MLAT, DM, FFH}; pg8::StaticOrder S; S.init(MLAT, DM, F.G, obx());
        EpiResid<true, false> E{XR, XR, F.out, F.out, MOD + 9 * 6144 + 5 * DM, nullptr};
        pg8::gemm_phase<EpiResid<true, false>, pg8::StaticOrder, PG8_ALIGN, PG8_SP2>(F.lds, g, S, E); }
    if (TS_PHASE >= 0) { TSTAMP(16); REPBAR();
        if (blockIdx.x == TS_BLOCK && threadIdx.x == 0) { volatile LAS unsigned long long* ts = (volatile LAS unsigned long long*)(lds + MISC_OFF + 256); const float us = TS_PHASE == 119 ? (float)ts[21] * 0.01f : TS_PHASE == 118 ? (float)ts[18] * 0.1f : TS_PHASE == 117 ? ((float)ts[20] * 10.f + fminf((float)ts[18] * 0.001f, 9.f)) * 100.f : TS_PHASE == 113 ? (float)ts[29] * 0.1f : (TS_PHASE == 115 || TS_PHASE == 116) ? (float)ts[19] * 0.01f : TS_PHASE == 110 ? (float)ts[28] * 0.1f : TS_PHASE == 111 ? (float)ts[29] * 0.01f : TS_PHASE == 112 ? (float)ts[30] * 0.01f : TS_PHASE == 105 ? (float)ts[24] * 0.1f : TS_PHASE == 106 ? (float)ts[25] * 0.01f : TS_PHASE == 107 ? (float)ts[26] * 0.1f : TS_PHASE == 108 ? (float)ts[27] * 10.f : TS_PHASE == 99 ? (float)(ts[17] - ts[0]) * 0.01f - 2000.f : TS_PHASE == 101 ? (float)(ts[21] - ts[20]) * 0.1f : TS_PHASE == 102 ? (float)(ts[22] - ts[21]) * 0.1f : TS_PHASE == 103 ? (float)(ts[23] - ts[22]) * 0.1f : TS_PHASE == 104 ? (float)(ts[12] - ts[23]) * 0.1f : (float)(ts[TS_PHASE < 100 ? TS_PHASE + 1 : 0] - ts[TS_PHASE < 100 ? TS_PHASE : 0]) * 0.01f; mkframe().out[0] += (us - (float)TS_SUB) * 0.01f * TS_SCALE; } }
#undef IN
#undef SEAM
#undef FRAME
}
}

#ifndef DBG_CHK
#define DBG_CHK 0
#endif
#ifndef DBG_PH_END
#define DBG_PH_END 17
#endif

#if DBG_CHK
namespace dbg {
using namespace mk;
constexpr int RS = 3, NRS = (nv::R + RS - 1) / RS;
__device__ __forceinline__ size_t mrow(int r) { return r < 4096 ? (size_t)r : (size_t)MLAT + (r - 4096); }
__device__ __forceinline__ float kimg_get(const unsigned char* base, int slot_bytes, int bh, int r, int d) {
    const int kt = r >> 6, kk = r & 63; const unsigned char* img = base + ((size_t)bh * NKT + kt) * slot_bytes; return bf2f(*(const bf16_t*)(img + (d >> 3) * 1024 + kk * 16 + (d & 7) * 2)); }
__device__ __forceinline__ float vimg_get(const unsigned char* base, int slot_bytes, int bh, int r, int dv) {
    const int kt = r >> 6, kk = r & 63; const unsigned char* img = base + ((size_t)bh * NKT + kt) * slot_bytes; return bf2f(*(const bf16_t*)(img + (dv >> 5) * 4096 + (kk >> 4) * 1024 + (kk & 15) * 64 + (dv & 31) * 2)); }
template <int CHK> __device__ __forceinline__ int ncols() { return CHK == 2 ? 2304 : CHK == 6 ? 2048 : 1024; }
template <int CHK> __global__ void k_snap(const unsigned char* ws, float* SNAP) {
    const int NC = ncols<CHK>(); const size_t idx = (size_t)blockIdx.x * 256 + threadIdx.x; if (idx >= (size_t)NRS * NC) return;
    const int rs = (int)(idx / NC), c = (int)(idx % NC), r = rs * RS; const size_t m = mrow(r); float v = 0.f;
    if (CHK == 1) v = bf2f(((const bf16_t*)(ws + WS_HN))[m * DM + c]);
    else if (CHK == 2) {
        if (c < 1024) v = bf2f(((const bf16_t*)(ws + WS_Q))[m * DM + c]) / (0.125f * LOG2E);
        else if (c < 1152) v = kimg_get(ws + WS_KA, 8192, (c - 1024) >> 6, r, c & 63);
        else if (c < 1280) v = vimg_get(ws + WS_VA, 8192, (c - 1152) >> 6, r, c & 63);
        else if (c < 1792) v = kimg_get(ws + WS_KB, 8192, (c - 1280) >> 6, r, c & 63);
        else v = vimg_get(ws + WS_VB, 16384, (c - 1792) >> 7, r, (c - 1792) & 127);
    } else if (CHK == 3 || CHK == 7) v = bf2f(((const bf16_t*)(ws + WS_MIX))[m * DM + c]);
    else if (CHK == 4 || CHK == 5) v = bf2f(((const bf16_t*)(ws + WS_XR))[m * DM + c]);
    else if (CHK == 6) {
        if (c < 512) v = r < 4096 ? bf2f(((const bf16_t*)(ws + WS_Q2))[m * 512 + c]) / (0.08838834764831845f * LOG2E) : 0.f;
        else if (c < 1024) v = kimg_get(ws + WS_KD, 16384, (c - 512) >> 7, r, (c - 512) & 127);
        else if (c < 1536) v = vimg_get(ws + WS_VD, 16384, (c - 1024) >> 7, r, (c - 1024) & 127);
        else v = r < 4096 ? bf2f(((const bf16_t*)(ws + WS_MIX))[m * DM + (c - 1536)]) : 0.f;
    }
    SNAP[idx] = v;
}
template <int CHK> __global__ void k_cmp(nv::Bufs B, const float* SNAP, unsigned* res) {
    const int NC = ncols<CHK>(); const size_t idx = (size_t)blockIdx.x * 256 + threadIdx.x; if (idx >= (size_t)NRS * NC) return;
    const int rs = (int)(idx / NC), c = (int)(idx % NC), r = rs * RS; float ref = 0.f; bool skip = false;
    if (CHK == 1) ref = B.H[(size_t)r * 1024 + c];
    else if (CHK == 2) ref = B.PL[(size_t)r * 2304 + c];
    else if (CHK == 3) ref = B.MIX[(size_t)r * 1024 + c];
    else if (CHK == 7) { ref = B.MIX[(size_t)r * 1024 + c]; skip = r >= 4096; }
    else if (CHK == 4 || CHK == 5) ref = B.X[(size_t)r * 1024 + c];
    else if (CHK == 6) {
        if (c < 512) { ref = B.QU[(size_t)r * 512 + c]; skip = r >= 4096; }
        else if (c < 1024) ref = B.KC[(size_t)r * 512 + (c - 512)];
        else if (c < 1536) { const int h = (c - 1024) >> 7, dv = (c - 1024) & 127; ref = B.KVU[(size_t)r * 768 + h * 192 + 64 + dv]; }
        else { ref = B.MIX[(size_t)r * 1024 + (c - 1536)]; skip = r >= 4096; }
    }
    if (skip) return;
    const float d = fabsf(ref - SNAP[idx]);
    atomicMax(res + 0, __float_as_uint(d == d ? d : INFINITY)); atomicMax(res + 1, __float_as_uint(fabsf(ref)));
}
__global__ void k_cmp_mod(const float* modA, const float* modB, unsigned* res) {
    const int idx = blockIdx.x * 256 + threadIdx.x; if (idx >= 2 * 9 * 6144) return;
    const float d = fabsf(modA[idx] - modB[idx]); atomicMax(res + 0, __float_as_uint(d == d ? d : INFINITY)); atomicMax(res + 1, __float_as_uint(fabsf(modA[idx])));
}
__global__ void k_code(float* out, size_t n, const unsigned* res, float thresh) {
    const float md = __uint_as_float(res[0]), mr = __uint_as_float(res[1]); const float rel = md / fmaxf(mr, 1e-20f);
    float code = 0.f; if (!(rel <= thresh)) code = 10.f + log10f(fminf(fmaxf(rel, 1e-9f), 1e9f));
    if (mr == 0.f) code = 77.f;
    if (code == 0.f) return;
    for (size_t i = (size_t)blockIdx.x * 256 + threadIdx.x; i < n; i += (size_t)gridDim.x * 256) out[i] += code;
}
static float* g_snap; static unsigned* g_res; static const float* g_mod_mk;
static void hook(int k, const nv::Bufs& B, hipStream_t st) {
    if (k != DBG_CHK) return;
    const size_t n = (size_t)NRS * (DBG_CHK == 2 ? 2304 : DBG_CHK == 6 ? 2048 : 1024);
    hipLaunchKernelGGL(k_cmp<DBG_CHK>, dim3((unsigned)((n + 255) / 256)), dim3(256), 0, st, B, (const float*)g_snap, g_res);
    if (DBG_CHK == 1) hipLaunchKernelGGL(k_cmp_mod, dim3((2 * 9 * 6144 + 255) / 256), dim3(256), 0, st, (const float*)B.MOD, g_mod_mk, g_res);
}
}
#endif

extern "C" void kernel_launch(void* const* d_in, const int* in_sizes, int n_in, void* d_out, int out_size, void* d_ws, size_t ws_size, hipStream_t stream) {
    static int grid = 0;
    if (grid == 0) {
        int dev = 0, cus = 0, per_cu = 0;
        hipGetDevice(&dev); hipDeviceGetAttribute(&cus, hipDeviceAttributeMultiprocessorCount, dev);
        if (hipFuncSetAttribute((const void*)mk::fwd, hipFuncAttributeMaxDynamicSharedMemorySize, mk::LDS_BYTES) != hipSuccess) fprintf(stderr, "kernel_launch: hipFuncSetAttribute failed\n");
        if (hipOccupancyMaxActiveBlocksPerMultiprocessor(&per_cu, (const void*)mk::fwd, mk::NTHR, mk::LDS_BYTES) != hipSuccess || per_cu < 1) { fprintf(stderr, "kernel_launch: occupancy query says %d\n", per_cu); per_cu = 1; }
        (void)hipGetLastError();
        grid = cus * per_cu;
        if (grid != 256) fprintf(stderr, "kernel_launch: grid %d (cus %d x %d) != 256: the static work split assumes 256 workgroups\n", grid, cus, per_cu);
        if (n_in != 34 || ws_size < mk::WS_END) fprintf(stderr, "kernel_launch: unexpected n_in %d / ws_size %zu\n", n_in, ws_size);
    }
#if DBG_CHK
    hipMemsetAsync((char*)d_ws + mk::WS_CTL, 0, mk::CTL_ZERO_BYTES, stream);
#endif
    mk::Args a{};
    for (int i = 0; i < 34; ++i) a.in[i] = (const float*)d_in[i];
    a.out = (float*)d_out; a.ws = (unsigned char*)d_ws;
#if DBG_CHK
    {
        hipLaunchKernelGGL(mk::fwd, dim3(grid), dim3(mk::NTHR), mk::LDS_BYTES, stream, a);
        float* SNAP = (float*)((char*)d_ws + mk::WS_SNAP); unsigned* res = (unsigned*)((char*)d_ws + mk::WS_END - 4096);
        const size_t n = (size_t)dbg::NRS * (DBG_CHK == 2 ? 2304 : DBG_CHK == 6 ? 2048 : 1024);
        hipLaunchKernelGGL(dbg::k_snap<DBG_CHK>, dim3((unsigned)((n + 255) / 256)), dim3(256), 0, stream, (const unsigned char*)d_ws, SNAP);
        float* modc = (float*)((char*)d_ws + mk::WS_END - 1024 * 1024);
        hipMemcpyAsync(modc, (char*)d_ws + mk::WS_MOD, 2 * 9 * 6144 * 4, hipMemcpyDeviceToDevice, stream);
        hipMemsetAsync(res, 0, 64, stream);
        dbg::g_snap = SNAP; dbg::g_res = res; dbg::g_mod_mk = modc;
        nv::In I; const float** ip = (const float**)&I; for (int i = 0; i < 34; ++i) ip[i] = (const float*)d_in[i];
        nv::forward(I, (float*)d_out, (float*)d_ws, 0, 8, stream, dbg::hook);
        hipLaunchKernelGGL(dbg::k_code, dim3(1024), dim3(256), 0, stream, (float*)d_out, (size_t)out_size, (const unsigned*)res, 0.03f);
    }
#else
    void* args[] = {&a};
    hipError_t e = hipLaunchCooperativeKernel((const void*)mk::fwd, dim3(grid), dim3(mk::NTHR), args, mk::LDS_BYTES, stream);
    if (e != hipSuccess) fprintf(stderr, "kernel_launch: cooperative launch failed: %s (grid %d)\n", hipGetErrorString(e), grid);
#endif
}
```

```cpp
#define DBG_CHK 0
#define DBG_PH_END 17
#include <hip/hip_runtime.h>
#include <cstdio>
#include <cstdint>
#ifndef TS_PHASE
#define TS_PHASE -1
#endif
#ifndef TS_BLOCK
#define TS_BLOCK 0
#endif
#define TS_GEMM (TS_PHASE >= 110 && TS_PHASE <= 114)
#ifndef TS_GEMM_ID
#define TS_GEMM_ID -1
#endif
#ifndef PG8_PRIO
#define PG8_PRIO 1
#endif
#ifndef PG8_WGM
#define PG8_WGM 8
#endif
namespace pg8 {
#define PG8_LAS __attribute__((address_space(3)))
typedef unsigned short bf16_t;
typedef short bf16x8 __attribute__((ext_vector_type(8)));
typedef float f32x4 __attribute__((ext_vector_type(4)));
typedef unsigned u32x4 __attribute__((ext_vector_type(4)));
constexpr int BM = 256, BK = 64, HALF = 128, HTB = HALF * BK * 2  , STAGE_BYTES = 8 * HTB, NXCD = 8, WGM = PG8_WGM;

__host__ __device__ __forceinline__ int lds_byte(int r, int c) { const int st = (r >> 4) * 2 + (c >> 5), rr = r & 15, cc = c & 31, ob = rr * 64 + cc * 2; return st * 1024 + (ob ^ (((ob >> 9) & 1) << 5)); }
__host__ __device__ __forceinline__ void stage_rc(int b, int& R, int& C) { const int st = b / 1024, sb = b % 1024, swz = sb ^ (((sb >> 9) & 1) << 5); R = (st >> 1) * 16 + swz / 64; C = (st & 1) * 32 + (swz % 64) / 2; }
__host__ __device__ __forceinline__ int perm32(int rho) { const int n = rho >> 4, i = rho & 15; return 8 * (i >> 2) + 4 * n + (i & 3); }

struct Unit { int pm, pn, k0, nt, aux; };
struct Gemm { const bf16_t* A; const bf16_t* Bt; int M, N, K; };

struct StaticOrder {
    int nM, nN, nwg, G, c;
    __host__ __device__ void init(int M, int N, int G_, int c_) { nM = M / BM; nN = N / BM; nwg = nM * nN; G = G_; c = c_; }
    __host__ __device__ bool next(int i, Unit& u) const {
        const long L = (long)i * G + c; if (L >= nwg) return false;
        int wgid = (int)L; { const int q = nwg / NXCD, r = nwg % NXCD, xcd = wgid % NXCD, off = wgid / NXCD; wgid = (xcd < r ? xcd * (q + 1) : r * (q + 1) + (xcd - r) * q) + off; }
        const int nig = WGM * nN, gid = wgid / nig, fm = gid * WGM, gsz = (nM - fm) < WGM ? (nM - fm) : WGM;
        u.pm = fm + ((wgid % nig) % gsz); u.pn = (wgid % nig) / gsz; u.k0 = 0; u.nt = 0; u.aux = 0; return true;
    }
    __device__ __forceinline__ void a_ready(const Unit&) const {}
    __device__ __forceinline__ void done(const Unit&) const {}
};

__device__ __forceinline__ unsigned cvt_pk_bf16(float lo, float hi) { unsigned r; asm volatile("v_cvt_pk_bf16_f32 %0, %1, %2" : "=v"(r) : "v"(lo), "v"(hi)); return r; }
typedef float f32x2 __attribute__((ext_vector_type(2)));
__device__ __forceinline__ f32x2 gelu_pk(f32x2 v) {
    const f32x2 av = __builtin_elementwise_abs(v), d = av * 0.2316418882f + 1.0f;
    f32x2 t; t.x = __builtin_amdgcn_rcpf(d.x); t.y = __builtin_amdgcn_rcpf(d.y);
    f32x2 q = t * 0.5307027145f + (-0.7265760135f); q = q * t + 0.7107068705f; q = q * t + (-0.142248368f); q = q * t + 0.127414796f; q = q * t;
    const f32x2 s = (v * v) * (-0.72134752044f);
    f32x2 e; e.x = __builtin_amdgcn_exp2f(s.x); e.y = __builtin_amdgcn_exp2f(s.y);
    const f32x2 m = v * (q * e), r = v - m;
    f32x2 o; o.x = v.x < 0.f ? m.x : r.x; o.y = v.y < 0.f ? m.y : r.y; return o;
}

template <int ACT  > struct EpiBf16 {
    static constexpr bool PERM = true, AFTER_DRAIN = false; static_assert(ACT == 0 || ACT == 1, "EpiBf16: ACT is 0 (none) or 1 (gelu_pk)");
    bf16_t* O; int ldc; const float* bias; int split_cols; size_t split_stride; float scale0;
    __device__ __forceinline__ void operator()(const f32x4 (&acc)[2][2][4][2], const Unit& u, int wr, int wc, int fr, int fq) const {
        const int row0 = u.pm * BM + wr * 64 + fr; int colt = u.pn * BM; bf16_t* base = O;
        float sc = 1.f; if (split_cols) { const int t = colt / split_cols; base += (size_t)t * split_stride; colt -= t * split_cols; if (t == 0) sc = scale0; }
        const int col0 = colt + wc * 32 + 8 * fq, bcol0 = u.pn * BM + wc * 32 + 8 * fq;
        f32x4 bv[2][2];
#pragma unroll
        for (int bj = 0; bj < 2; ++bj)
#pragma unroll
            for (int n = 0; n < 2; ++n) bv[bj][n] = bias ? *(const f32x4*)(bias + bcol0 + bj * HALF + 4 * n) : (f32x4){0.f, 0.f, 0.f, 0.f};
#pragma unroll
        for (int ai = 0; ai < 2; ++ai)
#pragma unroll
            for (int m = 0; m < 4; ++m) { bf16_t* rowp = base + (size_t)(row0 + ai * HALF + m * 16) * ldc + col0;
#pragma unroll
                for (int bj = 0; bj < 2; ++bj) { f32x4 v0 = acc[ai][bj][m][0] + bv[bj][0], v1 = acc[ai][bj][m][1] + bv[bj][1];
                    if (ACT == 1) { f32x2 a = gelu_pk((f32x2){v0[0], v0[1]}), b = gelu_pk((f32x2){v0[2], v0[3]}), c = gelu_pk((f32x2){v1[0], v1[1]}), d = gelu_pk((f32x2){v1[2], v1[3]});
                        v0 = (f32x4){a.x, a.y, b.x, b.y}; v1 = (f32x4){c.x, c.y, d.x, d.y}; }
                    v0 = v0 * sc; v1 = v1 * sc; u32x4 w; w.x = cvt_pk_bf16(v0[0], v0[1]); w.y = cvt_pk_bf16(v0[2], v0[3]); w.z = cvt_pk_bf16(v1[0], v1[1]); w.w = cvt_pk_bf16(v1[2], v1[3]);
                    *(u32x4*)(rowp + bj * HALF) = w; } }
    }
};

struct PanelStats {
    unsigned* xbuf;
    unsigned* cnt;
    unsigned* tmo;
    int ntn; float eps;
    unsigned code;
    __device__ __forceinline__ bool run(const f32x4 (&v)[2][2][4][2], const Unit& u, int wr, int wc, int fr, int fq, PG8_LAS unsigned char* lds, int wid, int lane) const {
        typedef float f32x2v __attribute__((ext_vector_type(2)));
        PG8_LAS f32x2v* P = (PG8_LAS f32x2v*)lds;
        PG8_LAS f32x2v* S = (PG8_LAS f32x2v*)(lds + 8192);
        PG8_LAS unsigned* flag = (PG8_LAS unsigned*)(lds + 8192 + 2048);
#pragma unroll
        for (int ai = 0; ai < 2; ++ai)
#pragma unroll
            for (int m = 0; m < 4; ++m) {
                float s = 0.f;
#pragma unroll
                for (int bj = 0; bj < 2; ++bj)
#pragma unroll
                    for (int n = 0; n < 2; ++n) { const f32x4 x = v[ai][bj][m][n]; s += (x[0] + x[1]) + (x[2] + x[3]); }
                s += __shfl_xor(s, 16); s += __shfl_xor(s, 32);
                const float mw = s * (1.0f / 64.0f); float q = 0.f;
#pragma unroll
                for (int bj = 0; bj < 2; ++bj)
#pragma unroll
                    for (int n = 0; n < 2; ++n) { const f32x4 d = v[ai][bj][m][n] - mw; q += (d[0] * d[0] + d[1] * d[1]) + (d[2] * d[2] + d[3] * d[3]); }
                q += __shfl_xor(q, 16); q += __shfl_xor(q, 32);
                if (fq == 0) P[(ai * HALF + wr * 64 + m * 16 + fr) * 4 + wc] = (f32x2v){mw, q};
            }
        asm volatile("s_waitcnt lgkmcnt(0)" ::: "memory"); __builtin_amdgcn_s_barrier(); asm volatile("" ::: "memory");
#if defined(BROKEN_EXCHANGE_NO_WAIT)
#warning BROKEN CONTROL BUILD: the row-statistics exchange does not wait; results are wrong by design
        if (blockIdx.x >= 64) { const long long t0_ = clock64(); while (clock64() - t0_ < 60000) __builtin_amdgcn_s_sleep(8); }
#endif
        const int row = wid * 32 + (lane & 31);
        if (lane < 32) {
            const f32x2v a = P[row * 4 + 0], b = P[row * 4 + 1], c = P[row * 4 + 2], d = P[row * 4 + 3];
            const float mt = (a.x + b.x + c.x + d.x) * 0.25f;
            const float da = a.x - mt, db = b.x - mt, dc = c.x - mt, dd = d.x - mt;
            const float m2 = (a.y + b.y) + (c.y + d.y) + 64.0f * ((da * da + db * db) + (dc * dc + dd * dd));
            unsigned long long* slot = (unsigned long long*)xbuf + ((size_t)(u.pm * BM + row) * 4 + u.pn);
            __hip_atomic_store(slot, ((unsigned long long)__float_as_uint(m2) << 32) | __float_as_uint(mt), __ATOMIC_RELAXED, __HIP_MEMORY_SCOPE_AGENT);
        }
        asm volatile("s_waitcnt vmcnt(0)" ::: "memory");
        if (lane == 0) __hip_atomic_fetch_add(cnt + 64 * u.pm, 1u, __ATOMIC_RELAXED, __HIP_MEMORY_SCOPE_AGENT);
        if (wid == 0) {
            bool dead = false; const unsigned long long t0 = __builtin_amdgcn_s_memrealtime(); const unsigned want = 8u * (unsigned)ntn;
            for (;;) {
#if defined(BROKEN_EXCHANGE_NO_WAIT)
                break;
#endif
                if ((unsigned)__builtin_amdgcn_readfirstlane(__hip_atomic_load(cnt + 64 * u.pm, __ATOMIC_RELAXED, __HIP_MEMORY_SCOPE_AGENT)) >= want) break;
                if (__builtin_amdgcn_s_memrealtime() - t0 > 2000000ull) {
                    if (lane == 0) { unsigned expect = 0u; __hip_atomic_compare_exchange_strong(tmo + 1, &expect, code | (unsigned)(u.pm & 0xff), __ATOMIC_RELAXED, __ATOMIC_RELAXED, __HIP_MEMORY_SCOPE_AGENT);
                                     __hip_atomic_store(tmo, 1u, __ATOMIC_RELAXED, __HIP_MEMORY_SCOPE_AGENT); }
                    dead = true; break; }
                __builtin_amdgcn_s_sleep(2);
            }
            __builtin_amdgcn_fence(__ATOMIC_ACQUIRE, "agent");
            if (lane == 0) flag[0] = dead ? 1u : 0u;
        }
        asm volatile("s_waitcnt vmcnt(0) lgkmcnt(0)" ::: "memory"); __builtin_amdgcn_s_barrier(); asm volatile("" ::: "memory");
        const bool bad = flag[0] != 0u;
        if (lane < 32) {
            const unsigned long long* slot = (const unsigned long long*)xbuf + (size_t)(u.pm * BM + row) * 4; float mt[4], m2[4]; float ms = 0.f;
#pragma unroll
            for (int t = 0; t < 4; ++t) { if (t < ntn) { const unsigned long long w = __hip_atomic_load(slot + t, __ATOMIC_RELAXED, __HIP_MEMORY_SCOPE_AGENT); mt[t] = __uint_as_float((unsigned)w); m2[t] = __uint_as_float((unsigned)(w >> 32)); } else { mt[t] = 0.f; m2[t] = 0.f; } ms += mt[t]; }
            const float mean = ms / (float)ntn; float q = 0.f;
#pragma unroll
            for (int t = 0; t < 4; ++t) if (t < ntn) { const float dm = mt[t] - mean; q += m2[t] + 256.0f * dm * dm; }
            S[row] = (f32x2v){mean, 1.0f / sqrtf(q / (256.0f * (float)ntn) + eps)};
        }
        asm volatile("s_waitcnt lgkmcnt(0)" ::: "memory"); __builtin_amdgcn_s_barrier(); asm volatile("" ::: "memory");
        return bad;
    }
};
struct EpiLnRes {
    static constexpr bool PERM = false, AFTER_DRAIN = true;
    const float* base; float* out; int ldc; const float* bias; PanelStats st; unsigned poison;
    __device__ __forceinline__ void fused(f32x4 (&acc)[2][2][4][2], const Unit& u, int wr, int wc, int fr, int fq, PG8_LAS unsigned char* lds, int wid, int lane) const {
        typedef float f32x2v __attribute__((ext_vector_type(2)));
        const PG8_LAS f32x2v* S = (const PG8_LAS f32x2v*)(lds + 8192);
        const int col0 = u.pn * BM + wc * 32 + 4 * fq;
#pragma unroll
        for (int bj = 0; bj < 2; ++bj)
#pragma unroll
            for (int n = 0; n < 2; ++n) { const f32x4 bv = bias ? *(const f32x4*)(bias + col0 + bj * HALF + n * 16) : (f32x4){0.f, 0.f, 0.f, 0.f};
#pragma unroll
                for (int ai = 0; ai < 2; ++ai)
#pragma unroll
                    for (int m = 0; m < 4; ++m) acc[ai][bj][m][n] += bv; }
        f32x4 pre[4][2][2];
#pragma unroll
        for (int m = 0; m < 4; ++m) { const size_t off = (size_t)(u.pm * BM + wr * 64 + m * 16 + fr) * ldc + col0;
#pragma unroll
            for (int bj = 0; bj < 2; ++bj)
#pragma unroll
                for (int n = 0; n < 2; ++n) pre[m][bj][n] = *(const f32x4*)(base + off + bj * HALF + n * 16); }
        const bool bad = st.run(acc, u, wr, wc, fr, fq, lds, wid, lane) || poison != 0u;
        const float qnan = __builtin_nanf("");
#pragma unroll
        for (int ai = 0; ai < 2; ++ai)
#pragma unroll
            for (int m = 0; m < 4; ++m) { const int r = ai * HALF + wr * 64 + m * 16 + fr; const f32x2v sr = S[r]; const size_t off = (size_t)(u.pm * BM + r) * ldc + col0;
#pragma unroll
                for (int bj = 0; bj < 2; ++bj)
#pragma unroll
                    for (int n = 0; n < 2; ++n) { const f32x4 bs = ai == 0 ? pre[m][bj][n] : *(const f32x4*)(base + off + bj * HALF + n * 16); f32x4 o = bs + (acc[ai][bj][m][n] - sr.x) * sr.y;
                        if (bad) o = (f32x4){qnan, qnan, qnan, qnan}; *(f32x4*)(out + off + bj * HALF + n * 16) = o; }
                if (m & 1) asm volatile("" ::: "memory"); }
    }
};
struct EpiLnResLn {
    static constexpr bool PERM = false, AFTER_DRAIN = true;
    const float* base; float* out; bf16_t* xn; int ldc; const float* bias; PanelStats st1, st2; unsigned poison;
    __device__ __forceinline__ void fused(f32x4 (&acc)[2][2][4][2], const Unit& u, int wr, int wc, int fr, int fq, PG8_LAS unsigned char* lds, int wid, int lane) const {
        typedef float f32x2v __attribute__((ext_vector_type(2))); typedef unsigned u32x2v __attribute__((ext_vector_type(2)));
        const PG8_LAS f32x2v* S = (const PG8_LAS f32x2v*)(lds + 8192);
        const int col0 = u.pn * BM + wc * 32 + 4 * fq;
#pragma unroll
        for (int bj = 0; bj < 2; ++bj)
#pragma unroll
            for (int n = 0; n < 2; ++n) { const f32x4 bv = bias ? *(const f32x4*)(bias + col0 + bj * HALF + n * 16) : (f32x4){0.f, 0.f, 0.f, 0.f};
#pragma unroll
                for (int ai = 0; ai < 2; ++ai)
#pragma unroll
                    for (int m = 0; m < 4; ++m) acc[ai][bj][m][n] += bv; }
        bool bad = st1.run(acc, u, wr, wc, fr, fq, lds, wid, lane) || poison != 0u;
        const float qnan = __builtin_nanf("");
#pragma unroll
        for (int ai = 0; ai < 2; ++ai)
#pragma unroll
            for (int m = 0; m < 4; ++m) { const int r = ai * HALF + wr * 64 + m * 16 + fr; const f32x2v sr = S[r]; const size_t off = (size_t)(u.pm * BM + r) * ldc + col0;
#pragma unroll
                for (int bj = 0; bj < 2; ++bj)
#pragma unroll
                    for (int n = 0; n < 2; ++n) { const f32x4 bs = *(const f32x4*)(base + off + bj * HALF + n * 16); acc[ai][bj][m][n] = bs + (acc[ai][bj][m][n] - sr.x) * sr.y; }
                asm volatile("" : "+v"(acc[ai][0][m][0]), "+v"(acc[ai][0][m][1]), "+v"(acc[ai][1][m][0]), "+v"(acc[ai][1][m][1]));
                if (m & 1) asm volatile("" ::: "memory"); }
        const bool bad1 = bad;
        bad = st2.run(acc, u, wr, wc, fr, fq, lds, wid, lane) || bad;
#pragma unroll
        for (int ai = 0; ai < 2; ++ai)
#pragma unroll
            for (int m = 0; m < 4; ++m) { const int r = ai * HALF + wr * 64 + m * 16 + fr; const f32x2v sr = S[r]; const size_t off = (size_t)(u.pm * BM + r) * ldc + col0;
#pragma unroll
                for (int bj = 0; bj < 2; ++bj)
#pragma unroll
                    for (int n = 0; n < 2; ++n) { const f32x4 x1 = acc[ai][bj][m][n]; *(f32x4*)(out + off + bj * HALF + n * 16) = bad1 ? (f32x4){qnan, qnan, qnan, qnan} : x1;
                        const f32x4 o = (x1 - sr.x) * sr.y; u32x2v w; w.x = cvt_pk_bf16(o[0], o[1]); w.y = cvt_pk_bf16(o[2], o[3]);
                        if (bad) { w.x = 0x7fc07fc0u; w.y = 0x7fc07fc0u; } *(u32x2v*)(xn + off + bj * HALF + n * 16) = w; }
                asm volatile("" ::: "memory"); }
    }
};

template <class Epi, class Sched, bool ALIGN_EPI = false, bool SP2 = false>
__device__ __forceinline__ void gemm_phase(PG8_LAS unsigned char* lds, const Gemm g, const Sched& S, const Epi& E) {
    int tid_ = threadIdx.x; asm volatile("" : "+v"(tid_));
    const int tid = tid_, wid = __builtin_amdgcn_readfirstlane(tid >> 6), lane = tid & 63, wr = wid >> 2, wc = wid & 3, fr = lane & 15, fq = lane >> 4;
    const int K = g.K, ntf = K / BK;
    unsigned voffA[2], voffB[2];
#pragma unroll
    for (int i = 0; i < 2; ++i) { int R, C; stage_rc(tid * 16 + i * 8192, R, C); const int Rb = Epi::PERM ? ((R & ~31) + perm32(R & 31)) : R;
        voffA[i] = (unsigned)(R * K + C) * 2u; voffB[i] = (unsigned)(Rb * K + C) * 2u; }
    const size_t kstep = (size_t)(BK * 2);
    const size_t hstep = (size_t)HALF * K * 2;
    const size_t tstep = 2 * hstep;
    const unsigned ldsw = (unsigned)wid * 1024u;
    const int aoff = lds_byte(wr * 64 + fr, fq * 8), boff = lds_byte(wc * 32 + fr, fq * 8);
#define PG8_SA(b, h) (((b) * 2 + (h)) * HTB)
#define PG8_SB(b, h) ((4 + (b) * 2 + (h)) * HTB)
#define PG8_STAGE(bufoff, gbase, voff) do { _Pragma("unroll") for (int _i = 0; _i < 2; ++_i) \
        __builtin_amdgcn_global_load_lds((const unsigned*)((const char*)(gbase) + (voff)[_i]), (PG8_LAS unsigned*)(lds + (bufoff) + ldsw + _i * 8192), 16, 0, 0); } while (0)
#define PG8_LDA(dst, b, h) do { _Pragma("unroll") for (int m = 0; m < 4; ++m) _Pragma("unroll") for (int k = 0; k < 2; ++k) dst[m][k] = *(const PG8_LAS bf16x8*)(lds + PG8_SA(b, h) + aoff + m * 2048 + k * 1024); } while (0)
#define PG8_LDB(dst, b, h) do { _Pragma("unroll") for (int n = 0; n < 2; ++n) _Pragma("unroll") for (int k = 0; k < 2; ++k) dst[n][k] = *(const PG8_LAS bf16x8*)(lds + PG8_SB(b, h) + boff + n * 2048 + k * 1024); } while (0)
#define PG8_MMA(ai, bj, At, Bt) do { if (PG8_PRIO) __builtin_amdgcn_s_setprio(PG8_PRIO); _Pragma("unroll") for (int m = 0; m < 4; ++m) _Pragma("unroll") for (int n = 0; n < 2; ++n) _Pragma("unroll") for (int k = 0; k < 2; ++k) \
        acc[ai][bj][m][n] = __builtin_amdgcn_mfma_f32_16x16x32_bf16(Bt[n][k], At[m][k], acc[ai][bj][m][n], 0, 0, 0); if (PG8_PRIO) __builtin_amdgcn_s_setprio(0); } while (0)
#define PG8_WAIT_V(n) asm volatile("s_waitcnt vmcnt(" #n ")" ::: "memory")
#define PG8_WAIT_L(n) asm volatile("s_waitcnt lgkmcnt(" #n ")" ::: "memory")
#define PG8_BAR __builtin_amdgcn_s_barrier()
#define PG8_SCHED __builtin_amdgcn_sched_barrier(0)
    const unsigned long long tg_in = TS_GEMM ? __builtin_amdgcn_s_memrealtime() : 0ull; unsigned long long tg_ep = 0, tg_l0 = 0; (void)tg_in; (void)tg_ep; (void)tg_l0;
    Unit cur, nxt; int ui = 0;
    if (!S.next(0, cur)) return;
    f32x4 acc[2][2][4][2];
#pragma unroll
    for (int a = 0; a < 2; ++a)
#pragma unroll
        for (int b = 0; b < 2; ++b)
#pragma unroll
            for (int m = 0; m < 4; ++m)
#pragma unroll
                for (int n = 0; n < 2; ++n) acc[a][b][m][n] = (f32x4){0.f, 0.f, 0.f, 0.f};
    bf16x8 At[4][2], B0[2][2], B1[2][2];
    const char* cA = (const char*)g.A + (size_t)cur.pm * tstep + (size_t)cur.k0 * 2; const char* cB = (const char*)g.Bt + (size_t)cur.pn * tstep + (size_t)cur.k0 * 2;
    S.a_ready(cur);
    if constexpr (SP2) {
        PG8_STAGE(PG8_SB(0, 0), cB, voffB); PG8_STAGE(PG8_SB(0, 1), cB + hstep, voffB); PG8_STAGE(PG8_SA(0, 0), cA, voffA); PG8_STAGE(PG8_SA(0, 1), cA + hstep, voffA);
        if (wr == 1) PG8_BAR;
        PG8_WAIT_V(2); PG8_BAR;
        PG8_STAGE(PG8_SB(1, 0), cB + kstep, voffB); PG8_STAGE(PG8_SA(1, 0), cA + kstep, voffA); PG8_STAGE(PG8_SB(1, 1), cB + hstep + kstep, voffB);
        PG8_WAIT_V(6); PG8_BAR;
    } else {
        PG8_STAGE(PG8_SB(0, 0), cB, voffB); PG8_STAGE(PG8_SA(0, 0), cA, voffA); PG8_STAGE(PG8_SB(0, 1), cB + hstep, voffB); PG8_STAGE(PG8_SA(0, 1), cA + hstep, voffA);
        if (wr == 1) PG8_BAR;
        PG8_WAIT_V(4); PG8_BAR;
        PG8_STAGE(PG8_SB(1, 0), cB + kstep, voffB); PG8_STAGE(PG8_SA(1, 0), cA + kstep, voffA); PG8_STAGE(PG8_SB(1, 1), cB + hstep + kstep, voffB);
        PG8_WAIT_V(6); PG8_BAR;
    }
    if (TS_GEMM) tg_l0 = __builtin_amdgcn_s_memrealtime();
    for (;;) {
        const bool has_next = S.next(ui + 1, nxt);
        const char* nA = has_next ? (const char*)g.A + (size_t)nxt.pm * tstep + (size_t)nxt.k0 * 2 : cA; const char* nB = has_next ? (const char*)g.Bt + (size_t)nxt.pn * tstep + (size_t)nxt.k0 * 2 : cB;
        const int nt = cur.nt ? cur.nt : ntf;
        for (int t = 0; t < nt; t += 2) {
            const bool last = (t == nt - 2);
            const char* a1 = cA + (size_t)(t + 1) * kstep;
            const char* a2 = last ? nA : cA + (size_t)(t + 2) * kstep; const char* b2 = last ? nB : cB + (size_t)(t + 2) * kstep;
            const char* a3 = a2 + kstep; const char* b3 = b2 + kstep;
            if (last && has_next) S.a_ready(nxt);
            if constexpr (SP2) {
            PG8_LDB(B0, 0, 0); PG8_LDB(B1, 0, 1); PG8_SCHED; PG8_LDA(At, 0, 0); PG8_STAGE(PG8_SA(1, 1), a1 + hstep, voffA);
            PG8_WAIT_V(8); PG8_WAIT_L(0); PG8_BAR; PG8_MMA(0, 0, At, B0); PG8_MMA(0, 1, At, B1); PG8_BAR; PG8_SCHED;
            PG8_LDA(At, 0, 1); PG8_STAGE(PG8_SB(0, 0), b2, voffB); PG8_STAGE(PG8_SB(0, 1), b2 + hstep, voffB); PG8_STAGE(PG8_SA(0, 0), a2, voffA);
            PG8_WAIT_V(8); PG8_WAIT_L(0); PG8_BAR; PG8_MMA(1, 0, At, B0); PG8_MMA(1, 1, At, B1); PG8_BAR; PG8_SCHED;
            PG8_LDB(B0, 1, 0); PG8_LDB(B1, 1, 1); PG8_SCHED; PG8_LDA(At, 1, 0); PG8_STAGE(PG8_SA(0, 1), a2 + hstep, voffA);
            PG8_WAIT_V(8); PG8_WAIT_L(0); PG8_BAR; PG8_MMA(0, 0, At, B0); PG8_MMA(0, 1, At, B1); PG8_BAR; PG8_SCHED;
            PG8_LDA(At, 1, 1); PG8_STAGE(PG8_SB(1, 0), b3, voffB); PG8_STAGE(PG8_SB(1, 1), b3 + hstep, voffB); PG8_STAGE(PG8_SA(1, 0), a3, voffA);
            PG8_WAIT_V(8); PG8_WAIT_L(0); PG8_BAR; PG8_MMA(1, 0, At, B0); PG8_MMA(1, 1, At, B1); PG8_BAR; PG8_SCHED;
            } else {
            PG8_LDB(B0, 0, 0); PG8_SCHED; PG8_LDA(At, 0, 0); PG8_STAGE(PG8_SA(1, 1), a1 + hstep, voffA);
            PG8_WAIT_L(8); PG8_BAR; PG8_WAIT_L(0); PG8_MMA(0, 0, At, B0); PG8_BAR; PG8_SCHED;
            PG8_LDB(B1, 0, 1); PG8_STAGE(PG8_SB(0, 0), b2, voffB);
            PG8_BAR; PG8_WAIT_L(0); PG8_MMA(0, 1, At, B1); PG8_BAR;
            PG8_LDA(At, 0, 1); PG8_STAGE(PG8_SA(0, 0), a2, voffA);
            PG8_BAR; PG8_WAIT_L(0); PG8_MMA(1, 0, At, B0); PG8_BAR; PG8_SCHED;
            PG8_STAGE(PG8_SB(0, 1), b2 + hstep, voffB);
            PG8_WAIT_V(6); PG8_BAR; PG8_MMA(1, 1, At, B1); PG8_BAR;
            PG8_LDB(B0, 1, 0); PG8_SCHED; PG8_LDA(At, 1, 0); PG8_STAGE(PG8_SA(0, 1), a2 + hstep, voffA);
            PG8_WAIT_L(8); PG8_BAR; PG8_WAIT_L(0); PG8_MMA(0, 0, At, B0); PG8_BAR; PG8_SCHED;
            PG8_LDB(B1, 1, 1); PG8_STAGE(PG8_SB(1, 0), b3, voffB);
            PG8_BAR; PG8_WAIT_L(0); PG8_MMA(0, 1, At, B1); PG8_BAR;
            PG8_LDA(At, 1, 1); PG8_STAGE(PG8_SA(1, 0), a3, voffA);
            PG8_BAR; PG8_WAIT_L(0); PG8_MMA(1, 0, At, B0); PG8_BAR; PG8_SCHED;
            PG8_STAGE(PG8_SB(1, 1), b3 + hstep, voffB);
            PG8_WAIT_V(6); PG8_BAR; PG8_MMA(1, 1, At, B1); PG8_BAR;
            }
        }
        if constexpr (ALIGN_EPI) { if (wr == 0) PG8_BAR; }
        { const unsigned long long te0 = TS_GEMM ? __builtin_amdgcn_s_memrealtime() : 0ull;
        if constexpr (!Epi::AFTER_DRAIN) { E(acc, cur, wr, wc, fr, fq); S.done(cur); }
        if (TS_GEMM) tg_ep += __builtin_amdgcn_s_memrealtime() - te0; }
        if (!has_next) break;
#pragma unroll
        for (int a = 0; a < 2; ++a)
#pragma unroll
            for (int b = 0; b < 2; ++b)
#pragma unroll
                for (int m = 0; m < 4; ++m)
#pragma unroll
                    for (int n = 0; n < 2; ++n) acc[a][b][m][n] = (f32x4){0.f, 0.f, 0.f, 0.f};
        cur = nxt; cA = nA; cB = nB; ++ui;
        if constexpr (ALIGN_EPI) { if (wr == 1) PG8_BAR; }
    }
    PG8_WAIT_V(0);
    if constexpr (!ALIGN_EPI) { if (wr == 0) PG8_BAR; }
    PG8_BAR;
    if constexpr (Epi::AFTER_DRAIN) { E.fused(acc, cur, wr, wc, fr, fq, lds, wid, lane); S.done(cur); }
    if (TS_GEMM && blockIdx.x == TS_BLOCK && threadIdx.x == 0) { volatile PG8_LAS unsigned long long* ts = (volatile PG8_LAS unsigned long long*)(lds + 139264 + 8192 + 256); const unsigned long long te = __builtin_amdgcn_s_memrealtime(); const unsigned long long cid = ts[31]; ts[31] = cid + 1; if ((TS_PHASE != 113 && TS_PHASE != 114) || (int)cid == TS_GEMM_ID) { ts[28] += tg_l0 - tg_in; ts[29] += tg_ep; ts[30] += te - tg_in; } }
#undef PG8_SA
#undef PG8_SB
#undef PG8_STAGE
#undef PG8_LDA
#undef PG8_LDB
#undef PG8_MMA
#undef PG8_WAIT_V
#undef PG8_WAIT_L
#undef PG8_BAR
#undef PG8_SCHED
}
}

#ifndef PG8_SP2
#define PG8_SP2 true
#endif
#ifndef PG8_ALIGN
#define PG8_ALIGN true
#endif

#include <hip/hip_cooperative_groups.h>
namespace mk {
using pg8::bf16_t; using pg8::bf16x8; using pg8::f32x4; using pg8::u32x4; using pg8::f32x2; using pg8::Unit; using pg8::Gemm; using pg8::cvt_pk_bf16; using pg8::gelu_pk;
typedef float f32x16 __attribute__((ext_vector_type(16)));
typedef short s16x4 __attribute__((ext_vector_type(4)));
typedef short v4i16_t __attribute__((ext_vector_type(4)));
typedef __bf16 bf16x2_t __attribute__((ext_vector_type(2)));
typedef __attribute__((address_space(3))) const unsigned char* lds_cptr;
typedef __attribute__((address_space(3))) unsigned char* lds_ptr;

constexpr int DM = 1024, SEQ = 4096, CTXL = 256, NB = 8, MLAT = NB * SEQ, MCTX = NB * CTXL, MALL = MLAT + MCTX, FFH = 2816, NKT = 68;
constexpr float EPS = 1e-6f, LOG2E = 1.4426950408889634f;
constexpr int NWAVES = 8, NTHR = 512;
constexpr int NSL = 8;
constexpr size_t MiB = 1u << 20;
constexpr size_t WS_CTL = 0, CTL_ZERO_BYTES = 1 * MiB;
constexpr size_t WS_W_EV = 1 * MiB, WS_W_OD = 6 * MiB, WS_W_MIX = 10 * MiB  , WS_W_FI = 14 * MiB  , WS_W_FO = 36 * MiB  ;
constexpr size_t WS_W_UQ = 48 * MiB, WS_W_UKV = 48 * MiB + 256 * 1024, WS_W_S = 48 * MiB + 640 * 1024;
constexpr size_t WS_MODP = 49 * MiB;
constexpr size_t WS_MOD = WS_MODP + 7 * MiB - 256 * 1024;
constexpr size_t WS_VSS = 56 * MiB + 512 * 1024, WS_CQS = WS_VSS + 1152 * 1024, WS_CKS = WS_CQS + 1152 * 1024;
constexpr size_t WS_XR = 60 * MiB;
constexpr size_t WS_HN = 196 * MiB;
constexpr size_t WS_MIX = 264 * MiB;
constexpr size_t WS_S = 332 * MiB;
constexpr size_t WS_Q = WS_S, WS_KA = 400 * MiB, WS_VA = WS_KA + 8704 * 1024, WS_KB = 417 * MiB, WS_VB = 451 * MiB;
constexpr size_t WS_UACT = WS_S, WS_VACT = 364 * MiB, WS_CQ = 396 * MiB, WS_CKV = 412 * MiB, WS_KD = 429 * MiB, WS_VD = 463 * MiB;
constexpr size_t WS_OB = WS_HN, WS_Q2 = WS_HN;
constexpr size_t WS_PART = 451 * MiB;
constexpr size_t WS_ACT = WS_MIX;
constexpr size_t WS_SNAP = 498 * MiB, WS_END = 512 * MiB;
static_assert(WS_CQ + (size_t)MLAT * 256 * 2 == WS_CKV && WS_W_UQ + 512 * 256 * 2 == WS_W_UKV, "the combined MLA up-projection GEMM needs CQ | CKV and W_UQ | W_UKV contiguous");
static_assert(WS_MOD + 2 * 9 * 6144 * 4 <= WS_VSS && WS_CKS + 1152 * 1024 <= WS_XR, "ws map");
static_assert(WS_VA + 8704 * 1024 <= WS_KB && WS_VB + 34 * MiB <= WS_SNAP && WS_VD + 34 * MiB <= WS_SNAP && WS_ACT + (size_t)MALL * FFH * 2 <= WS_SNAP, "ws map 2");
constexpr int CW_BAR = 4096;
constexpr int RING_BYTES = 139264  , ROPE_OFF = RING_BYTES, MISC_OFF = ROPE_OFF + 8192, PTR_OFF = MISC_OFF + 512  , LDS_BYTES = RING_BYTES + 16384;

#ifndef TS_PHASE
#define TS_PHASE -1
#endif
#ifndef TS_BLOCK
#define TS_BLOCK 0
#endif
#define TS_ATT (TS_PHASE >= 105 && TS_PHASE <= 108)
#ifndef TS_SUB
#define TS_SUB 0
#endif
#ifndef TS_SCALE
#define TS_SCALE 1.0f
#endif
#ifndef AT_ABL
#define AT_ABL 0
#endif
#ifndef TS_CLK
#define TS_CLK 0
#endif
#ifndef TS_SEAM_LO
#define TS_SEAM_LO 1
#endif
#ifndef TS_SEAM_HI
#define TS_SEAM_HI 9
#endif
#ifndef TS_SEAM_SKIP
#define TS_SEAM_SKIP -1
#endif
#ifndef AT_KSO_B
#define AT_KSO_B 1
#endif
#ifndef AT_KSO_A
#define AT_KSO_A 0
#endif
#ifndef AT_KSO_MLA
#define AT_KSO_MLA 0
#endif
#ifndef AT_DMA_LATE
#define AT_DMA_LATE 0
#endif
#ifndef AT_KSO_A
#define AT_KSO_A 0
#endif
#ifndef GS_AT_START
#define GS_AT_START 1
#endif
#ifndef NT_LOADS
#define NT_LOADS 1
#endif
#ifndef NT_P0ST
#define NT_P0ST 1
#endif
#ifndef NT_P1ST
#define NT_P1ST 1
#endif
#ifndef TS_BASE
#define TS_BASE 2250
#endif
#define GAS __attribute__((address_space(1)))
#define LAS __attribute__((address_space(3)))
typedef GAS unsigned gu32;
#define RLX_AGENT __ATOMIC_RELAXED, __HIP_MEMORY_SCOPE_AGENT

#define XB_TMO      128
#define XB_XCNT(j)  (256  + 64 * (j))
#define XB_XSUB(j)  (1280 + 64 * (j))
#define XB_XGEN(j)  (2304 + 64 * (j))
#define XB_TOP      3328
#define XB_TOPGEN   3392
#define XCD_BAR_WORDS 3456
#define XB_SPIN_CAP (1u << 18)
__device__ __forceinline__ unsigned xb_ld(unsigned* p)              { return __hip_atomic_load(p, __ATOMIC_RELAXED, __HIP_MEMORY_SCOPE_AGENT); }
__device__ __forceinline__ unsigned xb_add(unsigned* p, unsigned v) { return __hip_atomic_fetch_add(p, v, __ATOMIC_RELAXED, __HIP_MEMORY_SCOPE_AGENT); }
__device__ __forceinline__ unsigned xb_xcc_id() { return (unsigned)__builtin_amdgcn_s_getreg((3 << 11) | 20) & 0xFu; }
#define XB_SPIN(cond, bar) do { unsigned _sp = 0; while (cond) { __builtin_amdgcn_s_sleep(1); \
    if ((++_sp & 255u) == 0u) { if (xb_ld(&(bar)[XB_TMO])) break; if (_sp > XB_SPIN_CAP) { atomicAdd(&(bar)[XB_TMO], 1u); break; } } } } while (0)
struct XcdBarrier { unsigned* bar; unsigned x; volatile LAS unsigned* st; };
__device__ __forceinline__ XcdBarrier xcd_barrier_post(unsigned* bar, volatile LAS unsigned* st) {
    XcdBarrier b; b.bar = bar; b.x = xb_xcc_id(); b.st = st;
    if (threadIdx.x == 0) (void)xb_add(&bar[XB_XCNT(b.x)], 1u);
    return b;
}
__device__ __forceinline__ void xcd_barrier_complete(unsigned* bar, unsigned x, unsigned& nloc, unsigned& nx) {
    const unsigned G = gridDim.x * gridDim.y * gridDim.z;
    unsigned sum, cnt, mine, sp = 0u;
    for (;;) {
        sum = 0u; cnt = 0u; mine = 0u;
#pragma unroll
        for (unsigned j = 0; j < 16; ++j) { const unsigned c = xb_ld(&bar[XB_XCNT(j)]); sum += c; cnt += (c > 0u) ? 1u : 0u; mine = (j == x) ? c : mine; }
        if (sum == G) break;
        __builtin_amdgcn_s_sleep(1);
        if ((++sp & 255u) == 0u) { if (xb_ld(&bar[XB_TMO])) break; if (sp > XB_SPIN_CAP) { atomicAdd(&bar[XB_TMO], 1u); break; } }
    }
    nloc = mine > 0u ? mine : 1u; nx = cnt > 0u ? cnt : 1u;
}
__device__ __forceinline__ void xcd_barrier(const XcdBarrier& b) {
    asm volatile("s_waitcnt vmcnt(0)" ::: "memory");
    __syncthreads();
    if (threadIdx.x == 0) {
        unsigned* bar = b.bar;
        __builtin_amdgcn_s_waitcnt(0);
        unsigned nloc = b.st[0], nx = b.st[1];
        if (nloc == 0u) { xcd_barrier_complete(bar, b.x, nloc, nx); b.st[0] = nloc; b.st[1] = nx; }
        const unsigned old = xb_add(&bar[XB_XSUB(b.x)], 1u);
        const unsigned gen = old / nloc;
        if (old + 1u == (gen + 1u) * nloc) {
            __builtin_amdgcn_fence(__ATOMIC_RELEASE, "agent");
            asm volatile("s_waitcnt vmcnt(0)" ::: "memory");
            const unsigned og = xb_add(&bar[XB_TOP], 1u);
            const unsigned tg = og / nx;
            if (og + 1u == (tg + 1u) * nx) xb_add(&bar[XB_TOPGEN], 1u);
            else XB_SPIN(xb_ld(&bar[XB_TOPGEN]) == tg, bar);
            __builtin_amdgcn_fence(__ATOMIC_ACQUIRE, "agent");
            xb_add(&bar[XB_XGEN(b.x)], 1u);
            asm volatile("s_waitcnt vmcnt(0)" ::: "memory");
        } else {
            XB_SPIN(xb_ld(&bar[XB_XGEN(b.x)]) == gen, bar);
            __builtin_amdgcn_fence(__ATOMIC_ACQUIRE, "agent");
            asm volatile("s_waitcnt vmcnt(0)" ::: "memory");
        }
    }
    __syncthreads();
}

__device__ __forceinline__ unsigned f2bf(float f) { unsigned u = __builtin_bit_cast(unsigned, f); return (u + 0x7fffu + ((u >> 16) & 1u)) >> 16; }
__device__ __forceinline__ unsigned pk2(float lo, float hi) { f32x2 v = {lo, hi}; bf16x2_t b = __builtin_convertvector(v, bf16x2_t); return __builtin_bit_cast(unsigned, b); }
__device__ __forceinline__ float bf2f(unsigned short h) { return __builtin_bit_cast(float, (unsigned)h << 16); }
template <int M> __device__ __forceinline__ float shx(float v) {
    if (M == 32) { auto rr = __builtin_amdgcn_permlane32_swap(__float_as_uint(v), __float_as_uint(v), false, false); const bool up = (threadIdx.x & 32) != 0; return __uint_as_float(up ? rr[0] : rr[1]); }
    else return __uint_as_float((unsigned)__builtin_amdgcn_ds_swizzle((int)__float_as_uint(v), 0x1F | (M << 10)));
}
__device__ __forceinline__ float wave_sum(float v) { v += shx<1>(v); v += shx<2>(v); v += shx<4>(v); v += shx<8>(v); v += shx<16>(v); v += shx<32>(v); return v; }
__device__ __forceinline__ float wave_max(float v) { v = fmaxf(v, shx<1>(v)); v = fmaxf(v, shx<2>(v)); v = fmaxf(v, shx<4>(v)); v = fmaxf(v, shx<8>(v)); v = fmaxf(v, shx<16>(v)); v = fmaxf(v, shx<32>(v)); return v; }
__device__ __forceinline__ int ltid() { int t = threadIdx.x; asm volatile("" : "+v"(t)); return t; }
__device__ __forceinline__ int obx() { int b = blockIdx.x; asm volatile("" : "+s"(b)); return b; }
__device__ __forceinline__ int crow(int r, int hi) { return (r & 3) + 8 * (r >> 2) + 4 * hi; }
__device__ __forceinline__ s16x4 vtr(lds_cptr p) { return __builtin_bit_cast(s16x4, __builtin_amdgcn_ds_read_tr16_b64_v4i16((LAS v4i16_t*)p)); }
__device__ __forceinline__ float fast_rcp(float x) { return __builtin_amdgcn_rcpf(x); }
__device__ __forceinline__ float silu_f(float g) { return g * fast_rcp(1.f + __builtin_amdgcn_exp2f(-g * LOG2E)); }
__device__ __forceinline__ float gain_absmax64(const float* g) { return wave_max(fabsf(g[threadIdx.x & 63])); }

struct Frame { lds_ptr lds; unsigned char* ws; float* out; int wave, vcu, G; };
__device__ __forceinline__ const float* inp(const Frame& F, int i) {
    const unsigned long long v = ((const LAS unsigned long long*)(F.lds + PTR_OFF))[i];
    const unsigned lo = __builtin_amdgcn_readfirstlane((unsigned)v), hi = __builtin_amdgcn_readfirstlane((unsigned)(v >> 32));
    return (const float*)(const GAS float*)(((unsigned long long)hi << 32) | lo);
}
__device__ __forceinline__ Frame mkframe() {
    Frame F; asm volatile("" ::: "memory");
    extern __shared__ __attribute__((aligned(16))) unsigned char lds_raw[];
    F.lds = (lds_ptr)lds_raw;
    F.ws = (unsigned char*)inp(F, 34); F.out = (float*)inp(F, 35);
    F.wave = __builtin_amdgcn_readfirstlane(ltid() >> 6);
    F.G = gridDim.x; { const int bx = blockIdx.x; F.vcu = (F.G % 8 == 0) ? (bx % 8) * (F.G / 8) + bx / 8 : bx; }
    return F;
}
enum { I_X = 0, I_C, I_CTX, I_CCTX, I_N1G, I_N2G, I_ADAW, I_ADAB, I_MIXW, I_FIW, I_FOW, I_EVW, I_QNA, I_KNA, I_SINK, I_QNB, I_KNB, I_LQ1, I_LK1, I_LQ2, I_LK2, I_SUBLN,
       I_ODW, I_CVN, I_CWS, I_CBS, I_QAN, I_KVAN, I_WUQ, I_WUKV, I_QNN, I_KNN, I_QNR, I_KNR };

__device__ __forceinline__ int map_head(int R) { const int pn = R >> 8, bj = (R >> 7) & 1, wc = (R >> 5) & 3, rho = R & 31; return 256 * pn + 64 * wc + 32 * bj + rho; }
__device__ __forceinline__ int map_od(int R) { if (R < 1536) return R; const int q = R - 1536, bj = (q >> 7) & 1, wc = (q >> 5) & 3, rho = q & 31; return wc == 0 ? 1536 + 32 * bj + rho : -1; }
__device__ __forceinline__ int map_fi(int R) { const int pn = R >> 8, bj = (R >> 7) & 1, q = R & 127; return bj * FFH + 128 * pn + q; }
__device__ __forceinline__ int map_ukv(int R) { const int pn = R >> 8, bj = (R >> 7) & 1, wc = (R >> 5) & 3, rho = R & 31;
    if (pn == 0) return 192 * wc + 32 * bj + rho; const int u = 4 * (pn - 1) + wc; return 192 * (u >> 1) + 64 + 64 * (u & 1) + 32 * bj + rho; }

__device__ __forceinline__ void transpose_item(const float* W, int K, int ldn, bf16_t* WT, int n0, int cs, int k0, const float* kscale, LAS float* scr, int lane) {
    float tv[32];
#pragma unroll
    for (int i = 0; i < 32; ++i) { const int kk = 2 * i + (lane >> 5); tv[i] = cs >= 0 ? (NT_LOADS ? __builtin_nontemporal_load(&W[(size_t)(k0 + kk) * ldn + cs + (lane & 31)]) : W[(size_t)(k0 + kk) * ldn + cs + (lane & 31)]) : 0.f; }
#pragma unroll
    for (int i = 0; i < 32; ++i) { const int kk = 2 * i + (lane >> 5); float v = tv[i]; if (kscale) v *= kscale[k0 + kk]; scr[kk * 33 + (lane & 31)] = v; }
    asm volatile("s_waitcnt lgkmcnt(0)" ::: "memory");
    const int c = lane & 7;
#pragma unroll
    for (int j = 0; j < 4; ++j) { const int n = (lane >> 3) + 8 * j; const LAS float* s = scr + (8 * c) * 33 + n;
        u32x4 o; o.x = pk2(s[0 * 33], s[1 * 33]); o.y = pk2(s[2 * 33], s[3 * 33]); o.z = pk2(s[4 * 33], s[5 * 33]); o.w = pk2(s[6 * 33], s[7 * 33]);
        if (NT_P0ST) __builtin_nontemporal_store(o, (u32x4*)(WT + (size_t)(n0 + n) * K + k0 + 8 * c)); else *(u32x4*)(WT + (size_t)(n0 + n) * K + k0 + 8 * c) = o; }
    asm volatile("s_waitcnt lgkmcnt(0)" ::: "memory");
}

__device__ __forceinline__ void p0_prologue(Frame& F) {
    LAS float* scr = (LAS float*)(F.lds + F.wave * 16384);
    const int lane = ltid() & 63;
    const int gw = F.vcu * NWAVES + F.wave, NGW = F.G * NWAVES;
    constexpr int N_ADA = 2 * 16 * 24;
    constexpr int I_EV = 16 * 72, I_ODD = 16 * 56, I_MIX1 = 16 * 32, I_FI1 = 16 * 176, I_FO1 = 44 * 32, I_UQ = 4 * 16, I_UKV = 4 * 24;
    constexpr int N_TR = I_EV + I_ODD + 2 * I_MIX1 + 2 * I_FI1 + 2 * I_FO1 + I_UQ + I_UKV;
    constexpr int N_WS = 16;
    static_assert(N_ADA == 256 * 3, "three adaLN items per workgroup");
    if (ltid() == 0) *((volatile LAS unsigned*)(F.lds + MISC_OFF) + 16) = 0u;
    __syncthreads();
    (void)gw; (void)NGW;
    if (F.wave < 3) { const int it = F.vcu * 3 + F.wave;
        {
            const int i = it / (16 * 24), ks = (it / 24) % 16, cc = it % 24;
            for (int idx = lane; idx < 9 * 64; idx += 64) { const int r = idx >> 6, k = idx & 63; const float v = r < 8 ? inp(F, I_C)[r * DM + ks * 64 + k] : inp(F, I_CCTX)[ks * 64 + k]; scr[idx] = v / (1.f + expf(-v)); }
            asm volatile("s_waitcnt lgkmcnt(0)" ::: "memory");
            f32x4 acc[9];
#pragma unroll
            for (int r = 0; r < 9; ++r) acc[r] = (f32x4){0.f, 0.f, 0.f, 0.f};
            const float* w = inp(F, I_ADAW) + ((size_t)i * DM + ks * 64) * 6144 + cc * 256 + lane * 4;
#pragma unroll 8
            for (int k = 0; k < 64; ++k) { const f32x4 wv = NT_LOADS ? __builtin_nontemporal_load((const f32x4*)(w + (size_t)k * 6144)) : *(const f32x4*)(w + (size_t)k * 6144);
#pragma unroll
                for (int r = 0; r < 9; ++r) acc[r] += wv * scr[r * 64 + k]; }
            float* mp = (float*)(F.ws + WS_MODP) + ((size_t)(i * 16 + ks) * 9) * 6144 + cc * 256 + lane * 4;
#pragma unroll
            for (int r = 0; r < 9; ++r) *(f32x4*)(mp + (size_t)r * 6144) = acc[r];
            asm volatile("s_waitcnt lgkmcnt(0)" ::: "memory");
        }
    }
    volatile LAS unsigned* ticket = (volatile LAS unsigned*)(F.lds + MISC_OFF) + 16;
    for (;;) {
        unsigned jj = 0; if (lane == 0) jj = __hip_atomic_fetch_add((LAS unsigned*)ticket, 1u, __ATOMIC_RELAXED, __HIP_MEMORY_SCOPE_WORKGROUP);
        jj = __builtin_amdgcn_readfirstlane(jj);
        const int it = F.vcu + F.G * (int)jj; if (it >= N_TR + N_WS) break;
        int r = it;
        if (r < I_EV) { const int kb = r / 72, nb = r % 72; transpose_item(inp(F, I_EVW), DM, 2304, (bf16_t*)(F.ws + WS_W_EV), 32 * nb, map_head(32 * nb), 64 * kb, nullptr, scr, lane); continue; } r -= I_EV;
        if (r < I_ODD) { const int kb = r / 56, nb = r % 56; transpose_item(inp(F, I_ODW), DM, 1600, (bf16_t*)(F.ws + WS_W_OD), 32 * nb, map_od(32 * nb), 64 * kb, nullptr, scr, lane); continue; } r -= I_ODD;
        if (r < 2 * I_MIX1) { const int l = r / I_MIX1, q = r % I_MIX1, kb = q / 32, nb = q % 32; transpose_item(inp(F, I_MIXW) + (size_t)l * DM * DM, DM, DM, (bf16_t*)(F.ws + WS_W_MIX + l * 2 * MiB), 32 * nb, 32 * nb, 64 * kb, nullptr, scr, lane); continue; } r -= 2 * I_MIX1;
        if (r < 2 * I_FI1) { const int l = r / I_FI1, q = r % I_FI1, kb = q / 176, nb = q % 176; transpose_item(inp(F, I_FIW) + (size_t)l * DM * 2 * FFH, DM, 2 * FFH, (bf16_t*)(F.ws + WS_W_FI + l * 11 * MiB), 32 * nb, map_fi(32 * nb), 64 * kb, nullptr, scr, lane); continue; } r -= 2 * I_FI1;
        if (r < 2 * I_FO1) { const int l = r / I_FO1, q = r % I_FO1, kb = q / 32, nb = q % 32; transpose_item(inp(F, I_FOW) + (size_t)l * FFH * DM, FFH, DM, (bf16_t*)(F.ws + WS_W_FO + l * 6 * MiB), 32 * nb, 32 * nb, 64 * kb, nullptr, scr, lane); continue; } r -= 2 * I_FO1;
        if (r < I_UQ) { const int kb = r / 16, nb = r % 16; transpose_item(inp(F, I_WUQ), 256, 512, (bf16_t*)(F.ws + WS_W_UQ), 32 * nb, map_head(32 * nb), 64 * kb, inp(F, I_QAN), scr, lane); continue; } r -= I_UQ;
        if (r < I_UKV) { const int kb = r / 24, nb = r % 24; transpose_item(inp(F, I_WUKV), 256, 768, (bf16_t*)(F.ws + WS_W_UKV), 32 * nb, map_ukv(32 * nb), 64 * kb, inp(F, I_KVAN), scr, lane); continue; } r -= I_UKV;
        { bf16_t* d = (bf16_t*)(F.ws + WS_W_S); const float* s = inp(F, I_CWS);
#pragma unroll 4
          for (int j = 0; j < 64; ++j) { const int e = r * 4096 + j * 64 + lane; d[e] = (bf16_t)f2bf(s[e]); } }
    }
}

__device__ __forceinline__ void load_mod16(Frame& F, int lane, int layer, int mr, int chunk, bool from_partials, f32x4 (&dst)[4]) {
    if (from_partials) {
        const float* mp = (const float*)(F.ws + WS_MODP) + ((size_t)(layer * 16) * 9 + mr) * 6144 + chunk * DM + lane * 4;
        const float* bias = inp(F, I_ADAB) + layer * 6144 + chunk * DM + lane * 4;
#pragma unroll
        for (int j = 0; j < 4; ++j) { f32x4 a = *(const f32x4*)(bias + 256 * j);
            for (int ks = 0; ks < 16; ++ks) a += *(const f32x4*)(mp + (size_t)ks * 9 * 6144 + 256 * j);
            dst[j] = a; }
    } else {
        const float* m = (const float*)(F.ws + WS_MOD) + ((size_t)layer * 9 + mr) * 6144 + chunk * DM + lane * 4;
#pragma unroll
        for (int j = 0; j < 4; ++j) dst[j] = *(const f32x4*)(m + 256 * j);
    }
}
template <bool SRC_BF16>
__device__ __forceinline__ void ln_phase(Frame& F, int layer, int chunk, const float* gain, const void* src_lat, const void* src_ctx, int mrows, bool from_partials, bf16_t* ctx_out = nullptr, const float* parts = nullptr) {
    const int lane = ltid() & 63;
    const int gw = F.vcu * NWAVES + F.wave;
    bf16_t* HN = (bf16_t*)(F.ws + WS_HN);
    f32x4 gv[4], sh[4], sc[4];
#pragma unroll
    for (int j = 0; j < 4; ++j) gv[j] = *(const f32x4*)(gain + lane * 4 + 256 * j);
#define LN_LOAD(V, SS, XB, RO) do { SS = 0.f; _Pragma("unroll") for (int j = 0; j < 4; ++j) { \
            if (SRC_BF16) { const unsigned long long w_ = *(const unsigned long long*)((XB) + ((RO) + 256 * j) * 2); const unsigned lo_ = (unsigned)w_, hi_ = (unsigned)(w_ >> 32); \
                V[j] = (f32x4){__builtin_bit_cast(float, lo_ << 16), __builtin_bit_cast(float, lo_ & 0xffff0000u), __builtin_bit_cast(float, hi_ << 16), __builtin_bit_cast(float, hi_ & 0xffff0000u)}; } \
            else V[j] = NT_LOADS ? __builtin_nontemporal_load((const f32x4*)((XB) + ((RO) + 256 * j) * 4)) : *(const f32x4*)((XB) + ((RO) + 256 * j) * 4); \
            SS += (V[j].x * V[j].x + V[j].y * V[j].y) + (V[j].z * V[j].z + V[j].w * V[j].w); } } while (0)
#define LN_STORE(V, RS, M) do { unsigned long long* o8_ = (unsigned long long*)(HN + (size_t)(M) * DM) + lane; _Pragma("unroll") for (int j = 0; j < 4; ++j) { const f32x4 y_ = V[j] * (RS) * gv[j] * (sc[j] + 1.0f) + sh[j]; \
            const unsigned long long w8_ = (unsigned long long)pk2(y_.x, y_.y) | ((unsigned long long)pk2(y_.z, y_.w) << 32); if (NT_P1ST && !SRC_BF16) __builtin_nontemporal_store(w8_, o8_ + 64 * j); else o8_[64 * j] = w8_; } } while (0)
    { const int m0 = gw * 16; if (m0 < mrows) { const int mr = m0 >> 12; load_mod16(F, lane, layer, mr, chunk, from_partials, sh); load_mod16(F, lane, layer, mr, chunk + 1, from_partials, sc);
        const unsigned char* xb = (const unsigned char*)src_lat;
#pragma unroll 1
        for (int q = 0; q < 4; ++q) { f32x4 va[4], vb[4], vc[4], vd[4]; float sa, sb, sc2, sd; const size_t ro = (size_t)(m0 + 4 * q) * DM + lane * 4;
            LN_LOAD(va, sa, xb, ro); LN_LOAD(vb, sb, xb, ro + DM); LN_LOAD(vc, sc2, xb, ro + 2 * DM); LN_LOAD(vd, sd, xb, ro + 3 * DM);
            sa = wave_sum(sa); sb = wave_sum(sb); sc2 = wave_sum(sc2); sd = wave_sum(sd);
            const float ra = 1.0f / sqrtf(sa * (1.f / DM) + EPS), rb = 1.0f / sqrtf(sb * (1.f / DM) + EPS), rc = 1.0f / sqrtf(sc2 * (1.f / DM) + EPS), rd = 1.0f / sqrtf(sd * (1.f / DM) + EPS);
            LN_STORE(va, ra, m0 + 4 * q); LN_STORE(vb, rb, m0 + 4 * q + 1); LN_STORE(vc, rc, m0 + 4 * q + 2); LN_STORE(vd, rd, m0 + 4 * q + 3); } } }
    { const int m = MLAT + gw; if (m < mrows) { load_mod16(F, lane, layer, 8, chunk, from_partials, sh); load_mod16(F, lane, layer, 8, chunk + 1, from_partials, sc);
        const size_t ro = (size_t)(m - MLAT) * DM + lane * 4; f32x4 v[4]; float ss; LN_LOAD(v, ss, (const unsigned char*)src_ctx, ro);
        if (ctx_out) {
            if (parts) { ss = 0.f;
#pragma unroll
                for (int j = 0; j < 4; ++j) {
#pragma unroll
                    for (int sl = 0; sl < NSL; ++sl) { const unsigned long long w_ = *(const unsigned long long*)((const bf16_t*)parts + ((size_t)sl * MCTX + (m - MLAT)) * DM + lane * 4 + 256 * j); const unsigned lo_ = (unsigned)w_, hi_ = (unsigned)(w_ >> 32);
                        v[j] += (f32x4){__builtin_bit_cast(float, lo_ << 16), __builtin_bit_cast(float, lo_ & 0xffff0000u), __builtin_bit_cast(float, hi_ << 16), __builtin_bit_cast(float, hi_ & 0xffff0000u)}; }
                    ss += (v[j].x * v[j].x + v[j].y * v[j].y) + (v[j].z * v[j].z + v[j].w * v[j].w); } }
            unsigned long long* x8 = (unsigned long long*)(ctx_out + (size_t)(m - MLAT) * DM) + lane;
#pragma unroll
            for (int j = 0; j < 4; ++j) x8[64 * j] = (unsigned long long)pk2(v[j].x, v[j].y) | ((unsigned long long)pk2(v[j].z, v[j].w) << 32); }
        const float rs = 1.0f / sqrtf(wave_sum(ss) * (1.f / DM) + EPS);
        LN_STORE(v, rs, m); } }
#undef LN_LOAD
#undef LN_STORE
}
__device__ __forceinline__ void mod_reduce(Frame& F) {
    const int gt = F.vcu * NTHR + ltid();
    if (gt < 2 * 9 * 6144) { const int i = gt / (9 * 6144), rem = gt % (9 * 6144), r = rem / 6144, n = rem % 6144;
        float a = inp(F, I_ADAB)[i * 6144 + n]; const float* mp = (const float*)(F.ws + WS_MODP) + ((size_t)(i * 16) * 9 + r) * 6144 + n;
        for (int ks = 0; ks < 16; ++ks) a += mp[(size_t)ks * 9 * 6144];
        ((float*)(F.ws + WS_MOD))[gt] = a; }
}

__device__ __forceinline__ u32x4 pack8(const f32x4 a, const f32x4 b) { u32x4 w; w.x = pk2(a[0], a[1]); w.y = pk2(a[2], a[3]); w.z = pk2(b[0], b[1]); w.w = pk2(b[2], b[3]); return w; }
struct RowGrp { int b, ktile, is_ctx; };
__device__ __forceinline__ RowGrp rowgrp(int rb) { RowGrp g; if (rb < MLAT) { g.b = rb >> 12; g.ktile = (rb & 4095) >> 6; g.is_ctx = 0; } else { const int rc = rb - MLAT; g.b = rc >> 8; g.ktile = 64 + ((rc & 255) >> 6); g.is_ctx = 1; } return g; }
__device__ __forceinline__ void rope8(f32x4 (&v0)[2], f32x4 (&v1)[2], const LAS f32x2* T, int pos, int fq) {
    const LAS f32x2* t = T + pos * 16 + 8 * (fq & 1);
#pragma unroll
    for (int n = 0; n < 2; ++n)
#pragma unroll
        for (int j = 0; j < 4; ++j) { const f32x2 cs = t[4 * n + j]; const float x1 = v0[n][j], x2 = v1[n][j]; v0[n][j] = x1 * cs.x - x2 * cs.y; v1[n][j] = x2 * cs.x + x1 * cs.y; }
}

__device__ __forceinline__ void head_row(f32x4 (&v0)[2], f32x4 (&v1)[2], const f32x4 (&g0)[2], const f32x4 (&g1)[2], float r2, const LAS f32x2* T, int pos, int fq) {
    float ss = 0.f;
#pragma unroll
    for (int n = 0; n < 2; ++n) { ss += (v0[n][0] * v0[n][0] + v0[n][1] * v0[n][1]) + (v0[n][2] * v0[n][2] + v0[n][3] * v0[n][3]); ss += (v1[n][0] * v1[n][0] + v1[n][1] * v1[n][1]) + (v1[n][2] * v1[n][2] + v1[n][3] * v1[n][3]); }
    ss += shx<16>(ss); ss += shx<32>(ss);
    const float rs = __builtin_amdgcn_sqrtf(r2) * __builtin_amdgcn_rsqf(r2 * ss * (1.f / 64.f) + EPS);
#pragma unroll
    for (int n = 0; n < 2; ++n) {
        v0[n] = v0[n] * rs * g0[n]; v1[n] = v1[n] * rs * g1[n];
        if (pos >= 0) { const LAS f32x2* t = T + pos * 16 + 8 * (fq & 1) + 4 * n;
#pragma unroll
            for (int j = 0; j < 4; ++j) { const f32x2 cs = t[j]; const float x1 = v0[n][j], x2 = v1[n][j]; v0[n][j] = x1 * cs.x - x2 * cs.y; v1[n][j] = x2 * cs.x + x1 * cs.y; } }
    }
}
__device__ __forceinline__ void load_gains(const float* gp, int fq, f32x4 (&g0)[2], f32x4 (&g1)[2]) {
#pragma unroll
    for (int n = 0; n < 2; ++n) { g0[n] = *(const f32x4*)(gp + 8 * fq + 4 * n); g1[n] = *(const f32x4*)(gp + 32 + 8 * fq + 4 * n); }
}

struct EpiEven {
    static constexpr bool PERM = true, AFTER_DRAIN = false;
    unsigned char* ws; lds_ptr lds; float qscale;
    __device__ __forceinline__ void operator()(const f32x4 (&acc)[2][2][4][2], const Unit& u, int wr, int wc, int fr_, int fq_) const {
        int fr = fr_, fq = fq_; asm volatile("" : "+v"(fr), "+v"(fq));
        const int unit = 4 * u.pn + wc;
        const LAS f32x2* T = (const LAS f32x2*)(lds + ROPE_OFF); Frame Fq; Fq.lds = lds;
        const int gi = unit < 8 ? I_QNA : unit < 16 ? I_QNB : unit < 18 ? I_KNA : unit < 20 ? -1 : unit < 28 ? I_KNB : -1;
        const float* gp = gi >= 0 ? inp(Fq, gi) : nullptr;
        f32x4 g0[2], g1[2]; if (gp) load_gains(gp, fq, g0, g1);
#pragma unroll
        for (int ai = 0; ai < 2; ++ai) {
            const int rb = u.pm * 256 + ai * 128 + wr * 64; const RowGrp G = rowgrp(rb);
#pragma unroll
            for (int m = 0; m < 4; ++m) {
                const int kk = 16 * m + fr; const size_t row = (size_t)rb + kk;
                f32x4 v0[2] = {acc[ai][0][m][0], acc[ai][0][m][1]}, v1[2] = {acc[ai][1][m][0], acc[ai][1][m][1]};
                if (gp) head_row(v0, v1, g0, g1, 1.0f, T, G.is_ctx ? -1 : (fq < 2 ? G.ktile : kk), fq);
                if (unit < 16) {
                    bf16_t* q = (bf16_t*)(ws + WS_Q) + row * DM + 64 * unit + 8 * fq;
                    *(u32x4*)q = pack8(v0[0] * qscale, v0[1] * qscale); *(u32x4*)(q + 32) = pack8(v1[0] * qscale, v1[1] * qscale);
                } else if (unit < 18 || (unit >= 20 && unit < 28)) {
                    unsigned char* img = unit < 18 ? ws + WS_KA + ((size_t)(G.b * 2 + (unit - 16)) * NKT + G.ktile) * 8192 : ws + WS_KB + ((size_t)(G.b * 8 + (unit - 20)) * NKT + G.ktile) * 8192;
                    *(u32x4*)(img + fq * 1024 + kk * 16) = pack8(v0[0], v0[1]); *(u32x4*)(img + (4 + fq) * 1024 + kk * 16) = pack8(v1[0], v1[1]);
                } else if (unit < 20) {
                    unsigned char* img = ws + WS_VA + ((size_t)(G.b * 2 + (unit - 18)) * NKT + G.ktile) * 8192 + m * 1024 + fr * 64 + fq * 16;
                    *(u32x4*)img = pack8(v0[0], v0[1]); *(u32x4*)(img + 4096) = pack8(v1[0], v1[1]);
                } else {
                    const int j = unit - 28, h = j >> 1, half = j & 1;
                    unsigned char* img = ws + WS_VB + ((size_t)(G.b * 4 + h) * NKT + G.ktile) * 16384 + (2 * half) * 4096 + m * 1024 + fr * 64 + fq * 16;
                    *(u32x4*)img = pack8(v0[0], v0[1]); *(u32x4*)(img + 4096) = pack8(v1[0], v1[1]);
                }
                asm volatile("" ::: "memory");
            }
        }
    }
};

__device__ __forceinline__ void unpack8(const u32x4 w, f32x4& a, f32x4& b) {
#pragma unroll
    for (int j = 0; j < 2; ++j) { a[2 * j] = __builtin_bit_cast(float, w[j] << 16); a[2 * j + 1] = __builtin_bit_cast(float, w[j] & 0xffff0000u); b[2 * j] = __builtin_bit_cast(float, w[2 + j] << 16); b[2 * j + 1] = __builtin_bit_cast(float, w[2 + j] & 0xffff0000u); }
}
template <bool IN_BF16, bool OUT_BF16> struct EpiResid {
    static constexpr bool PERM = true, AFTER_DRAIN = false;
    const void* xin_lat; const void* xin_ctx; void* out_lat; void* out_ctx; const float* gate  ; float* part;
    __device__ __forceinline__ void operator()(const f32x4 (&acc)[2][2][4][2], const Unit& u, int wr, int wc, int fr_, int fq_) const {
        int fr = fr_, fq = fq_; asm volatile("" : "+v"(fr), "+v"(fq));
        const int rb0 = u.pm * 256; const bool ctx = rb0 >= MLAT; const int mr = ctx ? 8 : (rb0 >> 12);
        if (u.nt) {
            bf16_t* pp = (bf16_t*)part + ((size_t)u.aux * MCTX + (rb0 - MLAT)) * DM + u.pn * 256 + wc * 32 + 8 * fq;
#pragma unroll
            for (int bj = 0; bj < 2; ++bj) { const f32x4 ga = *(const f32x4*)(gate + (size_t)8 * 6144 + u.pn * 256 + wc * 32 + 8 * fq + 128 * bj), gb = *(const f32x4*)(gate + (size_t)8 * 6144 + u.pn * 256 + wc * 32 + 8 * fq + 128 * bj + 4);
#pragma unroll
                for (int ai = 0; ai < 2; ++ai)
#pragma unroll
                    for (int m = 0; m < 4; ++m) *(u32x4*)(pp + (size_t)(ai * 128 + wr * 64 + 16 * m + fr) * DM + 128 * bj) = pack8(ga * acc[ai][bj][m][0], gb * acc[ai][bj][m][1]); }
            return; }
        const size_t ro = (size_t)(ctx ? rb0 - MLAT : rb0) * DM;
        const unsigned char* xin = (const unsigned char*)(ctx ? xin_ctx : xin_lat) + ro * (IN_BF16 ? 2 : 4); unsigned char* out = (unsigned char*)(ctx ? out_ctx : out_lat) + ro * (OUT_BF16 ? 2 : 4);
        const int c0 = u.pn * 256 + wc * 32 + 8 * fq;
        f32x4 gt[2][2];
#pragma unroll
        for (int bj = 0; bj < 2; ++bj)
#pragma unroll
            for (int n = 0; n < 2; ++n) gt[bj][n] = *(const f32x4*)(gate + (size_t)mr * 6144 + c0 + 128 * bj + 4 * n);
#pragma unroll
        for (int ai = 0; ai < 2; ++ai) {
            u32x4 xb[4][2]; f32x4 xf[4][2][2];
#pragma unroll
            for (int m = 0; m < 4; ++m) { const size_t off = (size_t)(ai * 128 + wr * 64 + 16 * m + fr) * DM + c0;
#pragma unroll
                for (int bj = 0; bj < 2; ++bj) {
                    if (IN_BF16) xb[m][bj] = *(const u32x4*)(xin + (off + 128 * bj) * 2);
                    else { xf[m][bj][0] = *(const f32x4*)(xin + (off + 128 * bj) * 4); xf[m][bj][1] = *(const f32x4*)(xin + (off + 128 * bj + 4) * 4); } } }
            asm volatile("" ::: "memory");
#pragma unroll
            for (int m = 0; m < 4; ++m) { const size_t off = (size_t)(ai * 128 + wr * 64 + 16 * m + fr) * DM + c0;
#pragma unroll
                for (int bj = 0; bj < 2; ++bj) { f32x4 x0, x1;
                    if (IN_BF16) unpack8(xb[m][bj], x0, x1); else { x0 = xf[m][bj][0]; x1 = xf[m][bj][1]; }
                    x0 += gt[bj][0] * acc[ai][bj][m][0]; x1 += gt[bj][1] * acc[ai][bj][m][1];
                    if (OUT_BF16) *(u32x4*)(out + (off + 128 * bj) * 2) = pack8(x0, x1);
                    else { *(f32x4*)(out + (off + 128 * bj) * 4) = x0; *(f32x4*)(out + (off + 128 * bj + 4) * 4) = x1; } } }
            asm volatile("" ::: "memory");
        }
    }
};

struct EpiSwiglu {
    static constexpr bool PERM = true, AFTER_DRAIN = false;
    bf16_t* act;
    __device__ __forceinline__ void operator()(const f32x4 (&acc)[2][2][4][2], const Unit& u, int wr, int wc, int fr_, int fq_) const {
        int fr = fr_, fq = fq_; asm volatile("" : "+v"(fr), "+v"(fq));
#pragma unroll
        for (int ai = 0; ai < 2; ++ai)
#pragma unroll
            for (int m = 0; m < 4; ++m) { const size_t row = (size_t)u.pm * 256 + ai * 128 + wr * 64 + 16 * m + fr; f32x4 o[2];
#pragma unroll
                for (int n = 0; n < 2; ++n)
#pragma unroll
                    for (int j = 0; j < 4; ++j) o[n][j] = silu_f(acc[ai][0][m][n][j]) * acc[ai][1][m][n][j];
                *(u32x4*)(act + row * FFH + u.pn * 128 + wc * 32 + 8 * fq) = pack8(o[0], o[1]); }
    }
};

struct EpiOdd {
    static constexpr bool PERM = true, AFTER_DRAIN = false;
    unsigned char* ws; lds_ptr lds;
    __device__ __forceinline__ void operator()(const f32x4 (&acc)[2][2][4][2], const Unit& u, int wr, int wc, int fr_, int fq_) const {
        int fr = fr_, fq = fq_; asm volatile("" : "+v"(fr), "+v"(fq));
        const int pn = u.pn;
        if (pn == 6) {
            if (wc != 0) return;
            const LAS f32x2* T = (const LAS f32x2*)(lds + ROPE_OFF); Frame Fq; Fq.lds = lds; const float* knr = inp(Fq, I_KNR);
            f32x4 g0[2], g1[2]; load_gains(knr, fq, g0, g1);
#pragma unroll
            for (int ai = 0; ai < 2; ++ai) { const int rb = u.pm * 256 + ai * 128 + wr * 64; const RowGrp G = rowgrp(rb);
#pragma unroll
                for (int m = 0; m < 4; ++m) { const int kk = 16 * m + fr;
                    f32x4 v0[2] = {acc[ai][0][m][0], acc[ai][0][m][1]}, v1[2] = {acc[ai][1][m][0], acc[ai][1][m][1]};
                    head_row(v0, v1, g0, g1, 1.0f, T, G.is_ctx ? -1 : (fq < 2 ? G.ktile : kk), fq);
                    const u32x4 w0 = pack8(v0[0], v0[1]), w1 = pack8(v1[0], v1[1]);
#pragma unroll
                    for (int h = 0; h < 4; ++h) { unsigned char* img = ws + WS_KD + ((size_t)(G.b * 4 + h) * NKT + G.ktile) * 16384 + kk * 16;
                        *(u32x4*)(img + (8 + fq) * 1024) = w0; *(u32x4*)(img + (12 + fq) * 1024) = w1; }
                    asm volatile("" ::: "memory"); } }
            return;
        }
        const bool act = pn < 4; bf16_t* dbase; int ldd; float* sbase = nullptr;
        if (pn < 2) { dbase = (bf16_t*)(ws + WS_UACT) + 256 * pn; ldd = 512; }
        else if (pn < 4) { dbase = (bf16_t*)(ws + WS_VACT) + 256 * (pn - 2); ldd = 512; sbase = (float*)(ws + WS_VSS) + (pn - 2) * 4 + wc; }
        else if (pn == 4) { dbase = (bf16_t*)(ws + WS_CQ); ldd = 256; sbase = (float*)(ws + WS_CQS) + wc; }
        else { dbase = (bf16_t*)(ws + WS_CKV); ldd = 256; sbase = (float*)(ws + WS_CKS) + wc; }
        const int c0 = 32 * wc + 8 * fq;
#pragma unroll
        for (int ai = 0; ai < 2; ++ai)
#pragma unroll
            for (int m = 0; m < 4; ++m) { const size_t row = (size_t)u.pm * 256 + ai * 128 + wr * 64 + 16 * m + fr; float ss = 0.f;
#pragma unroll
                for (int bj = 0; bj < 2; ++bj) { f32x4 a = acc[ai][bj][m][0], b = acc[ai][bj][m][1];
                    if (act) { f32x2 t0 = gelu_pk((f32x2){a[0], a[1]}), t1 = gelu_pk((f32x2){a[2], a[3]}), t2 = gelu_pk((f32x2){b[0], b[1]}), t3 = gelu_pk((f32x2){b[2], b[3]});
                        a = (f32x4){t0.x, t0.y, t1.x, t1.y}; b = (f32x4){t2.x, t2.y, t3.x, t3.y}; }
                    ss += (a[0] * a[0] + a[1] * a[1]) + (a[2] * a[2] + a[3] * a[3]) + (b[0] * b[0] + b[1] * b[1]) + (b[2] * b[2] + b[3] * b[3]);
                    *(u32x4*)(dbase + row * ldd + 128 * bj + c0) = pack8(a, b); }
                if (sbase) { ss += shx<16>(ss); ss += shx<32>(ss); if (fq == 0) sbase[row * 8] = ss; }
                asm volatile("" ::: "memory"); }
    }
};

struct EpiUq {
    static constexpr bool PERM = true, AFTER_DRAIN = false;
    unsigned char* ws; lds_ptr lds; float qscale;
    __device__ __forceinline__ void operator()(const f32x4 (&acc)[2][2][4][2], const Unit& u, int wr, int wc, int fr_, int fq_) const {
        int fr = fr_, fq = fq_; asm volatile("" : "+v"(fr), "+v"(fq));
        const LAS f32x2* T = (const LAS f32x2*)(lds + ROPE_OFF); Frame Fq; Fq.lds = lds;
        const int unit = 4 * u.pn + wc, part = unit & 1; const float* gp = inp(Fq, part ? I_QNR : I_QNN);
        f32x4 g0[2], g1[2]; load_gains(gp, fq, g0, g1);
        float r2s[8];
#pragma unroll
        for (int i = 0; i < 8; ++i) { const size_t row = (size_t)u.pm * 256 + (i >> 2) * 128 + wr * 64 + 16 * (i & 3) + fr; const f32x4 sq = *(const f32x4*)((const float*)(ws + WS_CQS) + row * 8); r2s[i] = __builtin_amdgcn_rcpf(((sq[0] + sq[1]) + (sq[2] + sq[3])) * (1.f / 256.f) + EPS); }
#pragma unroll
        for (int ai = 0; ai < 2; ++ai) { const int rb = u.pm * 256 + ai * 128 + wr * 64; const RowGrp G = rowgrp(rb);
#pragma unroll
            for (int m = 0; m < 4; ++m) { const int kk = 16 * m + fr; const size_t row = (size_t)rb + kk; const float r2 = r2s[ai * 4 + m];
                f32x4 v0[2] = {acc[ai][0][m][0], acc[ai][0][m][1]}, v1[2] = {acc[ai][1][m][0], acc[ai][1][m][1]};
                head_row(v0, v1, g0, g1, r2, T, (part && !G.is_ctx) ? (fq < 2 ? G.ktile : kk) : -1, fq);
                bf16_t* q = (bf16_t*)(ws + WS_Q2) + row * 512 + 64 * unit + 8 * fq;
                *(u32x4*)q = pack8(v0[0] * qscale, v0[1] * qscale); *(u32x4*)(q + 32) = pack8(v1[0] * qscale, v1[1] * qscale);
                asm volatile("" ::: "memory"); } }
    }
};
struct EpiUkv {
    static constexpr bool PERM = true, AFTER_DRAIN = false;
    unsigned char* ws; lds_ptr lds;
    __device__ __forceinline__ void operator()(const f32x4 (&acc)[2][2][4][2], const Unit& u, int wr, int wc, int fr_, int fq_) const {
        int fr = fr_, fq = fq_; asm volatile("" : "+v"(fr), "+v"(fq));
        const float* knn = nullptr; if (u.pn == 0) { Frame Fq; Fq.lds = lds; knn = inp(Fq, I_KNN); }
        f32x4 g0[2], g1[2]; if (u.pn == 0) load_gains(knn, fq, g0, g1);
        float r2s[8];
#pragma unroll
        for (int i = 0; i < 8; ++i) { const size_t row = (size_t)u.pm * 256 + (i >> 2) * 128 + wr * 64 + 16 * (i & 3) + fr; const f32x4 sq = *(const f32x4*)((const float*)(ws + WS_CKS) + row * 8); r2s[i] = __builtin_amdgcn_rcpf(((sq[0] + sq[1]) + (sq[2] + sq[3])) * (1.f / 256.f) + EPS); }
#pragma unroll
        for (int ai = 0; ai < 2; ++ai) { const int rb = u.pm * 256 + ai * 128 + wr * 64; const RowGrp G = rowgrp(rb);
#pragma unroll
            for (int m = 0; m < 4; ++m) { const int kk = 16 * m + fr; const size_t row = (size_t)rb + kk; const float r2 = r2s[ai * 4 + m];
                f32x4 v0[2] = {acc[ai][0][m][0], acc[ai][0][m][1]}, v1[2] = {acc[ai][1][m][0], acc[ai][1][m][1]};
                if (u.pn == 0) {
                    head_row(v0, v1, g0, g1, r2, (const LAS f32x2*)nullptr, -1, fq);
                    unsigned char* img = ws + WS_KD + ((size_t)(G.b * 4 + wc) * NKT + G.ktile) * 16384 + kk * 16;
                    *(u32x4*)(img + fq * 1024) = pack8(v0[0], v0[1]); *(u32x4*)(img + (4 + fq) * 1024) = pack8(v1[0], v1[1]);
                } else {
                    const float rs = __builtin_amdgcn_sqrtf(r2); const int uu = 4 * (u.pn - 1) + wc, h = uu >> 1, half = uu & 1;
                    unsigned char* img = ws + WS_VD + ((size_t)(G.b * 4 + h) * NKT + G.ktile) * 16384 + (2 * half) * 4096 + m * 1024 + fr * 64 + fq * 16;
                    *(u32x4*)img = pack8(v0[0] * rs, v0[1] * rs); *(u32x4*)(img + 4096) = pack8(v1[0] * rs, v1[1] * rs);
                }
                asm volatile("" ::: "memory"); } }
    }
};

struct EpiNull { static constexpr bool PERM = true, AFTER_DRAIN = false;
    __device__ __forceinline__ void operator()(const f32x4 (&acc)[2][2][4][2], const Unit& u, int wr, int wc, int fr, int fq) const { asm volatile("" :: "v"(acc[0][0][0][0]), "v"(acc[1][1][3][1])); } };
struct UqkvOrder {
    int G, c;
    __device__ void init(int G_, int c_) { G = G_; c = c_; }
    __device__ static void tmpl(int L, int nM, int nN, Unit& u) { const int nwg = nM * nN; int wgid = L; { const int q = nwg / pg8::NXCD, r = nwg % pg8::NXCD, xcd = wgid % pg8::NXCD, off = wgid / pg8::NXCD; wgid = (xcd < r ? xcd * (q + 1) : r * (q + 1) + (xcd - r) * q) + off; }
        const int nig = pg8::WGM * nN, gid = wgid / nig, fm = gid * pg8::WGM, gsz = (nM - fm) < pg8::WGM ? (nM - fm) : pg8::WGM; u.pm = fm + ((wgid % nig) % gsz); u.pn = (wgid % nig) / gsz; }
    __device__ bool next(int i, Unit& u) const { const int L = i * G + c; u.k0 = 0; u.nt = 0;
        if (L < 256) { tmpl(L, MLAT / 256, 2, u); u.aux = 0; return true; }
        if (L < 256 + 408) { tmpl(L - 256, MALL / 256, 3, u); u.pm += 128; u.pn += 2; u.aux = 1; return true; }
        return false; }
    __device__ __forceinline__ void a_ready(const Unit&) const {}
    __device__ __forceinline__ void done(const Unit&) const {}
};
struct EpiUqkv {
    static constexpr bool PERM = true, AFTER_DRAIN = false;
    EpiUq q; EpiUkv kv;
    __device__ __forceinline__ void operator()(const f32x4 (&acc)[2][2][4][2], const Unit& u, int wr, int wc, int fr, int fq) const {
        if (u.aux == 0) q(acc, u, wr, wc, fr, fq);
        else { Unit v = u; v.pm -= 128; v.pn -= 2; kv(acc, v, wr, wc, fr, fq); }
    }
};
struct OddOrder {
    pg8::StaticOrder base;
    __device__ void init(int G, int c) { base.init(MLAT, 1792, G, c); }
    __device__ bool next(int i, Unit& u) const { const long L = (long)i * base.G + base.c; if (L < base.nwg) return base.next(i, u); const int q = (int)(L - base.nwg); if (q >= 16) return false; u.pm = 128 + (q >> 1); u.pn = 5 + (q & 1); u.k0 = 0; u.nt = 0; u.aux = 0; return true; }
    __device__ __forceinline__ void a_ready(const Unit&) const {}
    __device__ __forceinline__ void done(const Unit&) const {}
};

struct SplitOrder {
    pg8::StaticOrder base; int npairs;
    __device__ void init(int K, int G, int c) { base.init(MLAT, DM, G, c); npairs = K / 128; }
    __device__ bool next(int i, Unit& u) const { const long L = (long)i * base.G + base.c; if (L < base.nwg) return base.next(i, u); const int q = (int)(L - base.nwg); if (q >= 32 * NSL) return false;
        const int unit = q / NSL, sl = q % NSL, lo = npairs / NSL, rem = npairs % NSL;
        const int p0 = sl * lo + (sl < rem ? sl : rem), np = lo + (sl < rem ? 1 : 0);
        u.pm = 128 + (unit >> 2); u.pn = unit & 3; u.k0 = 128 * p0; u.nt = 2 * np; u.aux = sl; return true; }
    __device__ __forceinline__ void a_ready(const Unit&) const {}
    __device__ __forceinline__ void done(const Unit&) const {}
};

__device__ __forceinline__ void glds16(const void* gsrc, unsigned lds_dst) { unsigned keep;
    asm volatile("s_mov_b32 %0, m0\n\ts_mov_b32 m0, %2\n\ts_nop 0\n\tglobal_load_lds_dwordx4 %1, off\n\ts_mov_b32 m0, %0" : "=&s"(keep) : "v"(gsrc), "s"(lds_dst) : "memory"); }
#define AT_WAIT_BAR() asm volatile("s_waitcnt vmcnt(0) lgkmcnt(0)\n\ts_barrier" ::: "memory")

template <int DQK, int DV>
__device__ __forceinline__ void attn_pre(lds_ptr lds, const bf16_t* qptr, int ldq, const unsigned char* Kimg, const unsigned char* Vimg, int tile0, bf16x8 (&qr)[DQK / 16]) {
    constexpr int KBY = 64 * DQK * 2, VBY = 64 * DV * 2, NKR = KBY / 8192, NVR = VBY / 8192;
    int tid_ = threadIdx.x; asm volatile("" : "+v"(tid_));
    const int lane = tid_ & 63, r32 = lane & 31, hi = lane >> 5; const int wv = __builtin_amdgcn_readfirstlane(tid_ >> 6);
    const unsigned lds0 = (unsigned)(uintptr_t)lds;
    const unsigned char* gk = Kimg + (size_t)tile0 * KBY + wv * 1024 + lane * 16; const unsigned char* gv = Vimg + (size_t)tile0 * VBY + wv * 1024 + lane * 16;
#pragma unroll
    for (int tt = 0; tt < 2; ++tt) {
#pragma unroll
        for (int i = 0; i < NKR; ++i) glds16(gk + (size_t)tt * KBY + i * 8192, (unsigned)__builtin_amdgcn_readfirstlane(lds0 + tt * (KBY + VBY) + i * 8192 + wv * 1024));
#pragma unroll
        for (int i = 0; i < NVR; ++i) glds16(gv + (size_t)tt * VBY + i * 8192, (unsigned)__builtin_amdgcn_readfirstlane(lds0 + tt * (KBY + VBY) + KBY + i * 8192 + wv * 1024)); }
#pragma unroll
    for (int d0 = 0; d0 < DQK / 16; ++d0) qr[d0] = *(const bf16x8*)(qptr + (size_t)r32 * ldq + d0 * 16 + hi * 8);
}
template <int DQK, int DV, int MODE, int ABL = 0, int KSO = 1, class Pre = int>
__device__ __forceinline__ void attn_unit(lds_ptr lds, const bf16x8 (&qr)[DQK / 16], const unsigned char* Kimg, const unsigned char* Vimg,
                                          int ta0, int ta1, int tb0, int tb1, int qpos0, int win, float negMb, float l_extra, bf16_t* optr, int ldo,
                                          float lam, float dscale, const float* subln, const Pre& pre) {
    const lds_ptr keepl = lds + 73728 + __builtin_amdgcn_readfirstlane((int)threadIdx.x >> 6) * 8192 + (threadIdx.x & 63) * 16;
    constexpr int KBY = 64 * DQK * 2, VBY = 64 * DV * 2, SLOT = KBY + VBY, NKR = KBY / 8192, NVR = VBY / 8192;
    int tid_ = threadIdx.x; asm volatile("" : "+v"(tid_));
    const int tid = tid_, lane = tid & 63, r32 = lane & 31, hi = lane >> 5; const int wv = __builtin_amdgcn_readfirstlane(tid >> 6);
    const unsigned long long ts_in = TS_ATT ? __builtin_amdgcn_s_memrealtime() : 0ull; (void)ts_in;
    const int na = ta1 - ta0, nt = na + (tb1 - tb0);
    const unsigned lds0 = (unsigned)(uintptr_t)lds;
    f32x16 o[DV / 32];
#pragma unroll
    for (int d = 0; d < DV / 32; ++d)
#pragma unroll
        for (int r = 0; r < 16; ++r) o[d][r] = 0.f;
    float lsum = 0.f, lsum2 = 0.f;
#define AT_TILE(tt) ((tt) < na ? ta0 + (tt) : tb0 + ((tt) - na))
#define AT_DMA(tt, slot) do { const int t_ = AT_TILE(tt); const unsigned char* gk_ = Kimg + (size_t)t_ * KBY + wv * 1024 + lane * 16; const unsigned char* gv_ = Vimg + (size_t)t_ * VBY + wv * 1024 + lane * 16; \
        _Pragma("unroll") for (int i = 0; i < NKR; ++i) glds16(gk_ + i * 8192, (unsigned)__builtin_amdgcn_readfirstlane(lds0 + (slot) * SLOT + i * 8192 + wv * 1024)); \
        _Pragma("unroll") for (int i = 0; i < NVR; ++i) glds16(gv_ + i * 8192, (unsigned)__builtin_amdgcn_readfirstlane(lds0 + (slot) * SLOT + KBY + i * 8192 + wv * 1024)); } while (0)
#define AT_KRD(dst, i0, n, slot) do { const lds_cptr kb_ = (lds_cptr)lds + (slot) * SLOT + hi * 1024 + r32 * 16; \
        _Pragma("unroll") for (int i_ = 0; i_ < (n); ++i_) { dst[2 * i_] = *(const LAS bf16x8*)(kb_ + ((i0) + i_) * 2048); dst[2 * i_ + 1] = *(const LAS bf16x8*)(kb_ + ((i0) + i_) * 2048 + 512); } } while (0)
#define AT_QKM(P0, P1, src, i0, n) do { _Pragma("unroll") for (int i_ = 0; i_ < (n); ++i_) { const int d0 = (i0) + i_; \
        P0 = __builtin_amdgcn_mfma_f32_32x32x16_bf16(src[2 * i_], qr[d0], d0 == 0 ? z_ : P0, 0, 0, 0); P1 = __builtin_amdgcn_mfma_f32_32x32x16_bf16(src[2 * i_ + 1], qr[d0], d0 == 0 ? z_ : P1, 0, 0, 0); } } while (0)
#define AT_QK(P0, P1, slot) do { \
        const f32x16 z_ = {0.f, 0.f, 0.f, 0.f, 0.f, 0.f, 0.f, 0.f, 0.f, 0.f, 0.f, 0.f, 0.f, 0.f, 0.f, 0.f}; \
        bf16x8 kx_[4]; AT_KRD(kx_, 2, 2, slot); __builtin_amdgcn_sched_barrier(0);     \
        if constexpr (DQK == 64) { AT_QKM(P0, P1, kp, 0, 2); __builtin_amdgcn_sched_barrier(0); AT_QKM(P0, P1, kx_, 2, 2); __builtin_amdgcn_sched_barrier(0); } \
        else { bf16x8 ky_[8]; AT_QKM(P0, P1, kp, 0, 2); AT_KRD(ky_, 4, 4, slot); __builtin_amdgcn_sched_barrier(0); AT_QKM(P0, P1, kx_, 2, 2); __builtin_amdgcn_sched_barrier(0); AT_QKM(P0, P1, ky_, 4, 4); __builtin_amdgcn_sched_barrier(0); } } while (0)
#define AT_SM(P0, P1, tt) do { \
        if (win && (tt) < na) { const int dq0_ = (qpos0 + r32) - 64 * AT_TILE(tt) + 128; \
            _Pragma("unroll") for (int r = 0; r < 16; ++r) { const int k_ = crow(r, hi); if ((unsigned)(dq0_ - k_) > 256u) P0[r] = -INFINITY; if ((unsigned)(dq0_ - k_ - 32) > 256u) P1[r] = -INFINITY; } } } while (0)
#define AT_SL(P, b, w, LS) do { _Pragma("unroll") for (int r = (b); r < (b) + 8; ++r) { P[r] = __builtin_amdgcn_exp2f(P[r]); LS += P[r]; asm volatile("" : "+v"(LS)); } \
        _Pragma("unroll") for (int q = 0; q < 4; ++q) pw[w][q] = pk2(P[(b) + 2 * q], P[(b) + 2 * q + 1]); } while (0)
#define AT_VLD(slot, nslot, has_next) do { const lds_cptr vp_ = (lds_cptr)lds + (slot) * SLOT + KBY + ((lane >> 4) & 1) * 32 + (lane & 3) * 8 + (4 * hi + ((lane & 15) >> 2)) * 64; \
        _Pragma("unroll") for (int d = 0; d < DV / 32; ++d) _Pragma("unroll") for (int ks = 0; ks < 4; ++ks) { vlo[d * 4 + ks] = vtr(vp_ + d * 4096 + ks * 1024); vhi[d * 4 + ks] = vtr(vp_ + d * 4096 + ks * 1024 + 512); } \
        if (has_next) AT_KRD(kp, 0, 2, nslot);     \
        __builtin_amdgcn_sched_barrier(0); } while (0)
#define AT_PVK(ks) do { _Pragma("unroll") for (int d = 0; d < DV / 32; ++d) { const s16x4 lo_ = vlo[d * 4 + (ks)], hh_ = vhi[d * 4 + (ks)]; \
            const bf16x8 vf_ = (bf16x8){lo_[0], lo_[1], lo_[2], lo_[3], hh_[0], hh_[1], hh_[2], hh_[3]}; \
            o[d] = __builtin_amdgcn_mfma_f32_32x32x16_bf16(vf_, __builtin_bit_cast(bf16x8, pw[ks]), o[d], 0, 0, 0); } } while (0)
#define AT_PVM(P0, P1) do { if constexpr (KSO == 3) { AT_SL(P0, 0, 0, lsum); AT_SL(P0, 8, 1, lsum); AT_PVK(0); AT_PVK(1); AT_SL(P1, 0, 2, lsum2); AT_SL(P1, 8, 3, lsum2); AT_PVK(2); AT_PVK(3); } \
        else { AT_SL(P0, 0, 0, lsum); AT_PVK(0); AT_SL(P0, 8, 1, lsum); AT_PVK(1); AT_SL(P1, 0, 2, lsum2); AT_PVK(2); AT_SL(P1, 8, 3, lsum2); AT_PVK(3); } } while (0)
#define AT_SM_ALL(P0, P1, tt) do { \
        if (win && (tt) < na) { const int dq0_ = (qpos0 + r32) - 64 * AT_TILE(tt) + 128; \
            _Pragma("unroll") for (int r = 0; r < 16; ++r) { const int k_ = crow(r, hi); if ((unsigned)(dq0_ - k_) > 256u) P0[r] = -INFINITY; if ((unsigned)(dq0_ - k_ - 32) > 256u) P1[r] = -INFINITY; } } \
        _Pragma("unroll") for (int r = 0; r < 16; ++r) { P0[r] = __builtin_amdgcn_exp2f(P0[r]); P1[r] = __builtin_amdgcn_exp2f(P1[r]); lsum += P0[r]; asm volatile("" : "+v"(lsum)); lsum2 += P1[r]; asm volatile("" : "+v"(lsum2)); } \
        _Pragma("unroll") for (int q = 0; q < 4; ++q) { pw[0][q] = pk2(P0[2 * q], P0[2 * q + 1]); pw[1][q] = pk2(P0[8 + 2 * q], P0[8 + 2 * q + 1]); pw[2][q] = pk2(P1[2 * q], P1[2 * q + 1]); pw[3][q] = pk2(P1[8 + 2 * q], P1[8 + 2 * q + 1]); } } while (0)
#define AT_PVM_ALL() do { \
        _Pragma("unroll") for (int d = 0; d < DV / 32; ++d) _Pragma("unroll") for (int ks = 0; ks < 4; ++ks) { const s16x4 lo_ = vlo[d * 4 + ks], hh_ = vhi[d * 4 + ks]; \
            const bf16x8 vf_ = (bf16x8){lo_[0], lo_[1], lo_[2], lo_[3], hh_[0], hh_[1], hh_[2], hh_[3]}; \
            o[d] = __builtin_amdgcn_mfma_f32_32x32x16_bf16(vf_, __builtin_bit_cast(bf16x8, pw[ks]), o[d], 0, 0, 0); } } while (0)
#define AT_BAR() asm volatile("s_waitcnt lgkmcnt(0)\n\ts_barrier" ::: "memory")
    f32x16 sa0, sa1; u32x4 pw[4]; s16x4 vlo[DV / 8], vhi[DV / 8];
    unsigned long long ts_a = 0, ts_b = 0, ts_c = 0; (void)ts_a; (void)ts_b; (void)ts_c;
    bf16x8 kp[4];
    int sc = 0, sn = 1, sf = 2;
    for (int t = 0; t < nt; ++t) {
        AT_WAIT_BAR();
        if (TS_ATT && t == 0) ts_a = __builtin_amdgcn_s_memrealtime();
        if (!AT_DMA_LATE) { if (t + 2 < nt) AT_DMA(t + 2, sf); }
        if (t == 0) AT_KRD(kp, 0, 2, sc);
        if (!(ABL & 8)) { AT_QK(sa0, sa1, sc); }
        if (!(ABL & 4)) { AT_VLD(sc, sn, t + 1 < nt); }
        if (AT_DMA_LATE) { if (t + 2 < nt) AT_DMA(t + 2, sf); __builtin_amdgcn_sched_barrier(0); }
        if (!(ABL & 1)) { if constexpr (KSO != 0) { AT_SM(sa0, sa1, t); } else { AT_SM_ALL(sa0, sa1, t); } } else { _Pragma("unroll") for (int q = 0; q < 4; ++q) { pw[0][q] = __builtin_bit_cast(unsigned, sa0[q]); pw[1][q] = __builtin_bit_cast(unsigned, sa0[4 + q]); pw[2][q] = __builtin_bit_cast(unsigned, sa1[q]); pw[3][q] = __builtin_bit_cast(unsigned, sa1[4 + q]); } }
        if (!(ABL & 4)) { if constexpr (KSO != 0) { AT_PVM(sa0, sa1); } else { AT_PVM_ALL(); } }
        { const int s_ = sc; sc = sn; sn = sf; sf = s_; }
    }
    AT_WAIT_BAR();
    if (TS_ATT) ts_b = __builtin_amdgcn_s_memrealtime();
    pre();
#undef AT_TILE
#undef AT_DMA
#undef AT_QK
#undef AT_QKM
#undef AT_KRD
#undef AT_SM
#undef AT_SM_ALL
#undef AT_PVM_ALL
#undef AT_SL
#undef AT_PVK
#undef AT_VLD
#undef AT_PVM
#undef AT_BAR
    lsum += lsum2; lsum += shx<32>(lsum); lsum += l_extra;
    const float linv = 1.0f / lsum;
    bf16_t* orow = optr + (size_t)r32 * ldo + 8 * hi;
#define AT_ROWST(d, gp, e0, e1, e2, e3, e4, e5, e6, e7) do { const unsigned ax_ = pk2(e0, e1), ay_ = pk2(e2, e3), bx_ = pk2(e4, e5), by_ = pk2(e6, e7); \
        const auto sx_ = __builtin_amdgcn_permlane32_swap(ax_, bx_, false, false); const auto sy_ = __builtin_amdgcn_permlane32_swap(ay_, by_, false, false); \
        *(u32x4*)(orow + 32 * (d) + 16 * (gp)) = (u32x4){sx_[0], sy_[0], sx_[1], sy_[1]}; } while (0)
    if (MODE == 0) {
#pragma unroll
        for (int d = 0; d < DV / 32; ++d)
#pragma unroll
            for (int gp = 0; gp < 2; ++gp) AT_ROWST(d, gp, o[d][8 * gp] * linv, o[d][8 * gp + 1] * linv, o[d][8 * gp + 2] * linv, o[d][8 * gp + 3] * linv, o[d][8 * gp + 4] * linv, o[d][8 * gp + 5] * linv, o[d][8 * gp + 6] * linv, o[d][8 * gp + 7] * linv);
    } else if (MODE == 1) {
#pragma unroll
        for (int d = 0; d < DV / 32; ++d)
#pragma unroll
            for (int q4 = 0; q4 < 2; ++q4) { u32x4 kp;
#pragma unroll
                for (int e = 0; e < 4; ++e) { const int r = 8 * q4 + 2 * e; kp[e] = pk2(o[d][r] * linv, o[d][r + 1] * linv); }
                *(LAS u32x4*)(keepl + (d * 2 + q4) * 1024) = kp; }
    } else {
        float ss = 0.f;
#pragma unroll
        for (int d = 0; d < DV / 32; ++d)
#pragma unroll
            for (int q4 = 0; q4 < 2; ++q4) { const u32x4 kp = *(const LAS u32x4*)(keepl + (d * 2 + q4) * 1024);
#pragma unroll
                for (int e = 0; e < 4; ++e) { const int r = 8 * q4 + 2 * e; const float a0 = __builtin_bit_cast(float, kp[e] << 16), a1 = __builtin_bit_cast(float, kp[e] & 0xffff0000u);
                    const float w0 = a0 - lam * (o[d][r] * linv), w1 = a1 - lam * (o[d][r + 1] * linv); o[d][r] = w0; o[d][r + 1] = w1; ss += w0 * w0 + w1 * w1; } }
        ss += shx<32>(ss);
        const float rs = __builtin_amdgcn_rsqf(ss * (1.f / DV) + EPS) * dscale;
#pragma unroll
        for (int d = 0; d < DV / 32; ++d)
#pragma unroll
            for (int gp = 0; gp < 2; ++gp) { const f32x4 ga = *(const f32x4*)(subln + 32 * d + 16 * gp + 4 * hi) * rs, gb = *(const f32x4*)(subln + 32 * d + 16 * gp + 8 + 4 * hi) * rs;
                AT_ROWST(d, gp, o[d][8 * gp] * ga[0], o[d][8 * gp + 1] * ga[1], o[d][8 * gp + 2] * ga[2], o[d][8 * gp + 3] * ga[3], o[d][8 * gp + 4] * gb[0], o[d][8 * gp + 5] * gb[1], o[d][8 * gp + 6] * gb[2], o[d][8 * gp + 7] * gb[3]); }
    }
#undef AT_ROWST
    if (TS_ATT) { asm volatile("s_waitcnt vmcnt(0)" ::: "memory"); ts_c = __builtin_amdgcn_s_memrealtime(); if (blockIdx.x == TS_BLOCK && threadIdx.x == 0) { volatile LAS unsigned long long* ts = (volatile LAS unsigned long long*)(lds + MISC_OFF + 256); ts[24] += (ts_a - ts_in); ts[25] += (ts_b - ts_a); ts[26] += (ts_c - ts_b); ts[27] += 1; } }
}

struct AttCall { int kind  , b, hsel, ta0, ta1, tb0, tb1, qpos0, win; size_t m0; };
__device__ __forceinline__ bool att_call(const Frame& F, int n, AttCall& c) {
    const int w = F.wave; int i, sft;
    if (n < 4) { i = n >> 1; sft = n & 1; } else if (n < 8) { i = n - 2; sft = 0; } else { i = 6; sft = n - 8; }
    c.tb0 = 0; c.tb1 = 0; c.qpos0 = 0; c.win = 0;
    if (i < 2) { const int idx = F.vcu + 256 * i, j = idx >> 4, qb = idx & 15; c.kind = 1 + sft; c.b = j >> 2; c.hsel = j & 3; c.m0 = (size_t)c.b * SEQ + 256 * qb + 32 * w; c.ta0 = 0; c.ta1 = NKT; }
    else if (i < 6) { const int idx = F.vcu + 256 * (i - 2), kvh = (idx >> 6) & 1, nn = (idx >> 1) & 31, hp = idx & 1; c.kind = 0; c.b = idx >> 7; c.hsel = 4 * kvh + 2 * hp + (w >> 2);
        c.m0 = (size_t)c.b * SEQ + 128 * nn + 32 * (w & 3); c.ta0 = max(0, 2 * nn - 2); c.ta1 = min(64, 2 * nn + 4); c.tb0 = 64; c.tb1 = NKT; c.qpos0 = 128 * nn + 32 * (w & 3); c.win = 1; }
    else { if (n > 9 || F.vcu >= 128 || (F.vcu >= 32 && F.vcu < 64)) return false;
        if (F.vcu < 32) { c.kind = 1 + sft; c.b = F.vcu >> 2; c.hsel = F.vcu & 3; } else { if (sft) return false; const int j = F.vcu - 64; c.kind = 0; c.b = j >> 3; c.hsel = j & 7; }
        c.m0 = (size_t)MLAT + c.b * CTXL + 32 * w; c.ta0 = 64; c.ta1 = NKT; }
    return true;
}
__device__ __forceinline__ const unsigned char* att_K(const Frame& F, const AttCall& c) { return c.kind ? F.ws + WS_KB + (size_t)(c.b * 8 + 2 * c.hsel + (c.kind == 2 ? 1 : 0)) * NKT * 8192 : F.ws + WS_KA + (size_t)(c.b * 2 + (c.hsel >> 2)) * NKT * 8192; }
__device__ __forceinline__ const unsigned char* att_V(const Frame& F, const AttCall& c) { return c.kind ? F.ws + WS_VB + (size_t)(c.b * 4 + c.hsel) * NKT * 16384 : F.ws + WS_VA + (size_t)(c.b * 2 + (c.hsel >> 2)) * NKT * 8192; }
__device__ __forceinline__ void att_pre(const Frame& F, const AttCall& c, bf16x8 (&qr)[4]) {
    if (c.kind) attn_pre<64, 128>(F.lds, (const bf16_t*)(F.ws + WS_Q) + c.m0 * DM + 512 + 128 * c.hsel + (c.kind == 2 ? 64 : 0), DM, att_K(F, c), att_V(F, c), c.ta0, qr);
    else        attn_pre<64, 64>(F.lds, (const bf16_t*)(F.ws + WS_Q) + c.m0 * DM + 64 * c.hsel, DM, att_K(F, c), att_V(F, c), c.ta0, qr);
}
__device__ __forceinline__ void phase_attn_even(Frame& F) {
    const float MbA = 8.0f * gain_absmax64(inp(F, I_QNA)) * gain_absmax64(inp(F, I_KNA)) * LOG2E;
    const float MbB = 8.0f * gain_absmax64(inp(F, I_QNB)) * gain_absmax64(inp(F, I_KNB)) * LOG2E;
    const int w = F.wave, lane = ltid() & 63;
    float s1 = inp(F, I_LQ1)[lane] * inp(F, I_LK1)[lane], s2 = inp(F, I_LQ2)[lane] * inp(F, I_LK2)[lane];
    s1 = wave_sum(s1); s2 = wave_sum(s2);
    const float lam_init = 0.8f - 0.6f * 1.0f  , lam = expf(s1) - expf(s2) + lam_init;
    const float* subln = inp(F, I_SUBLN);
    bf16x8 qr[4];
    { AttCall c0; att_call(F, 0, c0); att_pre(F, c0, qr); }
    for (int n = 0; n < 10; ++n) {
        AttCall c; if (!att_call(F, n, c)) break;
        bf16x8 qn[4];
#pragma unroll
        for (int d = 0; d < 4; ++d) qn[d] = qr[d];
        const auto pre = [&]() { AttCall nx; if (att_call(F, n + 1, nx)) att_pre(F, nx, qn); };
        if (c.kind) {
            bf16_t* o = (bf16_t*)(F.ws + WS_MIX) + c.m0 * DM + 512 + 128 * c.hsel;
            if (c.kind == 1) attn_unit<64, 128, 1, 0, AT_KSO_B>(F.lds, qr, att_K(F, c), att_V(F, c), c.ta0, c.ta1, c.tb0, c.tb1, 0, 0, -MbB, 0.f, o, DM, lam, 1.0f - lam_init, subln, pre);
            else             attn_unit<64, 128, 2, 0, AT_KSO_B>(F.lds, qr, att_K(F, c), att_V(F, c), c.ta0, c.ta1, c.tb0, c.tb1, 0, 0, -MbB, 0.f, o, DM, lam, 1.0f - lam_init, subln, pre);
        } else {
            const float lx = __builtin_amdgcn_exp2f(inp(F, I_SINK)[c.hsel] * LOG2E);
            attn_unit<64, 64, 0, 0, AT_KSO_A>(F.lds, qr, att_K(F, c), att_V(F, c), c.ta0, c.ta1, c.tb0, c.tb1, c.qpos0, c.win, -MbA, lx, (bf16_t*)(F.ws + WS_MIX) + c.m0 * DM + 64 * c.hsel, DM, 0.f, 0.f, subln, pre);
        }
#pragma unroll
        for (int d = 0; d < 4; ++d) qr[d] = qn[d];
    }
}
__device__ __forceinline__ void phase_diff_combine(Frame& F) {
    const int lane = ltid() & 63;
    const int gw = F.vcu * NWAVES + F.wave;
    float s1 = inp(F, I_LQ1)[lane] * inp(F, I_LK1)[lane], s2 = inp(F, I_LQ2)[lane] * inp(F, I_LK2)[lane];
    s1 = wave_sum(s1); s2 = wave_sum(s2);
    const float lam_init = 0.8f - 0.6f * 1.0f  , lam = expf(s1) - expf(s2) + lam_init;
    const bf16_t* OB = (const bf16_t*)(F.ws + WS_OB); bf16_t* MIXp = (bf16_t*)(F.ws + WS_MIX);
    const int h = lane >> 4, d8 = (lane & 15) * 8;
    f32x4 g0 = *(const f32x4*)(inp(F, I_SUBLN) + d8), g1 = *(const f32x4*)(inp(F, I_SUBLN) + d8 + 4);
    for (int m = gw * 17; m < gw * 17 + 17; ++m) {
        const u32x4 a = *(const u32x4*)(OB + (size_t)m * DM + (2 * h) * 128 + d8), bq = *(const u32x4*)(OB + (size_t)m * DM + (2 * h + 1) * 128 + d8);
        float v[8]; float ss = 0.f;
#pragma unroll
        for (int j = 0; j < 4; ++j) { const float a0 = __builtin_bit_cast(float, a[j] << 16), a1 = __builtin_bit_cast(float, a[j] & 0xffff0000u), b0 = __builtin_bit_cast(float, bq[j] << 16), b1 = __builtin_bit_cast(float, bq[j] & 0xffff0000u);
            v[2 * j] = a0 - lam * b0; v[2 * j + 1] = a1 - lam * b1; ss += v[2 * j] * v[2 * j] + v[2 * j + 1] * v[2 * j + 1]; }
        ss += shx<1>(ss); ss += shx<2>(ss); ss += shx<4>(ss); ss += shx<8>(ss);
        const float rs = (1.0f - lam_init) / sqrtf(ss * (1.f / 128.f) + EPS);
        const f32x4 o0 = (f32x4){v[0], v[1], v[2], v[3]} * rs * g0, o1 = (f32x4){v[4], v[5], v[6], v[7]} * rs * g1;
        *(u32x4*)(MIXp + (size_t)m * DM + 512 + 128 * h + d8) = pack8(o0, o1);
    }
}

template <int ABL = 0> __device__ __forceinline__ void phase_attn_mla(Frame& F) {
    const float a = gain_absmax64(inp(F, I_QNN)), b2 = gain_absmax64(inp(F, I_QNR)), c = gain_absmax64(inp(F, I_KNN)), d = gain_absmax64(inp(F, I_KNR));
    const float Mb = 0.08838834764831845f * 64.0f * sqrtf((a * a + b2 * b2) * (c * c + d * d)) * LOG2E;
    const bf16_t* Q2 = (const bf16_t*)(F.ws + WS_Q2); bf16_t* MIXp = (bf16_t*)(F.ws + WS_MIX);
    bf16x8 qr[8];
    const auto mla_pre = [&](int i, bf16x8 (&q)[8]) { const int idx = F.vcu + 256 * i, j = idx >> 4, qb = idx & 15, b = j >> 2, h = j & 3; const size_t m0 = (size_t)b * SEQ + 256 * qb + 32 * F.wave;
        attn_pre<128, 128>(F.lds, Q2 + m0 * 512 + 128 * h, 512, F.ws + WS_KD + (size_t)(b * 4 + h) * NKT * 16384, F.ws + WS_VD + (size_t)(b * 4 + h) * NKT * 16384, 0, q); };
    mla_pre(0, qr);
    for (int i = 0; i < 2; ++i) { const int idx = F.vcu + 256 * i, j = idx >> 4, qb = idx & 15, b = j >> 2, h = j & 3;
        const size_t m0 = (size_t)b * SEQ + 256 * qb + 32 * F.wave;
        bf16x8 qn[8];
#pragma unroll
        for (int d = 0; d < 8; ++d) qn[d] = qr[d];
        const auto pre = [&]() { if (i + 1 < 2) mla_pre(i + 1, qn); };
        attn_unit<128, 128, 0, ABL, AT_KSO_MLA>(F.lds, qr, F.ws + WS_KD + (size_t)(b * 4 + h) * NKT * 16384, F.ws + WS_VD + (size_t)(b * 4 + h) * NKT * 16384,
                                   0, NKT, 0, 0, 0, 0, -Mb, 0.f, MIXp + m0 * DM + 512 + 128 * h, DM, 0.f, 0.f, (const float*)nullptr, pre);
#pragma unroll
        for (int d = 0; d < 8; ++d) qr[d] = qn[d]; }
}

__device__ __forceinline__ void phase_spatial(Frame& F) {
    const int tid = ltid(), lane = tid & 63, r32 = lane & 31, hi = lane >> 5, w = F.wave, pb = w >> 1, cb0 = 2 * (w & 1);
    const bf16_t* UACT = (const bf16_t*)(F.ws + WS_UACT); const bf16_t* VACT = (const bf16_t*)(F.ws + WS_VACT); const float* VSS = (const float*)(F.ws + WS_VSS);
    const bf16_t* WS = (const bf16_t*)(F.ws + WS_W_S); bf16_t* MIXp = (bf16_t*)(F.ws + WS_MIX);
    const float* cvn = inp(F, I_CVN); const float* cbs = inp(F, I_CBS);
    LAS float* rsl = (LAS float*)(F.lds + MISC_OFF + 1024);
    LAS float* bsl = (LAS float*)(F.lds + MISC_OFF + 2048);
    bsl[tid] = cbs[tid];
    for (int idx = F.vcu; idx < MLAT / 128; idx += F.G) {
        const size_t m0 = (size_t)idx * 128;
        if (tid < 128) { const f32x4 s0 = *(const f32x4*)(VSS + (m0 + tid) * 8), s1 = *(const f32x4*)(VSS + (m0 + tid) * 8 + 4);
            rsl[tid] = 1.0f / sqrtf((((s0[0] + s0[1]) + (s0[2] + s0[3])) + ((s1[0] + s1[1]) + (s1[2] + s1[3]))) * (1.f / 512.f) + EPS); }
        const int c8 = (tid & 63) * 8, g_ = c8 >> 7, cl = c8 & 127;
        u32x4 raw[16];
#pragma unroll
        for (int i = 0; i < 16; ++i) raw[i] = *(const u32x4*)(VACT + (m0 + w + 8 * i) * 512 + c8);
        const f32x4 g0 = *(const f32x4*)(cvn + c8), g1 = *(const f32x4*)(cvn + c8 + 4);
        const __amdgpu_buffer_rsrc_t urs = __builtin_amdgcn_make_buffer_rsrc((void*)(UACT + m0 * 512), (short)0, 128 * 512 * 2, 0x00020000), ors = __builtin_amdgcn_make_buffer_rsrc((void*)(MIXp + m0 * DM), (short)0, 128 * DM * 2, 0x00020000);
        const unsigned uoff = (unsigned)(((32 * pb + 4 * hi) * 512 + 32 * cb0 + r32) * 2), ooff = (unsigned)(((32 * pb + 4 * hi) * DM + 32 * cb0 + r32) * 2);
        unsigned short uA[32], uB[32];
#define SP_ULOAD(U, g) do { _Pragma("unroll") for (int r = 0; r < 16; ++r) _Pragma("unroll") for (int ci = 0; ci < 2; ++ci) U[r * 2 + ci] = (unsigned short)__builtin_amdgcn_raw_buffer_load_b16(urs, uoff, (((r & 3) + 8 * (r >> 2)) * 512 + 128 * (g) + 32 * ci) * 2, 0); } while (0)
        SP_ULOAD(uA, 0);
        s16x4 wA[16];
#define SP_WLOAD(Wf, g) do { const bf16_t* wrow_ = WS + ((size_t)(g) * 128 + 32 * pb + r32) * 128 + 4 * hi; _Pragma("unroll") for (int ks = 0; ks < 8; ++ks) { Wf[2 * ks] = *(const s16x4*)(wrow_ + 16 * ks); Wf[2 * ks + 1] = *(const s16x4*)(wrow_ + 16 * ks + 8); } } while (0)
        SP_WLOAD(wA, 0);
        __syncthreads();
        const lds_ptr vdst = F.lds + g_ * 32768 + (cl >> 5) * 8192 + w * 64 + (cl & 31) * 2;
#pragma unroll
        for (int i = 0; i < 16; ++i) { const float rs = rsl[w + 8 * i]; f32x4 a, bq; unpack8(raw[i], a, bq);
            *(LAS u32x4*)(vdst + (i >> 1) * 1024 + (i & 1) * 512) = pack8(a * rs * g0, bq * rs * g1); }
        __syncthreads();
#define SP_GROUP(g, UC, UN, WC, WN) do { \
            asm volatile("" ::: "memory");     \
            if ((g) < 3) { SP_ULOAD(UN, (g) + 1); } \
            asm volatile("" ::: "memory"); \
            f32x16 acc[2]; \
            _Pragma("unroll") for (int r = 0; r < 16; ++r) { acc[0][r] = 0.f; acc[1][r] = 0.f; } \
            const lds_cptr vp = (lds_cptr)F.lds + (g) * 32768 + ((lane >> 4) & 1) * 32 + (lane & 3) * 8 + (4 * hi + ((lane & 15) >> 2)) * 64; \
            _Pragma("unroll") for (int ks = 0; ks < 8; ++ks) { const s16x4 alo = WC[2 * ks], ahi = WC[2 * ks + 1]; \
                const bf16x8 af = (bf16x8){alo[0], alo[1], alo[2], alo[3], ahi[0], ahi[1], ahi[2], ahi[3]}; \
                _Pragma("unroll") for (int ci = 0; ci < 2; ++ci) { const s16x4 lo = vtr(vp + (cb0 + ci) * 8192 + ks * 1024), hh = vtr(vp + (cb0 + ci) * 8192 + ks * 1024 + 512); \
                    const bf16x8 vf = (bf16x8){lo[0], lo[1], lo[2], lo[3], hh[0], hh[1], hh[2], hh[3]}; \
                    acc[ci] = __builtin_amdgcn_mfma_f32_32x32x16_bf16(af, vf, acc[ci], 0, 0, 0); } } \
            asm volatile("" ::: "memory"); if ((g) < 3) { SP_WLOAD(WN, (g) + 1); } asm volatile("" ::: "memory"); \
            _Pragma("unroll") for (int r = 0; r < 16; ++r) { const int p = 32 * pb + crow(r, hi); const float bsv = bsl[(g) * 128 + p]; \
                _Pragma("unroll") for (int ci = 0; ci < 2; ++ci) \
                    __builtin_amdgcn_raw_buffer_store_b16((short)f2bf(bf2f(UC[r * 2 + ci]) * (acc[ci][r] + bsv)), ors, ooff, (((r & 3) + 8 * (r >> 2)) * DM + 128 * (g) + 32 * ci) * 2, 0); } } while (0)
        SP_GROUP(0, uA, uB, wA, wA); SP_GROUP(1, uB, uA, wA, wA); SP_GROUP(2, uA, uB, wA, wA); SP_GROUP(3, uB, uA, wA, wA);
#undef SP_GROUP
#undef SP_ULOAD
#undef SP_WLOAD
        __syncthreads();
    }
}

constexpr int N_PHASES = 17;
struct Args { const float* in[34]; float* out; unsigned char* ws; };
#ifndef DBG_PH_END
#define DBG_PH_END 17
#endif
#ifndef DBG_CHK
#define DBG_CHK 0
#endif
__global__ void __launch_bounds__(NTHR, 2) fwd(Args args) {
    extern __shared__ __attribute__((aligned(16))) unsigned char lds_raw[];
    const unsigned long long ts_entry_ = TS_PHASE == 119 ? __builtin_amdgcn_s_memrealtime() : 0ull; (void)ts_entry_;
    const lds_ptr lds = (lds_ptr)lds_raw;
    volatile LAS unsigned* MISC = (volatile LAS unsigned*)(lds + MISC_OFF);
    const int tid0 = threadIdx.x;
    if (tid0 == 0) {
#pragma unroll
        for (int i = 0; i < 34; ++i) ((LAS unsigned long long*)(lds + PTR_OFF))[i] = (unsigned long long)args.in[i];
        ((LAS unsigned long long*)(lds + PTR_OFF))[34] = (unsigned long long)args.ws; ((LAS unsigned long long*)(lds + PTR_OFF))[35] = (unsigned long long)args.out; }
    for (int u = tid0; u < 128; u += NTHR) MISC[u] = 0u;
    LAS f32x2* T = (LAS f32x2*)(lds + ROPE_OFF);
    for (int e = tid0; e < 1024; e += NTHR) { const int pos = e >> 4, fi = e & 15; const float inv = powf(10000.f, -(float)fi / 16.f), ang = (float)pos * inv; T[e] = (f32x2){cosf(ang), sinf(ang)}; }
    __syncthreads();
#if DBG_CHK
    { XcdBarrier b0 = xcd_barrier_post((unsigned*)(args.ws + WS_CTL) + CW_BAR, MISC + 8); (void)b0; }
#else
    if (blockIdx.x == 0) for (int u = tid0; u < XCD_BAR_WORDS; u += NTHR) __hip_atomic_store((unsigned*)(args.ws + WS_CTL) + CW_BAR + u, 0u, __ATOMIC_RELAXED, __HIP_MEMORY_SCOPE_AGENT);
#endif
#if GS_AT_START && !DBG_CHK
    cooperative_groups::this_grid().sync();
    { XcdBarrier b0 = xcd_barrier_post((unsigned*)(args.ws + WS_CTL) + CW_BAR, MISC + 8); (void)b0; }
#endif
    constexpr int lo = 0, hi = DBG_PH_END;
#ifndef PH_MASK
#define PH_MASK 0x1ffff
#endif
#define IN(k) (((PH_MASK >> (k)) & 1) && lo <= (k) && (k) < hi)
#ifndef TS_PHASE
#define TS_PHASE -1
#endif
#ifndef TS_BLOCK
#define TS_BLOCK 0
#endif
#define TSTAMP(k) do { if (TS_PHASE >= 0 && ((TS_PHASE == 99 && ((k) == -1 || (k) == 16)) || (TS_PHASE >= 100 && TS_PHASE < 110 && (k) == 11) || ((k) + 1 >= TS_PHASE && (k) <= TS_PHASE)) && blockIdx.x == TS_BLOCK && threadIdx.x == 0) ((volatile LAS unsigned long long*)(lds + MISC_OFF + 256))[(k) + 1] = TS_CLK ? __builtin_amdgcn_s_memtime() : __builtin_amdgcn_s_memrealtime(); } while (0)
#define SUBTS(i) do { if (TS_PHASE >= 100 && TS_PHASE < 110 && blockIdx.x == TS_BLOCK && threadIdx.x == 0) ((volatile LAS unsigned long long*)(lds + MISC_OFF + 256))[(i)] = __builtin_amdgcn_s_memrealtime(); } while (0)
#define SEAM(k) do { const unsigned long long tsm0_ = (TS_PHASE >= 115 && TS_PHASE <= 118) ? __builtin_amdgcn_s_memrealtime() : 0ull; if (IN(k) && IN((k) + 1)) { if ((k) == 0 && DBG_CHK == 0 && !GS_AT_START) cooperative_groups::this_grid().sync(); else { XcdBarrier bar; bar.bar = (unsigned*)(mkframe().ws + WS_CTL) + CW_BAR; bar.x = xb_xcc_id(); bar.st = (volatile LAS unsigned*)(lds + MISC_OFF) + 8; xcd_barrier(bar); } } asm volatile("" ::: "memory"); if ((TS_PHASE == 115 || (TS_PHASE == 116 && (k) != 0)) && blockIdx.x == TS_BLOCK && threadIdx.x == 0) ((volatile LAS unsigned long long*)(lds + MISC_OFF + 256))[19] += __builtin_amdgcn_s_memrealtime() - tsm0_; if ((TS_PHASE == 117 || TS_PHASE == 118) && (k) >= TS_SEAM_LO && (k) <= TS_SEAM_HI && (k) != TS_SEAM_SKIP && blockIdx.x == TS_BLOCK && threadIdx.x == 0) { volatile LAS unsigned long long* ts_ = (volatile LAS unsigned long long*)(lds + MISC_OFF + 256); const unsigned long long w_ = __builtin_amdgcn_s_memrealtime() - tsm0_; if (w_ > ts_[18]) { ts_[18] = w_; ts_[20] = (unsigned long long)((k) - TS_SEAM_LO + 1); } } } while (0)
#ifndef PH_REP
#define PH_REP 0
#endif
#define REPBAR() do { XcdBarrier bar; bar.bar = (unsigned*)(mkframe().ws + WS_CTL) + CW_BAR; bar.x = xb_xcc_id(); bar.st = (volatile LAS unsigned*)(lds + MISC_OFF) + 8; xcd_barrier(bar); asm volatile("" ::: "memory"); } while (0)
#define FRAME() Frame F = mkframe(); const float* MOD = (const float*)(F.ws + WS_MOD); bf16_t* XR = (bf16_t*)(F.ws + WS_XR); const bf16_t* HN = (const bf16_t*)(F.ws + WS_HN); (void)MOD; (void)XR; (void)HN

    TSTAMP(-1);
    if (TS_PHASE == 119 && blockIdx.x == TS_BLOCK && threadIdx.x == 0) ((volatile LAS unsigned long long*)(lds + MISC_OFF + 256))[21] = __builtin_amdgcn_s_memrealtime() - ts_entry_;
    if (IN(0)) for (int rep_ = 0; rep_ <= ((PH_REP >> (0)) & 1); ++rep_) { if (rep_) REPBAR(); FRAME(); p0_prologue(F); }
    SEAM(0); TSTAMP(0);
#if !DBG_CHK && !GS_AT_START
    { XcdBarrier b0 = xcd_barrier_post((unsigned*)(args.ws + WS_CTL) + CW_BAR, MISC + 8); (void)b0; }
#endif
    if (IN(1)) for (int rep_ = 0; rep_ <= ((PH_REP >> (1)) & 1); ++rep_) { if (rep_) REPBAR(); FRAME(); mod_reduce(F); REPBAR();
        ln_phase<false>(F, 0, 0, inp(F, I_N1G), inp(F, I_X), inp(F, I_CTX), MALL, false, XR + (size_t)MLAT * DM); }
    SEAM(1); TSTAMP(1);
    if (IN(2)) for (int rep_ = 0; rep_ <= ((PH_REP >> (2)) & 1); ++rep_) { if (rep_) REPBAR(); FRAME(); Gemm g{HN, (const bf16_t*)(F.ws + WS_W_EV), MALL, 2304, DM}; pg8::StaticOrder S; S.init(MALL, 2304, F.G, obx());
        EpiEven E{F.ws, F.lds, 0.125f * LOG2E};
        pg8::gemm_phase<EpiEven, pg8::StaticOrder, PG8_ALIGN, PG8_SP2>(F.lds, g, S, E); }
    SEAM(2); TSTAMP(2);
    if (IN(3)) for (int rep_ = 0; rep_ <= ((PH_REP >> (3)) & 1); ++rep_) { if (rep_) REPBAR(); FRAME(); phase_attn_even(F); }
    SEAM(3); TSTAMP(3); TSTAMP(4);
    if (IN(5)) for (int rep_ = 0; rep_ <= ((PH_REP >> (5)) & 1); ++rep_) { if (rep_) REPBAR(); FRAME(); Gemm g{(const bf16_t*)(F.ws + WS_MIX), (const bf16_t*)(F.ws + WS_W_MIX), MALL, DM, DM}; SplitOrder S; S.init(DM, F.G, obx());
        EpiResid<false, true> E{inp(F, I_X), inp(F, I_CTX), XR, XR + (size_t)MLAT * DM, MOD + 2 * DM, (float*)(F.ws + WS_PART)};
        pg8::gemm_phase<EpiResid<false, true>, SplitOrder, PG8_ALIGN, PG8_SP2>(F.lds, g, S, E); }
    SEAM(5); TSTAMP(5);
    if (IN(6)) for (int rep_ = 0; rep_ <= ((PH_REP >> (6)) & 1); ++rep_) { if (rep_) REPBAR(); FRAME(); ln_phase<true>(F, 0, 3, inp(F, I_N2G), XR, XR + (size_t)MLAT * DM, MALL, false, XR + (size_t)MLAT * DM, (const float*)(F.ws + WS_PART)); }
    SEAM(6); TSTAMP(6);
    if (IN(7)) for (int rep_ = 0; rep_ <= ((PH_REP >> (7)) & 1); ++rep_) { if (rep_) REPBAR(); FRAME(); Gemm g{HN, (const bf16_t*)(F.ws + WS_W_FI), MALL, 2 * FFH, DM}; pg8::StaticOrder S; S.init(MALL, 2 * FFH, F.G, obx());
        EpiSwiglu E{(bf16_t*)(F.ws + WS_ACT)};
        pg8::gemm_phase<EpiSwiglu, pg8::StaticOrder, PG8_ALIGN, PG8_SP2>(F.lds, g, S, E); }
    SEAM(7); TSTAMP(7);
    if (IN(8)) for (int rep_ = 0; rep_ <= ((PH_REP >> (8)) & 1); ++rep_) { if (rep_) REPBAR(); FRAME(); int KF = FFH; asm volatile("" : "+s"(KF));
        Gemm g{(const bf16_t*)(F.ws + WS_ACT), (const bf16_t*)(F.ws + WS_W_FO), MALL, DM, KF}; SplitOrder S; S.init(KF, F.G, obx());
        EpiResid<true, true> E{XR, XR + (size_t)MLAT * DM, XR, XR + (size_t)MLAT * DM, MOD + 5 * DM, (float*)(F.ws + WS_PART)};
        pg8::gemm_phase<EpiResid<true, true>, SplitOrder, PG8_ALIGN, PG8_SP2>(F.lds, g, S, E); }
    SEAM(8); TSTAMP(8);
    if (IN(9)) for (int rep_ = 0; rep_ <= ((PH_REP >> (9)) & 1); ++rep_) { if (rep_) REPBAR(); FRAME(); ln_phase<true>(F, 1, 0, inp(F, I_N1G) + DM, XR, XR + (size_t)MLAT * DM, MALL, false, XR + (size_t)MLAT * DM, (const float*)(F.ws + WS_PART)); }
    SEAM(9); TSTAMP(9);
    if (IN(10)) for (int rep_ = 0; rep_ <= ((PH_REP >> (10)) & 1); ++rep_) { if (rep_) REPBAR(); FRAME(); Gemm g{HN, (const bf16_t*)(F.ws + WS_W_OD), MALL, 1792, DM}; OddOrder S; S.init(F.G, obx());
        EpiOdd E{F.ws, F.lds};
        pg8::gemm_phase<EpiOdd, OddOrder, PG8_ALIGN, PG8_SP2>(F.lds, g, S, E); }
    SEAM(10); TSTAMP(10);
    if (IN(11)) for (int rep_ = 0; rep_ <= ((PH_REP >> (11)) & 1); ++rep_) { if (rep_) REPBAR(); FRAME();
        int K256 = 256; asm volatile("" : "+s"(K256));
        SUBTS(20);
        { Gemm g{(const bf16_t*)(F.ws + WS_CQ), (const bf16_t*)(F.ws + WS_W_UQ), MLAT + MALL, 1280, K256}; UqkvOrder S; S.init(F.G, obx());
          EpiUqkv E{EpiUq{F.ws, F.lds, 0.08838834764831845f * LOG2E}, EpiUkv{F.ws, F.lds}};
          pg8::gemm_phase<EpiUqkv, UqkvOrder, PG8_ALIGN, PG8_SP2>(F.lds, g, S, E); }
        SUBTS(21);
        SUBTS(22);
        phase_spatial(F);
        SUBTS(23);
        if ((PH_REP >> 17) & 1) { REPBAR(); phase_spatial(F); }
        if ((PH_REP >> 18) & 1) { REPBAR();
          { Gemm g{(const bf16_t*)(F.ws + WS_CQ), (const bf16_t*)(F.ws + WS_W_UQ), MLAT, 512, K256}; pg8::StaticOrder S; S.init(MLAT, 512, F.G, obx()); EpiUq E{F.ws, F.lds, 0.08838834764831845f * LOG2E}; pg8::gemm_phase<EpiUq, pg8::StaticOrder, PG8_ALIGN, PG8_SP2>(F.lds, g, S, E); }
          { Gemm g{(const bf16_t*)(F.ws + WS_CKV), (const bf16_t*)(F.ws + WS_W_UKV), MALL, 768, K256}; pg8::StaticOrder S; S.init(MALL, 768, F.G, obx()); EpiUkv E{F.ws, F.lds}; pg8::gemm_phase<EpiUkv, pg8::StaticOrder, PG8_ALIGN, PG8_SP2>(F.lds, g, S, E); } }
        if ((PH_REP >> 19) & 1) { REPBAR();
          { Gemm g{(const bf16_t*)(F.ws + WS_CQ), (const bf16_t*)(F.ws + WS_W_UQ), MLAT, 512, K256}; pg8::StaticOrder S; S.init(MLAT, 512, F.G, obx()); EpiNull E; pg8::gemm_phase<EpiNull, pg8::StaticOrder, PG8_ALIGN, PG8_SP2>(F.lds, g, S, E); }
          { Gemm g{(const bf16_t*)(F.ws + WS_CKV), (const bf16_t*)(F.ws + WS_W_UKV), MALL, 768, K256}; pg8::StaticOrder S; S.init(MALL, 768, F.G, obx()); EpiNull E; pg8::gemm_phase<EpiNull, pg8::StaticOrder, PG8_ALIGN, PG8_SP2>(F.lds, g, S, E); } }
    }
    SEAM(11); TSTAMP(11);
#if AT_ABL
    if (IN(12)) { FRAME(); phase_attn_mla<AT_ABL>(F); REPBAR(); if (blockIdx.x == TS_BLOCK && threadIdx.x == 0) ((volatile LAS unsigned long long*)(lds + MISC_OFF + 256))[13] = __builtin_amdgcn_s_memrealtime(); phase_attn_mla<0>(F); }
    SEAM(12);
#else
    if (IN(12)) for (int rep_ = 0; rep_ <= ((PH_REP >> (12)) & 1); ++rep_) { if (rep_) REPBAR(); FRAME(); phase_attn_mla<0>(F); }
    SEAM(12); TSTAMP(12);
#endif
    if (IN(13)) for (int rep_ = 0; rep_ <= ((PH_REP >> (13)) & 1); ++rep_) { if (rep_) REPBAR(); FRAME(); Gemm g{(const bf16_t*)(F.ws + WS_MIX), (const bf16_t*)(F.ws + WS_W_MIX + 2 * MiB), MLAT, DM, DM}; pg8::StaticOrder S; S.init(MLAT, DM, F.G, obx());
        EpiResid<true, true> E{XR, XR, XR, XR, MOD + 9 * 6144 + 2 * DM, nullptr};
        pg8::gemm_phase<EpiResid<true, true>, pg8::StaticOrder, PG8_ALIGN, PG8_SP2>(F.lds, g, S, E); }
    SEAM(13); TSTAMP(13);
    if (IN(14)) for (int rep_ = 0; rep_ <= ((PH_REP >> (14)) & 1); ++rep_) { if (rep_) REPBAR(); FRAME(); ln_phase<true>(F, 1, 3, inp(F, I_N2G) + DM, XR, XR, MLAT, false); }
    SEAM(14); TSTAMP(14);
    if (IN(15)) for (int rep_ = 0; rep_ <= ((PH_REP >> (15)) & 1); ++rep_) { if (rep_) REPBAR(); FRAME(); Gemm g{HN, (const bf16_t*)(F.ws + WS_W_FI + 11 * MiB), MLAT, 2 * FFH, DM}; pg8::StaticOrder S; S.init(MLAT, 2 * FFH, F.G, obx());
        EpiSwiglu E{(bf16_t*)(F.ws + WS_ACT)};
        pg8::gemm_phase<EpiSwiglu, pg8::StaticOrder, PG8_ALIGN, PG8_SP2>(F.lds, g, S, E); }
    SEAM(15); TSTAMP(15);
    if (IN(16)) for (int rep_ = 0; rep_ <= ((PH_REP >> (16)) & 1); ++rep_) { if (rep_) REPBAR(); FRAME(); Gemm g{(const bf16_t*)(F.ws + WS_ACT), (const bf16_t*)(F.ws + WS_W_FO + 6 * MiB), MLAT, DM, FFH}; pg8::StaticOrder S; S.init(MLAT, DM, F.G, obx());
        EpiResid<true, false> E{XR, XR, F.out, F.out, MOD + 9 * 6144 + 5 * DM, nullptr};
        pg8::gemm_phase<EpiResid<true, false>, pg8::StaticOrder, PG8_ALIGN, PG8_SP2>(F.lds, g, S, E); }
    if (TS_PHASE >= 0) { TSTAMP(16); REPBAR();
        if (blockIdx.x == TS_BLOCK && threadIdx.x == 0) { volatile LAS unsigned long long* ts = (volatile LAS unsigned long long*)(lds + MISC_OFF + 256); const float us = TS_PHASE == 119 ? (float)ts[21] * 0.01f : TS_PHASE == 118 ? (float)ts[18] * 0.1f : TS_PHASE == 117 ? ((float)ts[20] * 10.f + fminf((float)ts[18] * 0.001f, 9.f)) * 100.f : TS_PHASE == 113 ? (float)ts[29] * 0.1f : (TS_PHASE == 115 || TS_PHASE == 116) ? (float)ts[19] * 0.01f : TS_PHASE == 110 ? (float)ts[28] * 0.1f : TS_PHASE == 111 ? (float)ts[29] * 0.01f : TS_PHASE == 112 ? (float)ts[30] * 0.01f : TS_PHASE == 105 ? (float)ts[24] * 0.1f : TS_PHASE == 106 ? (float)ts[25] * 0.01f : TS_PHASE == 107 ? (float)ts[26] * 0.1f : TS_PHASE == 108 ? (float)ts[27] * 10.f : TS_PHASE == 99 ? (float)(ts[17] - ts[0]) * 0.01f - 2000.f : TS_PHASE == 101 ? (float)(ts[21] - ts[20]) * 0.1f : TS_PHASE == 102 ? (float)(ts[22] - ts[21]) * 0.1f : TS_PHASE == 103 ? (float)(ts[23] - ts[22]) * 0.1f : TS_PHASE == 104 ? (float)(ts[12] - ts[23]) * 0.1f : (float)(ts[TS_PHASE < 100 ? TS_PHASE + 1 : 0] - ts[TS_PHASE < 100 ? TS_PHASE : 0]) * 0.01f; mkframe().out[0] += (us - (float)TS_SUB) * 0.01f * TS_SCALE; } }
#undef IN
#undef SEAM
#undef FRAME
}
}

#ifndef DBG_CHK
#define DBG_CHK 0
#endif
#ifndef DBG_PH_END
#define DBG_PH_END 17
#endif

#if DBG_CHK
namespace dbg {
using namespace mk;
constexpr int RS = 3, NRS = (nv::R + RS - 1) / RS;
__device__ __forceinline__ size_t mrow(int r) { return r < 4096 ? (size_t)r : (size_t)MLAT + (r - 4096); }
__device__ __forceinline__ float kimg_get(const unsigned char* base, int slot_bytes, int bh, int r, int d) {
    const int kt = r >> 6, kk = r & 63; const unsigned char* img = base + ((size_t)bh * NKT + kt) * slot_bytes; return bf2f(*(const bf16_t*)(img + (d >> 3) * 1024 + kk * 16 + (d & 7) * 2)); }
__device__ __forceinline__ float vimg_get(const unsigned char* base, int slot_bytes, int bh, int r, int dv) {
    const int kt = r >> 6, kk = r & 63; const unsigned char* img = base + ((size_t)bh * NKT + kt) * slot_bytes; return bf2f(*(const bf16_t*)(img + (dv >> 5) * 4096 + (kk >> 4) * 1024 + (kk & 15) * 64 + (dv & 31) * 2)); }
template <int CHK> __device__ __forceinline__ int ncols() { return CHK == 2 ? 2304 : CHK == 6 ? 2048 : 1024; }
template <int CHK> __global__ void k_snap(const unsigned char* ws, float* SNAP) {
    const int NC = ncols<CHK>(); const size_t idx = (size_t)blockIdx.x * 256 + threadIdx.x; if (idx >= (size_t)NRS * NC) return;
    const int rs = (int)(idx / NC), c = (int)(idx % NC), r = rs * RS; const size_t m = mrow(r); float v = 0.f;
    if (CHK == 1) v = bf2f(((const bf16_t*)(ws + WS_HN))[m * DM + c]);
    else if (CHK == 2) {
        if (c < 1024) v = bf2f(((const bf16_t*)(ws + WS_Q))[m * DM + c]) / (0.125f * LOG2E);
        else if (c < 1152) v = kimg_get(ws + WS_KA, 8192, (c - 1024) >> 6, r, c & 63);
        else if (c < 1280) v = vimg_get(ws + WS_VA, 8192, (c - 1152) >> 6, r, c & 63);
        else if (c < 1792) v = kimg_get(ws + WS_KB, 8192, (c - 1280) >> 6, r, c & 63);
        else v = vimg_get(ws + WS_VB, 16384, (c - 1792) >> 7, r, (c - 1792) & 127);
    } else if (CHK == 3 || CHK == 7) v = bf2f(((const bf16_t*)(ws + WS_MIX))[m * DM + c]);
    else if (CHK == 4 || CHK == 5) v = bf2f(((const bf16_t*)(ws + WS_XR))[m * DM + c]);
    else if (CHK == 6) {
        if (c < 512) v = r < 4096 ? bf2f(((const bf16_t*)(ws + WS_Q2))[m * 512 + c]) / (0.08838834764831845f * LOG2E) : 0.f;
        else if (c < 1024) v = kimg_get(ws + WS_KD, 16384, (c - 512) >> 7, r, (c - 512) & 127);
        else if (c < 1536) v = vimg_get(ws + WS_VD, 16384, (c - 1024) >> 7, r, (c - 1024) & 127);
        else v = r < 4096 ? bf2f(((const bf16_t*)(ws + WS_MIX))[m * DM + (c - 1536)]) : 0.f;
    }
    SNAP[idx] = v;
}
template <int CHK> __global__ void k_cmp(nv::Bufs B, const float* SNAP, unsigned* res) {
    const int NC = ncols<CHK>(); const size_t idx = (size_t)blockIdx.x * 256 + threadIdx.x; if (idx >= (size_t)NRS * NC) return;
    const int rs = (int)(idx / NC), c = (int)(idx % NC), r = rs * RS; float ref = 0.f; bool skip = false;
    if (CHK == 1) ref = B.H[(size_t)r * 1024 + c];
    else if (CHK == 2) ref = B.PL[(size_t)r * 2304 + c];
    else if (CHK == 3) ref = B.MIX[(size_t)r * 1024 + c];
    else if (CHK == 7) { ref = B.MIX[(size_t)r * 1024 + c]; skip = r >= 4096; }
    else if (CHK == 4 || CHK == 5) ref = B.X[(size_t)r * 1024 + c];
    else if (CHK == 6) {
        if (c < 512) { ref = B.QU[(size_t)r * 512 + c]; skip = r >= 4096; }
        else if (c < 1024) ref = B.KC[(size_t)r * 512 + (c - 512)];
        else if (c < 1536) { const int h = (c - 1024) >> 7, dv = (c - 1024) & 127; ref = B.KVU[(size_t)r * 768 + h * 192 + 64 + dv]; }
        else { ref = B.MIX[(size_t)r * 1024 + (c - 1536)]; skip = r >= 4096; }
    }
    if (skip) return;
    const float d = fabsf(ref - SNAP[idx]);
    atomicMax(res + 0, __float_as_uint(d == d ? d : INFINITY)); atomicMax(res + 1, __float_as_uint(fabsf(ref)));
}
__global__ void k_cmp_mod(const float* modA, const float* modB, unsigned* res) {
    const int idx = blockIdx.x * 256 + threadIdx.x; if (idx >= 2 * 9 * 6144) return;
    const float d = fabsf(modA[idx] - modB[idx]); atomicMax(res + 0, __float_as_uint(d == d ? d : INFINITY)); atomicMax(res + 1, __float_as_uint(fabsf(modA[idx])));
}
__global__ void k_code(float* out, size_t n, const unsigned* res, float thresh) {
    const float md = __uint_as_float(res[0]), mr = __uint_as_float(res[1]); const float rel = md / fmaxf(mr, 1e-20f);
    float code = 0.f; if (!(rel <= thresh)) code = 10.f + log10f(fminf(fmaxf(rel, 1e-9f), 1e9f));
    if (mr == 0.f) code = 77.f;
    if (code == 0.f) return;
    for (size_t i = (size_t)blockIdx.x * 256 + threadIdx.x; i < n; i += (size_t)gridDim.x * 256) out[i] += code;
}
static float* g_snap; static unsigned* g_res; static const float* g_mod_mk;
static void hook(int k, const nv::Bufs& B, hipStream_t st) {
    if (k != DBG_CHK) return;
    const size_t n = (size_t)NRS * (DBG_CHK == 2 ? 2304 : DBG_CHK == 6 ? 2048 : 1024);
    hipLaunchKernelGGL(k_cmp<DBG_CHK>, dim3((unsigned)((n + 255) / 256)), dim3(256), 0, st, B, (const float*)g_snap, g_res);
    if (DBG_CHK == 1) hipLaunchKernelGGL(k_cmp_mod, dim3((2 * 9 * 6144 + 255) / 256), dim3(256), 0, st, (const float*)B.MOD, g_mod_mk, g_res);
}
}
#endif

extern "C" void kernel_launch(void* const* d_in, const int* in_sizes, int n_in, void* d_out, int out_size, void* d_ws, size_t ws_size, hipStream_t stream) {
    static int grid = 0;
    if (grid == 0) {
        int dev = 0, cus = 0, per_cu = 0;
        hipGetDevice(&dev); hipDeviceGetAttribute(&cus, hipDeviceAttributeMultiprocessorCount, dev);
        if (hipFuncSetAttribute((const void*)mk::fwd, hipFuncAttributeMaxDynamicSharedMemorySize, mk::LDS_BYTES) != hipSuccess) fprintf(stderr, "kernel_launch: hipFuncSetAttribute failed\n");
        if (hipOccupancyMaxActiveBlocksPerMultiprocessor(&per_cu, (const void*)mk::fwd, mk::NTHR, mk::LDS_BYTES) != hipSuccess || per_cu < 1) { fprintf(stderr, "kernel_launch: occupancy query says %d\n", per_cu); per_cu = 1; }
        (void)hipGetLastError();
        grid = cus * per_cu;
        if (grid != 256) fprintf(stderr, "kernel_launch: grid %d (cus %d x %d) != 256: the static work split assumes 256 workgroups\n", grid, cus, per_cu);
        if (n_in != 34 || ws_size < mk::WS_END) fprintf(stderr, "kernel_launch: unexpected n_in %d / ws_size %zu\n", n_in, ws_size);
    }
#if DBG_CHK
    hipMemsetAsync((char*)d_ws + mk::WS_CTL, 0, mk::CTL_ZERO_BYTES, stream);
#endif
    mk::Args a{};
    for (int i = 0; i < 34; ++i) a.in[i] = (const float*)d_in[i];
    a.out = (float*)d_out; a.ws = (unsigned char*)d_ws;
#if DBG_CHK
    {
        hipLaunchKernelGGL(mk::fwd, dim3(grid), dim3(mk::NTHR), mk::LDS_BYTES, stream, a);
        float* SNAP = (float*)((char*)d_ws + mk::WS_SNAP); unsigned* res = (unsigned*)((char*)d_ws + mk::WS_END - 4096);
        const size_t n = (size_t)dbg::NRS * (DBG_CHK == 2 ? 2304 : DBG_CHK == 6 ? 2048 : 1024);
        hipLaunchKernelGGL(dbg::k_snap<DBG_CHK>, dim3((unsigned)((n + 255) / 256)), dim3(256), 0, stream, (const unsigned char*)d_ws, SNAP);
        float* modc = (float*)((char*)d_ws + mk::WS_END - 1024 * 1024);
        hipMemcpyAsync(modc, (char*)d_ws + mk::WS_MOD, 2 * 9 * 6144 * 4, hipMemcpyDeviceToDevice, stream);
        hipMemsetAsync(res, 0, 64, stream);
        dbg::g_snap = SNAP; dbg::g_res = res; dbg::g_mod_mk = modc;
        nv::In I; const float** ip = (const float**)&I; for (int i = 0; i < 34; ++i) ip[i] = (const float*)d_in[i];
        nv::forward(I, (float*)d_out, (float*)d_ws, 0, 8, stream, dbg::hook);
        hipLaunchKernelGGL(dbg::k_code, dim3(1024), dim3(256), 0, stream, (float*)d_out, (size_t)out_size, (const unsigned*)res, 0.03f);
    }
#else
    void* args[] = {&a};
    hipError_t e = hipLaunchCooperativeKernel((const void*)mk::fwd, dim3(grid), dim3(mk::NTHR), args, mk::LDS_BYTES, stream);
    if (e != hipSuccess) fprintf(stderr, "kernel_launch: cooperative launch failed: %s (grid %d)\n", hipGetErrorString(e), grid);
#endif
}
```

```cpp
#define DBG_CHK 0
#define DBG_PH_END 17
#include <hip/hip_runtime.h>
#include <cstdio>
#include <cstdint>
#ifndef TS_PHASE
#define TS_PHASE -1
#endif
#ifndef TS_BLOCK
#define TS_BLOCK 0
#endif
#define TS_GEMM (TS_PHASE >= 110 && TS_PHASE <= 114)
#ifndef TS_GEMM_ID
#define TS_GEMM_ID -1
#endif
#ifndef PG8_PRIO
#define PG8_PRIO 1
#endif
#ifndef PG8_WGM
#define PG8_WGM 8
#endif
namespace pg8 {
#define PG8_LAS __attribute__((address_space(3)))
typedef unsigned short bf16_t;
typedef short bf16x8 __attribute__((ext_vector_type(8)));
typedef float f32x4 __attribute__((ext_vector_type(4)));
typedef unsigned u32x4 __attribute__((ext_vector_type(4)));
constexpr int BM = 256, BK = 64, HALF = 128, HTB = HALF * BK * 2  , STAGE_BYTES = 8 * HTB, NXCD = 8, WGM = PG8_WGM;

__host__ __device__ __forceinline__ int lds_byte(int r, int c) { const int st = (r >> 4) * 2 + (c >> 5), rr = r & 15, cc = c & 31, ob = rr * 64 + cc * 2; return st * 1024 + (ob ^ (((ob >> 9) & 1) << 5)); }
__host__ __device__ __forceinline__ void stage_rc(int b, int& R, int& C) { const int st = b / 1024, sb = b % 1024, swz = sb ^ (((sb >> 9) & 1) << 5); R = (st >> 1) * 16 + swz / 64; C = (st & 1) * 32 + (swz % 64) / 2; }
__host__ __device__ __forceinline__ int perm32(int rho) { const int n = rho >> 4, i = rho & 15; return 8 * (i >> 2) + 4 * n + (i & 3); }

struct Unit { int pm, pn, k0, nt, aux; };
struct Gemm { const bf16_t* A; const bf16_t* Bt; int M, N, K; };

struct StaticOrder {
    int nM, nN, nwg, G, c;
    __host__ __device__ void init(int M, int N, int G_, int c_) { nM = M / BM; nN = N / BM; nwg = nM * nN; G = G_; c = c_; }
    __host__ __device__ bool next(int i, Unit& u) const {
        const long L = (long)i * G + c; if (L >= nwg) return false;
        int wgid = (int)L; { const int q = nwg / NXCD, r = nwg % NXCD, xcd = wgid % NXCD, off = wgid / NXCD; wgid = (xcd < r ? xcd * (q + 1) : r * (q + 1) + (xcd - r) * q) + off; }
        const int nig = WGM * nN, gid = wgid / nig, fm = gid * WGM, gsz = (nM - fm) < WGM ? (nM - fm) : WGM;
        u.pm = fm + ((wgid % nig) % gsz); u.pn = (wgid % nig) / gsz; u.k0 = 0; u.nt = 0; u.aux = 0; return true;
    }
    __device__ __forceinline__ void a_ready(const Unit&) const {}
    __device__ __forceinline__ void done(const Unit&) const {}
};

__device__ __forceinline__ unsigned cvt_pk_bf16(float lo, float hi) { unsigned r; asm volatile("v_cvt_pk_bf16_f32 %0, %1, %2" : "=v"(r) : "v"(lo), "v"(hi)); return r; }
typedef float f32x2 __attribute__((ext_vector_type(2)));
__device__ __forceinline__ f32x2 gelu_pk(f32x2 v) {
    const f32x2 av = __builtin_elementwise_abs(v), d = av * 0.2316418882f + 1.0f;
    f32x2 t; t.x = __builtin_amdgcn_rcpf(d.x); t.y = __builtin_amdgcn_rcpf(d.y);
    f32x2 q = t * 0.5307027145f + (-0.7265760135f); q = q * t + 0.7107068705f; q = q * t + (-0.142248368f); q = q * t + 0.127414796f; q = q * t;
    const f32x2 s = (v * v) * (-0.72134752044f);
    f32x2 e; e.x = __builtin_amdgcn_exp2f(s.x); e.y = __builtin_amdgcn_exp2f(s.y);
    const f32x2 m = v * (q * e), r = v - m;
    f32x2 o; o.x = v.x < 0.f ? m.x : r.x; o.y = v.y < 0.f ? m.y : r.y; return o;
}

template <int ACT  > struct EpiBf16 {
    static constexpr bool PERM = true, AFTER_DRAIN = false; static_assert(ACT == 0 || ACT == 1, "EpiBf16: ACT is 0 (none) or 1 (gelu_pk)");
    bf16_t* O; int ldc; const float* bias; int split_cols; size_t split_stride; float scale0;
    __device__ __forceinline__ void operator()(const f32x4 (&acc)[2][2][4][2], const Unit& u, int wr, int wc, int fr, int fq) const {
        const int row0 = u.pm * BM + wr * 64 + fr; int colt = u.pn * BM; bf16_t* base = O;
        float sc = 1.f; if (split_cols) { const int t = colt / split_cols; base += (size_t)t * split_stride; colt -= t * split_cols; if (t == 0) sc = scale0; }
        const int col0 = colt + wc * 32 + 8 * fq, bcol0 = u.pn * BM + wc * 32 + 8 * fq;
        f32x4 bv[2][2];
#pragma unroll
        for (int bj = 0; bj < 2; ++bj)
#pragma unroll
            for (int n = 0; n < 2; ++n) bv[bj][n] = bias ? *(const f32x4*)(bias + bcol0 + bj * HALF + 4 * n) : (f32x4){0.f, 0.f, 0.f, 0.f};
#pragma unroll
        for (int ai = 0; ai < 2; ++ai)
#pragma unroll
            for (int m = 0; m < 4; ++m) { bf16_t* rowp = base + (size_t)(row0 + ai * HALF + m * 16) * ldc + col0;
#pragma unroll
                for (int bj = 0; bj < 2; ++bj) { f32x4 v0 = acc[ai][bj][m][0] + bv[bj][0], v1 = acc[ai][bj][m][1] + bv[bj][1];
                    if (ACT == 1) { f32x2 a = gelu_pk((f32x2){v0[0], v0[1]}), b = gelu_pk((f32x2){v0[2], v0[3]}), c = gelu_pk((f32x2){v1[0], v1[1]}), d = gelu_pk((f32x2){v1[2], v1[3]});
                        v0 = (f32x4){a.x, a.y, b.x, b.y}; v1 = (f32x4){c.x, c.y, d.x, d.y}; }
                    v0 = v0 * sc; v1 = v1 * sc; u32x4 w; w.x = cvt_pk_bf16(v0[0], v0[1]); w.y = cvt_pk_bf16(v0[2], v0[3]); w.z = cvt_pk_bf16(v1[0], v1[1]); w.w = cvt_pk_bf16(v1[2], v1[3]);
                    *(u32x4*)(rowp + bj * HALF) = w; } }
    }
};

struct PanelStats {
    unsigned* xbuf;
    unsigned* cnt;
    unsigned* tmo;
    int ntn; float eps;
    unsigned code;
    __device__ __forceinline__ bool run(const f32x4 (&v)[2][2][4][2], const Unit& u, int wr, int wc, int fr, int fq, PG8_LAS unsigned char* lds, int wid, int lane) const {
        typedef float f32x2v __attribute__((ext_vector_type(2)));
        PG8_LAS f32x2v* P = (PG8_LAS f32x2v*)lds;
        PG8_LAS f32x2v* S = (PG8_LAS f32x2v*)(lds + 8192);
        PG8_LAS unsigned* flag = (PG8_LAS unsigned*)(lds + 8192 + 2048);
#pragma unroll
        for (int ai = 0; ai < 2; ++ai)
#pragma unroll
            for (int m = 0; m < 4; ++m) {
                float s = 0.f;
#pragma unroll
                for (int bj = 0; bj < 2; ++bj)
#pragma unroll
                    for (int n = 0; n < 2; ++n) { const f32x4 x = v[ai][bj][m][n]; s += (x[0] + x[1]) + (x[2] + x[3]); }
                s += __shfl_xor(s, 16); s += __shfl_xor(s, 32);
                const float mw = s * (1.0f / 64.0f); float q = 0.f;
#pragma unroll
                for (int bj = 0; bj < 2; ++bj)
#pragma unroll
                    for (int n = 0; n < 2; ++n) { const f32x4 d = v[ai][bj][m][n] - mw; q += (d[0] * d[0] + d[1] * d[1]) + (d[2] * d[2] + d[3] * d[3]); }
                q += __shfl_xor(q, 16); q += __shfl_xor(q, 32);
                if (fq == 0) P[(ai * HALF + wr * 64 + m * 16 + fr) * 4 + wc] = (f32x2v){mw, q};
            }
        asm volatile("s_waitcnt lgkmcnt(0)" ::: "memory"); __builtin_amdgcn_s_barrier(); asm volatile("" ::: "memory");
#if defined(BROKEN_EXCHANGE_NO_WAIT)
#warning BROKEN CONTROL BUILD: the row-statistics exchange does not wait; results are wrong by design
        if (blockIdx.x >= 64) { const long long t0_ = clock64(); while (clock64() - t0_ < 60000) __builtin_amdgcn_s_sleep(8); }
#endif
        const int row = wid * 32 + (lane & 31);
        if (lane < 32) {
            const f32x2v a = P[row * 4 + 0], b = P[row * 4 + 1], c = P[row * 4 + 2], d = P[row * 4 + 3];
            const float mt = (a.x + b.x + c.x + d.x) * 0.25f;
            const float da = a.x - mt, db = b.x - mt, dc = c.x - mt, dd = d.x - mt;
            const float m2 = (a.y + b.y) + (c.y + d.y) + 64.0f * ((da * da + db * db) + (dc * dc + dd * dd));
            unsigned long long* slot = (unsigned long long*)xbuf + ((size_t)(u.pm * BM + row) * 4 + u.pn);
            __hip_atomic_store(slot, ((unsigned long long)__float_as_uint(m2) << 32) | __float_as_uint(mt), __ATOMIC_RELAXED, __HIP_MEMORY_SCOPE_AGENT);
        }
        asm volatile("s_waitcnt vmcnt(0)" ::: "memory");
        if (lane == 0) __hip_atomic_fetch_add(cnt + 64 * u.pm, 1u, __ATOMIC_RELAXED, __HIP_MEMORY_SCOPE_AGENT);
        if (wid == 0) {
            bool dead = false; const unsigned long long t0 = __builtin_amdgcn_s_memrealtime(); const unsigned want = 8u * (unsigned)ntn;
            for (;;) {
#if defined(BROKEN_EXCHANGE_NO_WAIT)
                break;
#endif
                if ((unsigned)__builtin_amdgcn_readfirstlane(__hip_atomic_load(cnt + 64 * u.pm, __ATOMIC_RELAXED, __HIP_MEMORY_SCOPE_AGENT)) >= want) break;
                if (__builtin_amdgcn_s_memrealtime() - t0 > 2000000ull) {
                    if (lane == 0) { unsigned expect = 0u; __hip_atomic_compare_exchange_strong(tmo + 1, &expect, code | (unsigned)(u.pm & 0xff), __ATOMIC_RELAXED, __ATOMIC_RELAXED, __HIP_MEMORY_SCOPE_AGENT);
                                     __hip_atomic_store(tmo, 1u, __ATOMIC_RELAXED, __HIP_MEMORY_SCOPE_AGENT); }
                    dead = true; break; }
                __builtin_amdgcn_s_sleep(2);
            }
            __builtin_amdgcn_fence(__ATOMIC_ACQUIRE, "agent");
            if (lane == 0) flag[0] = dead ? 1u : 0u;
        }
        asm volatile("s_waitcnt vmcnt(0) lgkmcnt(0)" ::: "memory"); __builtin_amdgcn_s_barrier(); asm volatile("" ::: "memory");
        const bool bad = flag[0] != 0u;
        if (lane < 32) {
            const unsigned long long* slot = (const unsigned long long*)xbuf + (size_t)(u.pm * BM + row) * 4; float mt[4], m2[4]; float ms = 0.f;
#pragma unroll
            for (int t = 0; t < 4; ++t) { if (t < ntn) { const unsigned long long w = __hip_atomic_load(slot + t, __ATOMIC_RELAXED, __HIP_MEMORY_SCOPE_AGENT); mt[t] = __uint_as_float((unsigned)w); m2[t] = __uint_as_float((unsigned)(w >> 32)); } else { mt[t] = 0.f; m2[t] = 0.f; } ms += mt[t]; }
            const float mean = ms / (float)ntn; float q = 0.f;
#pragma unroll
            for (int t = 0; t < 4; ++t) if (t < ntn) { const float dm = mt[t] - mean; q += m2[t] + 256.0f * dm * dm; }
            S[row] = (f32x2v){mean, 1.0f / sqrtf(q / (256.0f * (float)ntn) + eps)};
        }
        asm volatile("s_waitcnt lgkmcnt(0)" ::: "memory"); __builtin_amdgcn_s_barrier(); asm volatile("" ::: "memory");
        return bad;
    }
};
struct EpiLnRes {
    static constexpr bool PERM = false, AFTER_DRAIN = true;
    const float* base; float* out; int ldc; const float* bias; PanelStats st; unsigned poison;
    __device__ __forceinline__ void fused(f32x4 (&acc)[2][2][4][2], const Unit& u, int wr, int wc, int fr, int fq, PG8_LAS unsigned char* lds, int wid, int lane) const {
        typedef float f32x2v __attribute__((ext_vector_type(2)));
        const PG8_LAS f32x2v* S = (const PG8_LAS f32x2v*)(lds + 8192);
        const int col0 = u.pn * BM + wc * 32 + 4 * fq;
#pragma unroll
        for (int bj = 0; bj < 2; ++bj)
#pragma unroll
            for (int n = 0; n < 2; ++n) { const f32x4 bv = bias ? *(const f32x4*)(bias + col0 + bj * HALF + n * 16) : (f32x4){0.f, 0.f, 0.f, 0.f};
#pragma unroll
                for (int ai = 0; ai < 2; ++ai)
#pragma unroll
                    for (int m = 0; m < 4; ++m) acc[ai][bj][m][n] += bv; }
        f32x4 pre[4][2][2];
#pragma unroll
        for (int m = 0; m < 4; ++m) { const size_t off = (size_t)(u.pm * BM + wr * 64 + m * 16 + fr) * ldc + col0;
#pragma unroll
            for (int bj = 0; bj < 2; ++bj)
#pragma unroll
                for (int n = 0; n < 2; ++n) pre[m][bj][n] = *(const f32x4*)(base + off + bj * HALF + n * 16); }
        const bool bad = st.run(acc, u, wr, wc, fr, fq, lds, wid, lane) || poison != 0u;
        const float qnan = __builtin_nanf("");
#pragma unroll
        for (int ai = 0; ai < 2; ++ai)
#pragma unroll
            for (int m = 0; m < 4; ++m) { const int r = ai * HALF + wr * 64 + m * 16 + fr; const f32x2v sr = S[r]; const size_t off = (size_t)(u.pm * BM + r) * ldc + col0;
#pragma unroll
                for (int bj = 0; bj < 2; ++bj)
#pragma unroll
                    for (int n = 0; n < 2; ++n) { const f32x4 bs = ai == 0 ? pre[m][bj][n] : *(const f32x4*)(base + off + bj * HALF + n * 16); f32x4 o = bs + (acc[ai][bj][m][n] - sr.x) * sr.y;
                        if (bad) o = (f32x4){qnan, qnan, qnan, qnan}; *(f32x4*)(out + off + bj * HALF + n * 16) = o; }
                if (m & 1) asm volatile("" ::: "memory"); }
    }
};
struct EpiLnResLn {
    static constexpr bool PERM = false, AFTER_DRAIN = true;
    const float* base; float* out; bf16_t* xn; int ldc; const float* bias; PanelStats st1, st2; unsigned poison;
    __device__ __forceinline__ void fused(f32x4 (&acc)[2][2][4][2], const Unit& u, int wr, int wc, int fr, int fq, PG8_LAS unsigned char* lds, int wid, int lane) const {
        typedef float f32x2v __attribute__((ext_vector_type(2))); typedef unsigned u32x2v __attribute__((ext_vector_type(2)));
        const PG8_LAS f32x2v* S = (const PG8_LAS f32x2v*)(lds + 8192);
        const int col0 = u.pn * BM + wc * 32 + 4 * fq;
#pragma unroll
        for (int bj = 0; bj < 2; ++bj)
#pragma unroll
            for (int n = 0; n < 2; ++n) { const f32x4 bv = bias ? *(const f32x4*)(bias + col0 + bj * HALF + n * 16) : (f32x4){0.f, 0.f, 0.f, 0.f};
#pragma unroll
                for (int ai = 0; ai < 2; ++ai)
#pragma unroll
                    for (int m = 0; m < 4; ++m) acc[ai][bj][m][n] += bv; }
        bool bad = st1.run(acc, u, wr, wc, fr, fq, lds, wid, lane) || poison != 0u;
        const float qnan = __builtin_nanf("");
#pragma unroll
        for (int ai = 0; ai < 2; ++ai)
#pragma unroll
            for (int m = 0; m < 4; ++m) { const int r = ai * HALF + wr * 64 + m * 16 + fr; const f32x2v sr = S[r]; const size_t off = (size_t)(u.pm * BM + r) * ldc + col0;
#pragma unroll
                for (int bj = 0; bj < 2; ++bj)
#pragma unroll
                    for (int n = 0; n < 2; ++n) { const f32x4 bs = *(const f32x4*)(base + off + bj * HALF + n * 16); acc[ai][bj][m][n] = bs + (acc[ai][bj][m][n] - sr.x) * sr.y; }
                asm volatile("" : "+v"(acc[ai][0][m][0]), "+v"(acc[ai][0][m][1]), "+v"(acc[ai][1][m][0]), "+v"(acc[ai][1][m][1]));
                if (m & 1) asm volatile("" ::: "memory"); }
        const bool bad1 = bad;
        bad = st2.run(acc, u, wr, wc, fr, fq, lds, wid, lane) || bad;
#pragma unroll
        for (int ai = 0; ai < 2; ++ai)
#pragma unroll
            for (int m = 0; m < 4; ++m) { const int r = ai * HALF + wr * 64 + m * 16 + fr; const f32x2v sr = S[r]; const size_t off = (size_t)(u.pm * BM + r) * ldc + col0;
#pragma unroll
                for (int bj = 0; bj < 2; ++bj)
#pragma unroll
                    for (int n = 0; n < 2; ++n) { const f32x4 x1 = acc[ai][bj][m][n]; *(f32x4*)(out + off + bj * HALF + n * 16) = bad1 ? (f32x4){qnan, qnan, qnan, qnan} : x1;
                        const f32x4 o = (x1 - sr.x) * sr.y; u32x2v w; w.x = cvt_pk_bf16(o[0], o[1]); w.y = cvt_pk_bf16(o[2], o[3]);
                        if (bad) { w.x = 0x7fc07fc0u; w.y = 0x7fc07fc0u; } *(u32x2v*)(xn + off + bj * HALF + n * 16) = w; }
                asm volatile("" ::: "memory"); }
    }
};

template <class Epi, class Sched, bool ALIGN_EPI = false, bool SP2 = false>
__device__ __forceinline__ void gemm_phase(PG8_LAS unsigned char* lds, const Gemm g, const Sched& S, const Epi& E) {
    int tid_ = threadIdx.x; asm volatile("" : "+v"(tid_));
    const int tid = tid_, wid = __builtin_amdgcn_readfirstlane(tid >> 6), lane = tid & 63, wr = wid >> 2, wc = wid & 3, fr = lane & 15, fq = lane >> 4;
    const int K = g.K, ntf = K / BK;
    unsigned voffA[2], voffB[2];
#pragma unroll
    for (int i = 0; i < 2; ++i) { int R, C; stage_rc(tid * 16 + i * 8192, R, C); const int Rb = Epi::PERM ? ((R & ~31) + perm32(R & 31)) : R;
        voffA[i] = (unsigned)(R * K + C) * 2u; voffB[i] = (unsigned)(Rb * K + C) * 2u; }
    const size_t kstep = (size_t)(BK * 2);
    const size_t hstep = (size_t)HALF * K * 2;
    const size_t tstep = 2 * hstep;
    const unsigned ldsw = (unsigned)wid * 1024u;
    const int aoff = lds_byte(wr * 64 + fr, fq * 8), boff = lds_byte(wc * 32 + fr, fq * 8);
#define PG8_SA(b, h) (((b) * 2 + (h)) * HTB)
#define PG8_SB(b, h) ((4 + (b) * 2 + (h)) * HTB)
#define PG8_STAGE(bufoff, gbase, voff) do { _Pragma("unroll") for (int _i = 0; _i < 2; ++_i) \
        __builtin_amdgcn_global_load_lds((const unsigned*)((const char*)(gbase) + (voff)[_i]), (PG8_LAS unsigned*)(lds + (bufoff) + ldsw + _i * 8192), 16, 0, 0); } while (0)
#define PG8_LDA(dst, b, h) do { _Pragma("unroll") for (int m = 0; m < 4; ++m) _Pragma("unroll") for (int k = 0; k < 2; ++k) dst[m][k] = *(const PG8_LAS bf16x8*)(lds + PG8_SA(b, h) + aoff + m * 2048 + k * 1024); } while (0)
#define PG8_LDB(dst, b, h) do { _Pragma("unroll") for (int n = 0; n < 2; ++n) _Pragma("unroll") for (int k = 0; k < 2; ++k) dst[n][k] = *(const PG8_LAS bf16x8*)(lds + PG8_SB(b, h) + boff + n * 2048 + k * 1024); } while (0)
#define PG8_MMA(ai, bj, At, Bt) do { if (PG8_PRIO) __builtin_amdgcn_s_setprio(PG8_PRIO); _Pragma("unroll") for (int m = 0; m < 4; ++m) _Pragma("unroll") for (int n = 0; n < 2; ++n) _Pragma("unroll") for (int k = 0; k < 2; ++k) \
        acc[ai][bj][m][n] = __builtin_amdgcn_mfma_f32_16x16x32_bf16(Bt[n][k], At[m][k], acc[ai][bj][m][n], 0, 0, 0); if (PG8_PRIO) __builtin_amdgcn_s_setprio(0); } while (0)
#define PG8_WAIT_V(n) asm volatile("s_waitcnt vmcnt(" #n ")" ::: "memory")
#define PG8_WAIT_L(n) asm volatile("s_waitcnt lgkmcnt(" #n ")" ::: "memory")
#define PG8_BAR __builtin_amdgcn_s_barrier()
#define PG8_SCHED __builtin_amdgcn_sched_barrier(0)
    const unsigned long long tg_in = TS_GEMM ? __builtin_amdgcn_s_memrealtime() : 0ull; unsigned long long tg_ep = 0, tg_l0 = 0; (void)tg_in; (void)tg_ep; (void)tg_l0;
    Unit cur, nxt; int ui = 0;
    if (!S.next(0, cur)) return;
    f32x4 acc[2][2][4][2];
#pragma unroll
    for (int a = 0; a < 2; ++a)
#pragma unroll
        for (int b = 0; b < 2; ++b)
#pragma unroll
            for (int m = 0; m < 4; ++m)
#pragma unroll
                for (int n = 0; n < 2; ++n) acc[a][b][m][n] = (f32x4){0.f, 0.f, 0.f, 0.f};
    bf16x8 At[4][2], B0[2][2], B1[2][2];
    const char* cA = (const char*)g.A + (size_t)cur.pm * tstep + (size_t)cur.k0 * 2; const char* cB = (const char*)g.Bt + (size_t)cur.pn * tstep + (size_t)cur.k0 * 2;
    S.a_ready(cur);
    if constexpr (SP2) {
        PG8_STAGE(PG8_SB(0, 0), cB, voffB); PG8_STAGE(PG8_SB(0, 1), cB + hstep, voffB); PG8_STAGE(PG8_SA(0, 0), cA, voffA); PG8_STAGE(PG8_SA(0, 1), cA + hstep, voffA);
        if (wr == 1) PG8_BAR;
        PG8_WAIT_V(2); PG8_BAR;
        PG8_STAGE(PG8_SB(1, 0), cB + kstep, voffB); PG8_STAGE(PG8_SA(1, 0), cA + kstep, voffA); PG8_STAGE(PG8_SB(1, 1), cB + hstep + kstep, voffB);
        PG8_WAIT_V(6); PG8_BAR;
    } else {
        PG8_STAGE(PG8_SB(0, 0), cB, voffB); PG8_STAGE(PG8_SA(0, 0), cA, voffA); PG8_STAGE(PG8_SB(0, 1), cB + hstep, voffB); PG8_STAGE(PG8_SA(0, 1), cA + hstep, voffA);
        if (wr == 1) PG8_BAR;
        PG8_WAIT_V(4); PG8_BAR;
        PG8_STAGE(PG8_SB(1, 0), cB + kstep, voffB); PG8_STAGE(PG8_SA(1, 0), cA + kstep, voffA); PG8_STAGE(PG8_SB(1, 1), cB + hstep + kstep, voffB);
        PG8_WAIT_V(6); PG8_BAR;
    }
    if (TS_GEMM) tg_l0 = __builtin_amdgcn_s_memrealtime();
    for (;;) {
        const bool has_next = S.next(ui + 1, nxt);
        const char* nA = has_next ? (const char*)g.A + (size_t)nxt.pm * tstep + (size_t)nxt.k0 * 2 : cA; const char* nB = has_next ? (const char*)g.Bt + (size_t)nxt.pn * tstep + (size_t)nxt.k0 * 2 : cB;
        const int nt = cur.nt ? cur.nt : ntf;
        for (int t = 0; t < nt; t += 2) {
            const bool last = (t == nt - 2);
            const char* a1 = cA + (size_t)(t + 1) * kstep;
            const char* a2 = last ? nA : cA + (size_t)(t + 2) * kstep; const char* b2 = last ? nB : cB + (size_t)(t + 2) * kstep;
            const char* a3 = a2 + kstep; const char* b3 = b2 + kstep;
            if (last && has_next) S.a_ready(nxt);
            if constexpr (SP2) {
            PG8_LDB(B0, 0, 0); PG8_LDB(B1, 0, 1); PG8_SCHED; PG8_LDA(At, 0, 0); PG8_STAGE(PG8_SA(1, 1), a1 + hstep, voffA);
            PG8_WAIT_V(8); PG8_WAIT_L(0); PG8_BAR; PG8_MMA(0, 0, At, B0); PG8_MMA(0, 1, At, B1); PG8_BAR; PG8_SCHED;
            PG8_LDA(At, 0, 1); PG8_STAGE(PG8_SB(0, 0), b2, voffB); PG8_STAGE(PG8_SB(0, 1), b2 + hstep, voffB); PG8_STAGE(PG8_SA(0, 0), a2, voffA);
            PG8_WAIT_V(8); PG8_WAIT_L(0); PG8_BAR; PG8_MMA(1, 0, At, B0); PG8_MMA(1, 1, At, B1); PG8_BAR; PG8_SCHED;
            PG8_LDB(B0, 1, 0); PG8_LDB(B1, 1, 1); PG8_SCHED; PG8_LDA(At, 1, 0); PG8_STAGE(PG8_SA(0, 1), a2 + hstep, voffA);
            PG8_WAIT_V(8); PG8_WAIT_L(0); PG8_BAR; PG8_MMA(0, 0, At, B0); PG8_MMA(0, 1, At, B1); PG8_BAR; PG8_SCHED;
            PG8_LDA(At, 1, 1); PG8_STAGE(PG8_SB(1, 0), b3, voffB); PG8_STAGE(PG8_SB(1, 1), b3 + hstep, voffB); PG8_STAGE(PG8_SA(1, 0), a3, voffA);
            PG8_WAIT_V(8); PG8_WAIT_L(0); PG8_BAR; PG8_MMA(1, 0, At, B0); PG8_MMA(1, 1, At, B1); PG8_BAR; PG8_SCHED;
            } else {
            PG8_LDB(B0, 0, 0); PG8_SCHED; PG8_LDA(At, 0, 0); PG8_STAGE(PG8_SA(1, 1), a1 + hstep, voffA);
            PG8_WAIT_L(8); PG8_BAR; PG8_WAIT_L(0); PG8_MMA(0, 0, At, B0); PG8_BAR; PG8_SCHED;
            PG8_LDB(B1, 0, 1); PG8_STAGE(PG8_SB(0, 0), b2, voffB);
            PG8_BAR; PG8_WAIT_L(0); PG8_MMA(0, 1, At, B1); PG8_BAR;
            PG8_LDA(At, 0, 1); PG8_STAGE(PG8_SA(0, 0), a2, voffA);
            PG8_BAR; PG8_WAIT_L(0); PG8_MMA(1, 0, At, B0); PG8_BAR; PG8_SCHED;
            PG8_STAGE(PG8_SB(0, 1), b2 + hstep, voffB);
            PG8_WAIT_V(6); PG8_BAR; PG8_MMA(1, 1, At, B1); PG8_BAR;
            PG8_LDB(B0, 1, 0); PG8_SCHED; PG8_LDA(At, 1, 0); PG8_STAGE(PG8_SA(0, 1), a2 + hstep, voffA);
            PG8_WAIT_L(8); PG8_BAR; PG8_WAIT_L(0); PG8_MMA(0, 0, At, B0); PG8_BAR; PG8_SCHED;
            PG8_LDB(B1, 1, 1); PG8_STAGE(PG8_SB(1, 0), b3, voffB);
            PG8_BAR; PG8_WAIT_L(0); PG8_MMA(0, 1, At, B1); PG8_BAR;
            PG8_LDA(At, 1, 1); PG8_STAGE(PG8_SA(1, 0), a3, voffA);
            PG8_BAR; PG8_WAIT_L(0); PG8_MMA(1, 0, At, B0); PG8_BAR; PG8_SCHED;
            PG8_STAGE(PG8_SB(1, 1), b3 + hstep, voffB);
            PG8_WAIT_V(6); PG8_BAR; PG8_MMA(1, 1, At, B1); PG8_BAR;
            }
        }
        if constexpr (ALIGN_EPI) { if (wr == 0) PG8_BAR; }
        { const unsigned long long te0 = TS_GEMM ? __builtin_amdgcn_s_memrealtime() : 0ull;
        if constexpr (!Epi::AFTER_DRAIN) { E(acc, cur, wr, wc, fr, fq); S.done(cur); }
        if (TS_GEMM) tg_ep += __builtin_amdgcn_s_memrealtime() - te0; }
        if (!has_next) break;
#pragma unroll
        for (int a = 0; a < 2; ++a)
#pragma unroll
            for (int b = 0; b < 2; ++b)
#pragma unroll
                for (int m = 0; m < 4; ++m)
#pragma unroll
                    for (int n = 0; n < 2; ++n) acc[a][b][m][n] = (f32x4){0.f, 0.f, 0.f, 0.f};
        cur = nxt; cA = nA; cB = nB; ++ui;
        if constexpr (ALIGN_EPI) { if (wr == 1) PG8_BAR; }
    }
    PG8_WAIT_V(0);
    if constexpr (!ALIGN_EPI) { if (wr == 0) PG8_BAR; }
    PG8_BAR;
    if constexpr (Epi::AFTER_DRAIN) { E.fused(acc, cur, wr, wc, fr, fq, lds, wid, lane); S.done(cur); }
    if (TS_GEMM && blockIdx.x == TS_BLOCK && threadIdx.x == 0) { volatile PG8_LAS unsigned long long* ts = (volatile PG8_LAS unsigned long long*)(lds + 139264 + 8192 + 256); const unsigned long long te = __builtin_amdgcn_s_memrealtime(); const unsigned long long cid = ts[31]; ts[31] = cid + 1; if ((TS_PHASE != 113 && TS_PHASE != 114) || (int)cid == TS_GEMM_ID) { ts[28] += tg_l0 - tg_in; ts[29] += tg_ep; ts[30] += te - tg_in; } }
#undef PG8_SA
#undef PG8_SB
#undef PG8_STAGE
#undef PG8_LDA
#undef PG8_LDB
#undef PG8_MMA
#undef PG8_WAIT_V
#undef PG8_WAIT_L
#undef PG8_BAR
#undef PG8_SCHED
}
}

#ifndef PG8_SP2
#define PG8_SP2 true
#endif
#ifndef PG8_ALIGN
#define PG8_ALIGN true
#endif

#include <hip/hip_cooperative_groups.h>
namespace mk {
using pg8::bf16_t; using pg8::bf16x8; using pg8::f32x4; using pg8::u32x4; using pg8::f32x2; using pg8::Unit; using pg8::Gemm; using pg8::cvt_pk_bf16; using pg8::gelu_pk;
typedef float f32x16 __attribute__((ext_vector_type(16)));
typedef short s16x4 __attribute__((ext_vector_type(4)));
typedef short v4i16_t __attribute__((ext_vector_type(4)));
typedef __bf16 bf16x2_t __attribute__((ext_vector_type(2)));
typedef __attribute__((address_space(3))) const unsigned char* lds_cptr;
typedef __attribute__((address_space(3))) unsigned char* lds_ptr;

constexpr int DM = 1024, SEQ = 4096, CTXL = 256, NB = 8, MLAT = NB * SEQ, MCTX = NB * CTXL, MALL = MLAT + MCTX, FFH = 2816, NKT = 68;
constexpr float EPS = 1e-6f, LOG2E = 1.4426950408889634f;
constexpr int NWAVES = 8, NTHR = 512;
constexpr int NSL = 8;
constexpr size_t MiB = 1u << 20;
constexpr size_t WS_CTL = 0, CTL_ZERO_BYTES = 1 * MiB;
constexpr size_t WS_W_EV = 1 * MiB, WS_W_OD = 6 * MiB, WS_W_MIX = 10 * MiB  , WS_W_FI = 14 * MiB  , WS_W_FO = 36 * MiB  ;
constexpr size_t WS_W_UQ = 48 * MiB, WS_W_UKV = 48 * MiB + 256 * 1024, WS_W_S = 48 * MiB + 640 * 1024;
constexpr size_t WS_MODP = 49 * MiB;
constexpr size_t WS_MOD = WS_MODP + 7 * MiB - 256 * 1024;
constexpr size_t WS_VSS = 56 * MiB + 512 * 1024, WS_CQS = WS_VSS + 1152 * 1024, WS_CKS = WS_CQS + 1152 * 1024;
constexpr size_t WS_XR = 60 * MiB;
constexpr size_t WS_HN = 196 * MiB;
constexpr size_t WS_MIX = 264 * MiB;
constexpr size_t WS_S = 332 * MiB;
constexpr size_t WS_Q = WS_S, WS_KA = 400 * MiB, WS_VA = WS_KA + 8704 * 1024, WS_KB = 417 * MiB, WS_VB = 451 * MiB;
constexpr size_t WS_UACT = WS_S, WS_VACT = 364 * MiB, WS_CQ = 396 * MiB, WS_CKV = 412 * MiB, WS_KD = 429 * MiB, WS_VD = 463 * MiB;
constexpr size_t WS_OB = WS_HN, WS_Q2 = WS_HN;
constexpr size_t WS_PART = 451 * MiB;
constexpr size_t WS_ACT = WS_MIX;
constexpr size_t WS_SNAP = 498 * MiB, WS_END = 512 * MiB;
static_assert(WS_CQ + (size_t)MLAT * 256 * 2 == WS_CKV && WS_W_UQ + 512 * 256 * 2 == WS_W_UKV, "the combined MLA up-projection GEMM needs CQ | CKV and W_UQ | W_UKV contiguous");
static_assert(WS_MOD + 2 * 9 * 6144 * 4 <= WS_VSS && WS_CKS + 1152 * 1024 <= WS_XR, "ws map");
static_assert(WS_VA + 8704 * 1024 <= WS_KB && WS_VB + 34 * MiB <= WS_SNAP && WS_VD + 34 * MiB <= WS_SNAP && WS_ACT + (size_t)MALL * FFH * 2 <= WS_SNAP, "ws map 2");
constexpr int CW_BAR = 4096;
constexpr int RING_BYTES = 139264  , ROPE_OFF = RING_BYTES, MISC_OFF = ROPE_OFF + 8192, PTR_OFF = MISC_OFF + 512  , LDS_BYTES = RING_BYTES + 16384;

#ifndef TS_PHASE
#define TS_PHASE -1
#endif
#ifndef TS_BLOCK
#define TS_BLOCK 0
#endif
#define TS_ATT (TS_PHASE >= 105 && TS_PHASE <= 108)
#ifndef TS_SUB
#define TS_SUB 0
#endif
#ifndef TS_SCALE
#define TS_SCALE 1.0f
#endif
#ifndef AT_ABL
#define AT_ABL 0
#endif
#ifndef TS_CLK
#define TS_CLK 0
#endif
#ifndef TS_SEAM_LO
#define TS_SEAM_LO 1
#endif
#ifndef TS_SEAM_HI
#define TS_SEAM_HI 9
#endif
#ifndef TS_SEAM_SKIP
#define TS_SEAM_SKIP -1
#endif
#ifndef AT_KSO_B
#define AT_KSO_B 1
#endif
#ifndef AT_KSO_A
#define AT_KSO_A 0
#endif
#ifndef AT_KSO_MLA
#define AT_KSO_MLA 0
#endif
#ifndef AT_DMA_LATE
#define AT_DMA_LATE 0
#endif
#ifndef AT_KSO_A
#define AT_KSO_A 0
#endif
#ifndef GS_AT_START
#define GS_AT_START 1
#endif
#ifndef NT_LOADS
#define NT_LOADS 1
#endif
#ifndef NT_P0ST
#define NT_P0ST 1
#endif
#ifndef NT_P1ST
#define NT_P1ST 1
#endif
#ifndef CODE_PF
#define CODE_PF 1
#endif
#define CODE_PF_BYTES 229376
#ifndef TS_BASE
#define TS_BASE 2250
#endif
#define GAS __attribute__((address_space(1)))
#define LAS __attribute__((address_space(3)))
typedef GAS unsigned gu32;
#define RLX_AGENT __ATOMIC_RELAXED, __HIP_MEMORY_SCOPE_AGENT

#define XB_TMO      128
#define XB_XCNT(j)  (256  + 64 * (j))
#define XB_XSUB(j)  (1280 + 64 * (j))
#define XB_XGEN(j)  (2304 + 64 * (j))
#define XB_TOP      3328
#define XB_TOPGEN   3392
#define XCD_BAR_WORDS 3456
#define XB_SPIN_CAP (1u << 18)
__device__ __forceinline__ unsigned xb_ld(unsigned* p)              { return __hip_atomic_load(p, __ATOMIC_RELAXED, __HIP_MEMORY_SCOPE_AGENT); }
__device__ __forceinline__ unsigned xb_add(unsigned* p, unsigned v) { return __hip_atomic_fetch_add(p, v, __ATOMIC_RELAXED, __HIP_MEMORY_SCOPE_AGENT); }
__device__ __forceinline__ unsigned xb_xcc_id() { return (unsigned)__builtin_amdgcn_s_getreg((3 << 11) | 20) & 0xFu; }
#define XB_SPIN(cond, bar) do { unsigned _sp = 0; while (cond) { __builtin_amdgcn_s_sleep(1); \
    if ((++_sp & 255u) == 0u) { if (xb_ld(&(bar)[XB_TMO])) break; if (_sp > XB_SPIN_CAP) { atomicAdd(&(bar)[XB_TMO], 1u); break; } } } } while (0)
struct XcdBarrier { unsigned* bar; unsigned x; volatile LAS unsigned* st; };
__device__ __forceinline__ XcdBarrier xcd_barrier_post(unsigned* bar, volatile LAS unsigned* st) {
    XcdBarrier b; b.bar = bar; b.x = xb_xcc_id(); b.st = st;
    if (threadIdx.x == 0) (void)xb_add(&bar[XB_XCNT(b.x)], 1u);
    return b;
}
__device__ __forceinline__ void xcd_barrier_complete(unsigned* bar, unsigned x, unsigned& nloc, unsigned& nx) {
    const unsigned G = gridDim.x * gridDim.y * gridDim.z;
    unsigned sum, cnt, mine, sp = 0u;
    for (;;) {
        sum = 0u; cnt = 0u; mine = 0u;
#pragma unroll
        for (unsigned j = 0; j < 16; ++j) { const unsigned c = xb_ld(&bar[XB_XCNT(j)]); sum += c; cnt += (c > 0u) ? 1u : 0u; mine = (j == x) ? c : mine; }
        if (sum == G) break;
        __builtin_amdgcn_s_sleep(1);
        if ((++sp & 255u) == 0u) { if (xb_ld(&bar[XB_TMO])) break; if (sp > XB_SPIN_CAP) { atomicAdd(&bar[XB_TMO], 1u); break; } }
    }
    nloc = mine > 0u ? mine : 1u; nx = cnt > 0u ? cnt : 1u;
}
__device__ __forceinline__ void xcd_barrier(const XcdBarrier& b) {
    asm volatile("s_waitcnt vmcnt(0)" ::: "memory");
    __syncthreads();
    if (threadIdx.x == 0) {
        unsigned* bar = b.bar;
        __builtin_amdgcn_s_waitcnt(0);
        unsigned nloc = b.st[0], nx = b.st[1];
        if (nloc == 0u) { xcd_barrier_complete(bar, b.x, nloc, nx); b.st[0] = nloc; b.st[1] = nx; }
        const unsigned old = xb_add(&bar[XB_XSUB(b.x)], 1u);
        const unsigned gen = old / nloc;
        if (old + 1u == (gen + 1u) * nloc) {
            __builtin_amdgcn_fence(__ATOMIC_RELEASE, "agent");
            asm volatile("s_waitcnt vmcnt(0)" ::: "memory");
            const unsigned og = xb_add(&bar[XB_TOP], 1u);
            const unsigned tg = og / nx;
            if (og + 1u == (tg + 1u) * nx) xb_add(&bar[XB_TOPGEN], 1u);
            else XB_SPIN(xb_ld(&bar[XB_TOPGEN]) == tg, bar);
            __builtin_amdgcn_fence(__ATOMIC_ACQUIRE, "agent");
            xb_add(&bar[XB_XGEN(b.x)], 1u);
            asm volatile("s_waitcnt vmcnt(0)" ::: "memory");
        } else {
            XB_SPIN(xb_ld(&bar[XB_XGEN(b.x)]) == gen, bar);
            __builtin_amdgcn_fence(__ATOMIC_ACQUIRE, "agent");
            asm volatile("s_waitcnt vmcnt(0)" ::: "memory");
        }
    }
    __syncthreads();
}

__device__ __forceinline__ unsigned f2bf(float f) { unsigned u = __builtin_bit_cast(unsigned, f); return (u + 0x7fffu + ((u >> 16) & 1u)) >> 16; }
__device__ __forceinline__ unsigned pk2(float lo, float hi) { f32x2 v = {lo, hi}; bf16x2_t b = __builtin_convertvector(v, bf16x2_t); return __builtin_bit_cast(unsigned, b); }
__device__ __forceinline__ float bf2f(unsigned short h) { return __builtin_bit_cast(float, (unsigned)h << 16); }
template <int M> __device__ __forceinline__ float shx(float v) {
    if (M == 32) { auto rr = __builtin_amdgcn_permlane32_swap(__float_as_uint(v), __float_as_uint(v), false, false); const bool up = (threadIdx.x & 32) != 0; return __uint_as_float(up ? rr[0] : rr[1]); }
    else return __uint_as_float((unsigned)__builtin_amdgcn_ds_swizzle((int)__float_as_uint(v), 0x1F | (M << 10)));
}
__device__ __forceinline__ float wave_sum(float v) { v += shx<1>(v); v += shx<2>(v); v += shx<4>(v); v += shx<8>(v); v += shx<16>(v); v += shx<32>(v); return v; }
__device__ __forceinline__ float wave_max(float v) { v = fmaxf(v, shx<1>(v)); v = fmaxf(v, shx<2>(v)); v = fmaxf(v, shx<4>(v)); v = fmaxf(v, shx<8>(v)); v = fmaxf(v, shx<16>(v)); v = fmaxf(v, shx<32>(v)); return v; }
__device__ __forceinline__ int ltid() { int t = threadIdx.x; asm volatile("" : "+v"(t)); return t; }
__device__ __forceinline__ int obx() { int b = blockIdx.x; asm volatile("" : "+s"(b)); return b; }
__device__ __forceinline__ int crow(int r, int hi) { return (r & 3) + 8 * (r >> 2) + 4 * hi; }
__device__ __forceinline__ s16x4 vtr(lds_cptr p) { return __builtin_bit_cast(s16x4, __builtin_amdgcn_ds_read_tr16_b64_v4i16((LAS v4i16_t*)p)); }
__device__ __forceinline__ float fast_rcp(float x) { return __builtin_amdgcn_rcpf(x); }
__device__ __forceinline__ float silu_f(float g) { return g * fast_rcp(1.f + __builtin_amdgcn_exp2f(-g * LOG2E)); }
__device__ __forceinline__ float gain_absmax64(const float* g) { return wave_max(fabsf(g[threadIdx.x & 63])); }

struct Frame { lds_ptr lds; unsigned char* ws; float* out; int wave, vcu, G; };
__device__ __forceinline__ const float* inp(const Frame& F, int i) {
    const unsigned long long v = ((const LAS unsigned long long*)(F.lds + PTR_OFF))[i];
    const unsigned lo = __builtin_amdgcn_readfirstlane((unsigned)v), hi = __builtin_amdgcn_readfirstlane((unsigned)(v >> 32));
    return (const float*)(const GAS float*)(((unsigned long long)hi << 32) | lo);
}
__device__ __forceinline__ Frame mkframe() {
    Frame F; asm volatile("" ::: "memory");
    extern __shared__ __attribute__((aligned(16))) unsigned char lds_raw[];
    F.lds = (lds_ptr)lds_raw;
    F.ws = (unsigned char*)inp(F, 34); F.out = (float*)inp(F, 35);
    F.wave = __builtin_amdgcn_readfirstlane(ltid() >> 6);
    F.G = gridDim.x; { const int bx = blockIdx.x; F.vcu = (F.G % 8 == 0) ? (bx % 8) * (F.G / 8) + bx / 8 : bx; }
    return F;
}
enum { I_X = 0, I_C, I_CTX, I_CCTX, I_N1G, I_N2G, I_ADAW, I_ADAB, I_MIXW, I_FIW, I_FOW, I_EVW, I_QNA, I_KNA, I_SINK, I_QNB, I_KNB, I_LQ1, I_LK1, I_LQ2, I_LK2, I_SUBLN,
       I_ODW, I_CVN, I_CWS, I_CBS, I_QAN, I_KVAN, I_WUQ, I_WUKV, I_QNN, I_KNN, I_QNR, I_KNR };

__device__ __forceinline__ int map_head(int R) { const int pn = R >> 8, bj = (R >> 7) & 1, wc = (R >> 5) & 3, rho = R & 31; return 256 * pn + 64 * wc + 32 * bj + rho; }
__device__ __forceinline__ int map_od(int R) { if (R < 1536) return R; const int q = R - 1536, bj = (q >> 7) & 1, wc = (q >> 5) & 3, rho = q & 31; return wc == 0 ? 1536 + 32 * bj + rho : -1; }
__device__ __forceinline__ int map_fi(int R) { const int pn = R >> 8, bj = (R >> 7) & 1, q = R & 127; return bj * FFH + 128 * pn + q; }
__device__ __forceinline__ int map_ukv(int R) { const int pn = R >> 8, bj = (R >> 7) & 1, wc = (R >> 5) & 3, rho = R & 31;
    if (pn == 0) return 192 * wc + 32 * bj + rho; const int u = 4 * (pn - 1) + wc; return 192 * (u >> 1) + 64 + 64 * (u & 1) + 32 * bj + rho; }

__device__ __forceinline__ void transpose_item(const float* W, int K, int ldn, bf16_t* WT, int n0, int cs, int k0, const float* kscale, LAS float* scr, int lane) {
    float tv[32];
#pragma unroll
    for (int i = 0; i < 32; ++i) { const int kk = 2 * i + (lane >> 5); tv[i] = cs >= 0 ? (NT_LOADS ? __builtin_nontemporal_load(&W[(size_t)(k0 + kk) * ldn + cs + (lane & 31)]) : W[(size_t)(k0 + kk) * ldn + cs + (lane & 31)]) : 0.f; }
#pragma unroll
    for (int i = 0; i < 32; ++i) { const int kk = 2 * i + (lane >> 5); float v = tv[i]; if (kscale) v *= kscale[k0 + kk]; scr[kk * 33 + (lane & 31)] = v; }
    asm volatile("s_waitcnt lgkmcnt(0)" ::: "memory");
    const int c = lane & 7;
#pragma unroll
    for (int j = 0; j < 4; ++j) { const int n = (lane >> 3) + 8 * j; const LAS float* s = scr + (8 * c) * 33 + n;
        u32x4 o; o.x = pk2(s[0 * 33], s[1 * 33]); o.y = pk2(s[2 * 33], s[3 * 33]); o.z = pk2(s[4 * 33], s[5 * 33]); o.w = pk2(s[6 * 33], s[7 * 33]);
        if (NT_P0ST) __builtin_nontemporal_store(o, (u32x4*)(WT + (size_t)(n0 + n) * K + k0 + 8 * c)); else *(u32x4*)(WT + (size_t)(n0 + n) * K + k0 + 8 * c) = o; }
    asm volatile("s_waitcnt lgkmcnt(0)" ::: "memory");
}

__device__ __forceinline__ void p0_prologue(Frame& F) {
    LAS float* scr = (LAS float*)(F.lds + F.wave * 16384);
    const int lane = ltid() & 63;
    const int gw = F.vcu * NWAVES + F.wave, NGW = F.G * NWAVES;
    constexpr int N_ADA = 2 * 16 * 24;
    constexpr int I_EV = 16 * 72, I_ODD = 16 * 56, I_MIX1 = 16 * 32, I_FI1 = 16 * 176, I_FO1 = 44 * 32, I_UQ = 4 * 16, I_UKV = 4 * 24;
    constexpr int N_TR = I_EV + I_ODD + 2 * I_MIX1 + 2 * I_FI1 + 2 * I_FO1 + I_UQ + I_UKV;
    constexpr int N_WS = 16;
    static_assert(N_ADA == 256 * 3, "three adaLN items per workgroup");
    if (ltid() == 0) *((volatile LAS unsigned*)(F.lds + MISC_OFF) + 16) = 0u;
    __syncthreads();
    (void)gw; (void)NGW;
    if (F.wave < 3) { const int it = F.vcu * 3 + F.wave;
        {
            const int i = it / (16 * 24), ks = (it / 24) % 16, cc = it % 24;
            for (int idx = lane; idx < 9 * 64; idx += 64) { const int r = idx >> 6, k = idx & 63; const float v = r < 8 ? inp(F, I_C)[r * DM + ks * 64 + k] : inp(F, I_CCTX)[ks * 64 + k]; scr[idx] = v / (1.f + expf(-v)); }
            asm volatile("s_waitcnt lgkmcnt(0)" ::: "memory");
            f32x4 acc[9];
#pragma unroll
            for (int r = 0; r < 9; ++r) acc[r] = (f32x4){0.f, 0.f, 0.f, 0.f};
            const float* w = inp(F, I_ADAW) + ((size_t)i * DM + ks * 64) * 6144 + cc * 256 + lane * 4;
#pragma unroll 8
            for (int k = 0; k < 64; ++k) { const f32x4 wv = NT_LOADS ? __builtin_nontemporal_load((const f32x4*)(w + (size_t)k * 6144)) : *(const f32x4*)(w + (size_t)k * 6144);
#pragma unroll
                for (int r = 0; r < 9; ++r) acc[r] += wv * scr[r * 64 + k]; }
            float* mp = (float*)(F.ws + WS_MODP) + ((size_t)(i * 16 + ks) * 9) * 6144 + cc * 256 + lane * 4;
#pragma unroll
            for (int r = 0; r < 9; ++r) *(f32x4*)(mp + (size_t)r * 6144) = acc[r];
            asm volatile("s_waitcnt lgkmcnt(0)" ::: "memory");
        }
    }
    volatile LAS unsigned* ticket = (volatile LAS unsigned*)(F.lds + MISC_OFF) + 16;
    for (;;) {
        unsigned jj = 0; if (lane == 0) jj = __hip_atomic_fetch_add((LAS unsigned*)ticket, 1u, __ATOMIC_RELAXED, __HIP_MEMORY_SCOPE_WORKGROUP);
        jj = __builtin_amdgcn_readfirstlane(jj);
        const int it = F.vcu + F.G * (int)jj; if (it >= N_TR + N_WS) break;
        int r = it;
        if (r < I_EV) { const int kb = r / 72, nb = r % 72; transpose_item(inp(F, I_EVW), DM, 2304, (bf16_t*)(F.ws + WS_W_EV), 32 * nb, map_head(32 * nb), 64 * kb, nullptr, scr, lane); continue; } r -= I_EV;
        if (r < I_ODD) { const int kb = r / 56, nb = r % 56; transpose_item(inp(F, I_ODW), DM, 1600, (bf16_t*)(F.ws + WS_W_OD), 32 * nb, map_od(32 * nb), 64 * kb, nullptr, scr, lane); continue; } r -= I_ODD;
        if (r < 2 * I_MIX1) { const int l = r / I_MIX1, q = r % I_MIX1, kb = q / 32, nb = q % 32; transpose_item(inp(F, I_MIXW) + (size_t)l * DM * DM, DM, DM, (bf16_t*)(F.ws + WS_W_MIX + l * 2 * MiB), 32 * nb, 32 * nb, 64 * kb, nullptr, scr, lane); continue; } r -= 2 * I_MIX1;
        if (r < 2 * I_FI1) { const int l = r / I_FI1, q = r % I_FI1, kb = q / 176, nb = q % 176; transpose_item(inp(F, I_FIW) + (size_t)l * DM * 2 * FFH, DM, 2 * FFH, (bf16_t*)(F.ws + WS_W_FI + l * 11 * MiB), 32 * nb, map_fi(32 * nb), 64 * kb, nullptr, scr, lane); continue; } r -= 2 * I_FI1;
        if (r < 2 * I_FO1) { const int l = r / I_FO1, q = r % I_FO1, kb = q / 32, nb = q % 32; transpose_item(inp(F, I_FOW) + (size_t)l * FFH * DM, FFH, DM, (bf16_t*)(F.ws + WS_W_FO + l * 6 * MiB), 32 * nb, 32 * nb, 64 * kb, nullptr, scr, lane); continue; } r -= 2 * I_FO1;
        if (r < I_UQ) { const int kb = r / 16, nb = r % 16; transpose_item(inp(F, I_WUQ), 256, 512, (bf16_t*)(F.ws + WS_W_UQ), 32 * nb, map_head(32 * nb), 64 * kb, inp(F, I_QAN), scr, lane); continue; } r -= I_UQ;
        if (r < I_UKV) { const int kb = r / 24, nb = r % 24; transpose_item(inp(F, I_WUKV), 256, 768, (bf16_t*)(F.ws + WS_W_UKV), 32 * nb, map_ukv(32 * nb), 64 * kb, inp(F, I_KVAN), scr, lane); continue; } r -= I_UKV;
        { bf16_t* d = (bf16_t*)(F.ws + WS_W_S); const float* s = inp(F, I_CWS);
#pragma unroll 4
          for (int j = 0; j < 64; ++j) { const int e = r * 4096 + j * 64 + lane; d[e] = (bf16_t)f2bf(s[e]); } }
    }
}

__device__ __forceinline__ void load_mod16(Frame& F, int lane, int layer, int mr, int chunk, bool from_partials, f32x4 (&dst)[4]) {
    if (from_partials) {
        const float* mp = (const float*)(F.ws + WS_MODP) + ((size_t)(layer * 16) * 9 + mr) * 6144 + chunk * DM + lane * 4;
        const float* bias = inp(F, I_ADAB) + layer * 6144 + chunk * DM + lane * 4;
#pragma unroll
        for (int j = 0; j < 4; ++j) { f32x4 a = *(const f32x4*)(bias + 256 * j);
            for (int ks = 0; ks < 16; ++ks) a += *(const f32x4*)(mp + (size_t)ks * 9 * 6144 + 256 * j);
            dst[j] = a; }
    } else {
        const float* m = (const float*)(F.ws + WS_MOD) + ((size_t)layer * 9 + mr) * 6144 + chunk * DM + lane * 4;
#pragma unroll
        for (int j = 0; j < 4; ++j) dst[j] = *(const f32x4*)(m + 256 * j);
    }
}
template <bool SRC_BF16>
__device__ __forceinline__ void ln_phase(Frame& F, int layer, int chunk, const float* gain, const void* src_lat, const void* src_ctx, int mrows, bool from_partials, bf16_t* ctx_out = nullptr, const float* parts = nullptr) {
    const int lane = ltid() & 63;
    const int gw = F.vcu * NWAVES + F.wave;
    bf16_t* HN = (bf16_t*)(F.ws + WS_HN);
    f32x4 gv[4], sh[4], sc[4];
#pragma unroll
    for (int j = 0; j < 4; ++j) gv[j] = *(const f32x4*)(gain + lane * 4 + 256 * j);
#define LN_LOAD(V, SS, XB, RO) do { SS = 0.f; _Pragma("unroll") for (int j = 0; j < 4; ++j) { \
            if (SRC_BF16) { const unsigned long long w_ = *(const unsigned long long*)((XB) + ((RO) + 256 * j) * 2); const unsigned lo_ = (unsigned)w_, hi_ = (unsigned)(w_ >> 32); \
                V[j] = (f32x4){__builtin_bit_cast(float, lo_ << 16), __builtin_bit_cast(float, lo_ & 0xffff0000u), __builtin_bit_cast(float, hi_ << 16), __builtin_bit_cast(float, hi_ & 0xffff0000u)}; } \
            else V[j] = NT_LOADS ? __builtin_nontemporal_load((const f32x4*)((XB) + ((RO) + 256 * j) * 4)) : *(const f32x4*)((XB) + ((RO) + 256 * j) * 4); \
            SS += (V[j].x * V[j].x + V[j].y * V[j].y) + (V[j].z * V[j].z + V[j].w * V[j].w); } } while (0)
#define LN_STORE(V, RS, M) do { unsigned long long* o8_ = (unsigned long long*)(HN + (size_t)(M) * DM) + lane; _Pragma("unroll") for (int j = 0; j < 4; ++j) { const f32x4 y_ = V[j] * (RS) * gv[j] * (sc[j] + 1.0f) + sh[j]; \
            const unsigned long long w8_ = (unsigned long long)pk2(y_.x, y_.y) | ((unsigned long long)pk2(y_.z, y_.w) << 32); if (NT_P1ST && !SRC_BF16) __builtin_nontemporal_store(w8_, o8_ + 64 * j); else o8_[64 * j] = w8_; } } while (0)
    { const int m0 = gw * 16; if (m0 < mrows) { const int mr = m0 >> 12; load_mod16(F, lane, layer, mr, chunk, from_partials, sh); load_mod16(F, lane, layer, mr, chunk + 1, from_partials, sc);
        const unsigned char* xb = (const unsigned char*)src_lat;
#pragma unroll 1
        for (int q = 0; q < 4; ++q) { f32x4 va[4], vb[4], vc[4], vd[4]; float sa, sb, sc2, sd; const size_t ro = (size_t)(m0 + 4 * q) * DM + lane * 4;
            LN_LOAD(va, sa, xb, ro); LN_LOAD(vb, sb, xb, ro + DM); LN_LOAD(vc, sc2, xb, ro + 2 * DM); LN_LOAD(vd, sd, xb, ro + 3 * DM);
            sa = wave_sum(sa); sb = wave_sum(sb); sc2 = wave_sum(sc2); sd = wave_sum(sd);
            const float ra = 1.0f / sqrtf(sa * (1.f / DM) + EPS), rb = 1.0f / sqrtf(sb * (1.f / DM) + EPS), rc = 1.0f / sqrtf(sc2 * (1.f / DM) + EPS), rd = 1.0f / sqrtf(sd * (1.f / DM) + EPS);
            LN_STORE(va, ra, m0 + 4 * q); LN_STORE(vb, rb, m0 + 4 * q + 1); LN_STORE(vc, rc, m0 + 4 * q + 2); LN_STORE(vd, rd, m0 + 4 * q + 3); } } }
    { const int m = MLAT + gw; if (m < mrows) { load_mod16(F, lane, layer, 8, chunk, from_partials, sh); load_mod16(F, lane, layer, 8, chunk + 1, from_partials, sc);
        const size_t ro = (size_t)(m - MLAT) * DM + lane * 4; f32x4 v[4]; float ss; LN_LOAD(v, ss, (const unsigned char*)src_ctx, ro);
        if (ctx_out) {
            if (parts) { ss = 0.f;
#pragma unroll
                for (int j = 0; j < 4; ++j) {
#pragma unroll
                    for (int sl = 0; sl < NSL; ++sl) { const unsigned long long w_ = *(const unsigned long long*)((const bf16_t*)parts + ((size_t)sl * MCTX + (m - MLAT)) * DM + lane * 4 + 256 * j); const unsigned lo_ = (unsigned)w_, hi_ = (unsigned)(w_ >> 32);
                        v[j] += (f32x4){__builtin_bit_cast(float, lo_ << 16), __builtin_bit_cast(float, lo_ & 0xffff0000u), __builtin_bit_cast(float, hi_ << 16), __builtin_bit_cast(float, hi_ & 0xffff0000u)}; }
                    ss += (v[j].x * v[j].x + v[j].y * v[j].y) + (v[j].z * v[j].z + v[j].w * v[j].w); } }
            unsigned long long* x8 = (unsigned long long*)(ctx_out + (size_t)(m - MLAT) * DM) + lane;
#pragma unroll
            for (int j = 0; j < 4; ++j) x8[64 * j] = (unsigned long long)pk2(v[j].x, v[j].y) | ((unsigned long long)pk2(v[j].z, v[j].w) << 32); }
        const float rs = 1.0f / sqrtf(wave_sum(ss) * (1.f / DM) + EPS);
        LN_STORE(v, rs, m); } }
#undef LN_LOAD
#undef LN_STORE
}
__device__ __forceinline__ void mod_reduce(Frame& F) {
    const int gt = F.vcu * NTHR + ltid();
    if (gt < 2 * 9 * 6144) { const int i = gt / (9 * 6144), rem = gt % (9 * 6144), r = rem / 6144, n = rem % 6144;
        float a = inp(F, I_ADAB)[i * 6144 + n]; const float* mp = (const float*)(F.ws + WS_MODP) + ((size_t)(i * 16) * 9 + r) * 6144 + n;
        for (int ks = 0; ks < 16; ++ks) a += mp[(size_t)ks * 9 * 6144];
        ((float*)(F.ws + WS_MOD))[gt] = a; }
}

__device__ __forceinline__ u32x4 pack8(const f32x4 a, const f32x4 b) { u32x4 w; w.x = pk2(a[0], a[1]); w.y = pk2(a[2], a[3]); w.z = pk2(b[0], b[1]); w.w = pk2(b[2], b[3]); return w; }
struct RowGrp { int b, ktile, is_ctx; };
__device__ __forceinline__ RowGrp rowgrp(int rb) { RowGrp g; if (rb < MLAT) { g.b = rb >> 12; g.ktile = (rb & 4095) >> 6; g.is_ctx = 0; } else { const int rc = rb - MLAT; g.b = rc >> 8; g.ktile = 64 + ((rc & 255) >> 6); g.is_ctx = 1; } return g; }
__device__ __forceinline__ void rope8(f32x4 (&v0)[2], f32x4 (&v1)[2], const LAS f32x2* T, int pos, int fq) {
    const LAS f32x2* t = T + pos * 16 + 8 * (fq & 1);
#pragma unroll
    for (int n = 0; n < 2; ++n)
#pragma unroll
        for (int j = 0; j < 4; ++j) { const f32x2 cs = t[4 * n + j]; const float x1 = v0[n][j], x2 = v1[n][j]; v0[n][j] = x1 * cs.x - x2 * cs.y; v1[n][j] = x2 * cs.x + x1 * cs.y; }
}

__device__ __forceinline__ void head_row(f32x4 (&v0)[2], f32x4 (&v1)[2], const f32x4 (&g0)[2], const f32x4 (&g1)[2], float r2, const LAS f32x2* T, int pos, int fq) {
    float ss = 0.f;
#pragma unroll
    for (int n = 0; n < 2; ++n) { ss += (v0[n][0] * v0[n][0] + v0[n][1] * v0[n][1]) + (v0[n][2] * v0[n][2] + v0[n][3] * v0[n][3]); ss += (v1[n][0] * v1[n][0] + v1[n][1] * v1[n][1]) + (v1[n][2] * v1[n][2] + v1[n][3] * v1[n][3]); }
    ss += shx<16>(ss); ss += shx<32>(ss);
    const float rs = __builtin_amdgcn_sqrtf(r2) * __builtin_amdgcn_rsqf(r2 * ss * (1.f / 64.f) + EPS);
#pragma unroll
    for (int n = 0; n < 2; ++n) {
        v0[n] = v0[n] * rs * g0[n]; v1[n] = v1[n] * rs * g1[n];
        if (pos >= 0) { const LAS f32x2* t = T + pos * 16 + 8 * (fq & 1) + 4 * n;
#pragma unroll
            for (int j = 0; j < 4; ++j) { const f32x2 cs = t[j]; const float x1 = v0[n][j], x2 = v1[n][j]; v0[n][j] = x1 * cs.x - x2 * cs.y; v1[n][j] = x2 * cs.x + x1 * cs.y; } }
    }
}
__device__ __forceinline__ void load_gains(const float* gp, int fq, f32x4 (&g0)[2], f32x4 (&g1)[2]) {
#pragma unroll
    for (int n = 0; n < 2; ++n) { g0[n] = *(const f32x4*)(gp + 8 * fq + 4 * n); g1[n] = *(const f32x4*)(gp + 32 + 8 * fq + 4 * n); }
}

struct EpiEven {
    static constexpr bool PERM = true, AFTER_DRAIN = false;
    unsigned char* ws; lds_ptr lds; float qscale;
    __device__ __forceinline__ void operator()(const f32x4 (&acc)[2][2][4][2], const Unit& u, int wr, int wc, int fr_, int fq_) const {
        int fr = fr_, fq = fq_; asm volatile("" : "+v"(fr), "+v"(fq));
        const int unit = 4 * u.pn + wc;
        const LAS f32x2* T = (const LAS f32x2*)(lds + ROPE_OFF); Frame Fq; Fq.lds = lds;
        const int gi = unit < 8 ? I_QNA : unit < 16 ? I_QNB : unit < 18 ? I_KNA : unit < 20 ? -1 : unit < 28 ? I_KNB : -1;
        const float* gp = gi >= 0 ? inp(Fq, gi) : nullptr;
        f32x4 g0[2], g1[2]; if (gp) load_gains(gp, fq, g0, g1);
#pragma unroll
        for (int ai = 0; ai < 2; ++ai) {
            const int rb = u.pm * 256 + ai * 128 + wr * 64; const RowGrp G = rowgrp(rb);
#pragma unroll
            for (int m = 0; m < 4; ++m) {
                const int kk = 16 * m + fr; const size_t row = (size_t)rb + kk;
                f32x4 v0[2] = {acc[ai][0][m][0], acc[ai][0][m][1]}, v1[2] = {acc[ai][1][m][0], acc[ai][1][m][1]};
                if (gp) head_row(v0, v1, g0, g1, 1.0f, T, G.is_ctx ? -1 : (fq < 2 ? G.ktile : kk), fq);
                if (unit < 16) {
                    bf16_t* q = (bf16_t*)(ws + WS_Q) + row * DM + 64 * unit + 8 * fq;
                    *(u32x4*)q = pack8(v0[0] * qscale, v0[1] * qscale); *(u32x4*)(q + 32) = pack8(v1[0] * qscale, v1[1] * qscale);
                } else if (unit < 18 || (unit >= 20 && unit < 28)) {
                    unsigned char* img = unit < 18 ? ws + WS_KA + ((size_t)(G.b * 2 + (unit - 16)) * NKT + G.ktile) * 8192 : ws + WS_KB + ((size_t)(G.b * 8 + (unit - 20)) * NKT + G.ktile) * 8192;
                    *(u32x4*)(img + fq * 1024 + kk * 16) = pack8(v0[0], v0[1]); *(u32x4*)(img + (4 + fq) * 1024 + kk * 16) = pack8(v1[0], v1[1]);
                } else if (unit < 20) {
                    unsigned char* img = ws + WS_VA + ((size_t)(G.b * 2 + (unit - 18)) * NKT + G.ktile) * 8192 + m * 1024 + fr * 64 + fq * 16;
                    *(u32x4*)img = pack8(v0[0], v0[1]); *(u32x4*)(img + 4096) = pack8(v1[0], v1[1]);
                } else {
                    const int j = unit - 28, h = j >> 1, half = j & 1;
                    unsigned char* img = ws + WS_VB + ((size_t)(G.b * 4 + h) * NKT + G.ktile) * 16384 + (2 * half) * 4096 + m * 1024 + fr * 64 + fq * 16;
                    *(u32x4*)img = pack8(v0[0], v0[1]); *(u32x4*)(img + 4096) = pack8(v1[0], v1[1]);
                }
                asm volatile("" ::: "memory");
            }
        }
    }
};

__device__ __forceinline__ void unpack8(const u32x4 w, f32x4& a, f32x4& b) {
#pragma unroll
    for (int j = 0; j < 2; ++j) { a[2 * j] = __builtin_bit_cast(float, w[j] << 16); a[2 * j + 1] = __builtin_bit_cast(float, w[j] & 0xffff0000u); b[2 * j] = __builtin_bit_cast(float, w[2 + j] << 16); b[2 * j + 1] = __builtin_bit_cast(float, w[2 + j] & 0xffff0000u); }
}
template <bool IN_BF16, bool OUT_BF16> struct EpiResid {
    static constexpr bool PERM = true, AFTER_DRAIN = false;
    const void* xin_lat; const void* xin_ctx; void* out_lat; void* out_ctx; const float* gate  ; float* part;
    __device__ __forceinline__ void operator()(const f32x4 (&acc)[2][2][4][2], const Unit& u, int wr, int wc, int fr_, int fq_) const {
        int fr = fr_, fq = fq_; asm volatile("" : "+v"(fr), "+v"(fq));
        const int rb0 = u.pm * 256; const bool ctx = rb0 >= MLAT; const int mr = ctx ? 8 : (rb0 >> 12);
        if (u.nt) {
            bf16_t* pp = (bf16_t*)part + ((size_t)u.aux * MCTX + (rb0 - MLAT)) * DM + u.pn * 256 + wc * 32 + 8 * fq;
#pragma unroll
            for (int bj = 0; bj < 2; ++bj) { const f32x4 ga = *(const f32x4*)(gate + (size_t)8 * 6144 + u.pn * 256 + wc * 32 + 8 * fq + 128 * bj), gb = *(const f32x4*)(gate + (size_t)8 * 6144 + u.pn * 256 + wc * 32 + 8 * fq + 128 * bj + 4);
#pragma unroll
                for (int ai = 0; ai < 2; ++ai)
#pragma unroll
                    for (int m = 0; m < 4; ++m) *(u32x4*)(pp + (size_t)(ai * 128 + wr * 64 + 16 * m + fr) * DM + 128 * bj) = pack8(ga * acc[ai][bj][m][0], gb * acc[ai][bj][m][1]); }
            return; }
        const size_t ro = (size_t)(ctx ? rb0 - MLAT : rb0) * DM;
        const unsigned char* xin = (const unsigned char*)(ctx ? xin_ctx : xin_lat) + ro * (IN_BF16 ? 2 : 4); unsigned char* out = (unsigned char*)(ctx ? out_ctx : out_lat) + ro * (OUT_BF16 ? 2 : 4);
        const int c0 = u.pn * 256 + wc * 32 + 8 * fq;
        f32x4 gt[2][2];
#pragma unroll
        for (int bj = 0; bj < 2; ++bj)
#pragma unroll
            for (int n = 0; n < 2; ++n) gt[bj][n] = *(const f32x4*)(gate + (size_t)mr * 6144 + c0 + 128 * bj + 4 * n);
#pragma unroll
        for (int ai = 0; ai < 2; ++ai) {
            u32x4 xb[4][2]; f32x4 xf[4][2][2];
#pragma unroll
            for (int m = 0; m < 4; ++m) { const size_t off = (size_t)(ai * 128 + wr * 64 + 16 * m + fr) * DM + c0;
#pragma unroll
                for (int bj = 0; bj < 2; ++bj) {
                    if (IN_BF16) xb[m][bj] = *(const u32x4*)(xin + (off + 128 * bj) * 2);
                    else { xf[m][bj][0] = *(const f32x4*)(xin + (off + 128 * bj) * 4); xf[m][bj][1] = *(const f32x4*)(xin + (off + 128 * bj + 4) * 4); } } }
            asm volatile("" ::: "memory");
#pragma unroll
            for (int m = 0; m < 4; ++m) { const size_t off = (size_t)(ai * 128 + wr * 64 + 16 * m + fr) * DM + c0;
#pragma unroll
                for (int bj = 0; bj < 2; ++bj) { f32x4 x0, x1;
                    if (IN_BF16) unpack8(xb[m][bj], x0, x1); else { x0 = xf[m][bj][0]; x1 = xf[m][bj][1]; }
                    x0 += gt[bj][0] * acc[ai][bj][m][0]; x1 += gt[bj][1] * acc[ai][bj][m][1];
                    if (OUT_BF16) *(u32x4*)(out + (off + 128 * bj) * 2) = pack8(x0, x1);
                    else { *(f32x4*)(out + (off + 128 * bj) * 4) = x0; *(f32x4*)(out + (off + 128 * bj + 4) * 4) = x1; } } }
            asm volatile("" ::: "memory");
        }
    }
};

struct EpiSwiglu {
    static constexpr bool PERM = true, AFTER_DRAIN = false;
    bf16_t* act;
    __device__ __forceinline__ void operator()(const f32x4 (&acc)[2][2][4][2], const Unit& u, int wr, int wc, int fr_, int fq_) const {
        int fr = fr_, fq = fq_; asm volatile("" : "+v"(fr), "+v"(fq));
#pragma unroll
        for (int ai = 0; ai < 2; ++ai)
#pragma unroll
            for (int m = 0; m < 4; ++m) { const size_t row = (size_t)u.pm * 256 + ai * 128 + wr * 64 + 16 * m + fr; f32x4 o[2];
#pragma unroll
                for (int n = 0; n < 2; ++n)
#pragma unroll
                    for (int j = 0; j < 4; ++j) o[n][j] = silu_f(acc[ai][0][m][n][j]) * acc[ai][1][m][n][j];
                *(u32x4*)(act + row * FFH + u.pn * 128 + wc * 32 + 8 * fq) = pack8(o[0], o[1]); }
    }
};

struct EpiOdd {
    static constexpr bool PERM = true, AFTER_DRAIN = false;
    unsigned char* ws; lds_ptr lds;
    __device__ __forceinline__ void operator()(const f32x4 (&acc)[2][2][4][2], const Unit& u, int wr, int wc, int fr_, int fq_) const {
        int fr = fr_, fq = fq_; asm volatile("" : "+v"(fr), "+v"(fq));
        const int pn = u.pn;
        if (pn == 6) {
            if (wc != 0) return;
            const LAS f32x2* T = (const LAS f32x2*)(lds + ROPE_OFF); Frame Fq; Fq.lds = lds; const float* knr = inp(Fq, I_KNR);
            f32x4 g0[2], g1[2]; load_gains(knr, fq, g0, g1);
#pragma unroll
            for (int ai = 0; ai < 2; ++ai) { const int rb = u.pm * 256 + ai * 128 + wr * 64; const RowGrp G = rowgrp(rb);
#pragma unroll
                for (int m = 0; m < 4; ++m) { const int kk = 16 * m + fr;
                    f32x4 v0[2] = {acc[ai][0][m][0], acc[ai][0][m][1]}, v1[2] = {acc[ai][1][m][0], acc[ai][1][m][1]};
                    head_row(v0, v1, g0, g1, 1.0f, T, G.is_ctx ? -1 : (fq < 2 ? G.ktile : kk), fq);
                    const u32x4 w0 = pack8(v0[0], v0[1]), w1 = pack8(v1[0], v1[1]);
#pragma unroll
                    for (int h = 0; h < 4; ++h) { unsigned char* img = ws + WS_KD + ((size_t)(G.b * 4 + h) * NKT + G.ktile) * 16384 + kk * 16;
                        *(u32x4*)(img + (8 + fq) * 1024) = w0; *(u32x4*)(img + (12 + fq) * 1024) = w1; }
                    asm volatile("" ::: "memory"); } }
            return;
        }
        const bool act = pn < 4; bf16_t* dbase; int ldd; float* sbase = nullptr;
        if (pn < 2) { dbase = (bf16_t*)(ws + WS_UACT) + 256 * pn; ldd = 512; }
        else if (pn < 4) { dbase = (bf16_t*)(ws + WS_VACT) + 256 * (pn - 2); ldd = 512; sbase = (float*)(ws + WS_VSS) + (pn - 2) * 4 + wc; }
        else if (pn == 4) { dbase = (bf16_t*)(ws + WS_CQ); ldd = 256; sbase = (float*)(ws + WS_CQS) + wc; }
        else { dbase = (bf16_t*)(ws + WS_CKV); ldd = 256; sbase = (float*)(ws + WS_CKS) + wc; }
        const int c0 = 32 * wc + 8 * fq;
#pragma unroll
        for (int ai = 0; ai < 2; ++ai)
#pragma unroll
            for (int m = 0; m < 4; ++m) { const size_t row = (size_t)u.pm * 256 + ai * 128 + wr * 64 + 16 * m + fr; float ss = 0.f;
#pragma unroll
                for (int bj = 0; bj < 2; ++bj) { f32x4 a = acc[ai][bj][m][0], b = acc[ai][bj][m][1];
                    if (act) { f32x2 t0 = gelu_pk((f32x2){a[0], a[1]}), t1 = gelu_pk((f32x2){a[2], a[3]}), t2 = gelu_pk((f32x2){b[0], b[1]}), t3 = gelu_pk((f32x2){b[2], b[3]});
                        a = (f32x4){t0.x, t0.y, t1.x, t1.y}; b = (f32x4){t2.x, t2.y, t3.x, t3.y}; }
                    ss += (a[0] * a[0] + a[1] * a[1]) + (a[2] * a[2] + a[3] * a[3]) + (b[0] * b[0] + b[1] * b[1]) + (b[2] * b[2] + b[3] * b[3]);
                    *(u32x4*)(dbase + row * ldd + 128 * bj + c0) = pack8(a, b); }
                if (sbase) { ss += shx<16>(ss); ss += shx<32>(ss); if (fq == 0) sbase[row * 8] = ss; }
                asm volatile("" ::: "memory"); }
    }
};

struct EpiUq {
    static constexpr bool PERM = true, AFTER_DRAIN = false;
    unsigned char* ws; lds_ptr lds; float qscale;
    __device__ __forceinline__ void operator()(const f32x4 (&acc)[2][2][4][2], const Unit& u, int wr, int wc, int fr_, int fq_) const {
        int fr = fr_, fq = fq_; asm volatile("" : "+v"(fr), "+v"(fq));
        const LAS f32x2* T = (const LAS f32x2*)(lds + ROPE_OFF); Frame Fq; Fq.lds = lds;
        const int unit = 4 * u.pn + wc, part = unit & 1; const float* gp = inp(Fq, part ? I_QNR : I_QNN);
        f32x4 g0[2], g1[2]; load_gains(gp, fq, g0, g1);
        float r2s[8];
#pragma unroll
        for (int i = 0; i < 8; ++i) { const size_t row = (size_t)u.pm * 256 + (i >> 2) * 128 + wr * 64 + 16 * (i & 3) + fr; const f32x4 sq = *(const f32x4*)((const float*)(ws + WS_CQS) + row * 8); r2s[i] = __builtin_amdgcn_rcpf(((sq[0] + sq[1]) + (sq[2] + sq[3])) * (1.f / 256.f) + EPS); }
#pragma unroll
        for (int ai = 0; ai < 2; ++ai) { const int rb = u.pm * 256 + ai * 128 + wr * 64; const RowGrp G = rowgrp(rb);
#pragma unroll
            for (int m = 0; m < 4; ++m) { const int kk = 16 * m + fr; const size_t row = (size_t)rb + kk; const float r2 = r2s[ai * 4 + m];
                f32x4 v0[2] = {acc[ai][0][m][0], acc[ai][0][m][1]}, v1[2] = {acc[ai][1][m][0], acc[ai][1][m][1]};
                head_row(v0, v1, g0, g1, r2, T, (part && !G.is_ctx) ? (fq < 2 ? G.ktile : kk) : -1, fq);
                bf16_t* q = (bf16_t*)(ws + WS_Q2) + row * 512 + 64 * unit + 8 * fq;
                *(u32x4*)q = pack8(v0[0] * qscale, v0[1] * qscale); *(u32x4*)(q + 32) = pack8(v1[0] * qscale, v1[1] * qscale);
                asm volatile("" ::: "memory"); } }
    }
};
struct EpiUkv {
    static constexpr bool PERM = true, AFTER_DRAIN = false;
    unsigned char* ws; lds_ptr lds;
    __device__ __forceinline__ void operator()(const f32x4 (&acc)[2][2][4][2], const Unit& u, int wr, int wc, int fr_, int fq_) const {
        int fr = fr_, fq = fq_; asm volatile("" : "+v"(fr), "+v"(fq));
        const float* knn = nullptr; if (u.pn == 0) { Frame Fq; Fq.lds = lds; knn = inp(Fq, I_KNN); }
        f32x4 g0[2], g1[2]; if (u.pn == 0) load_gains(knn, fq, g0, g1);
        float r2s[8];
#pragma unroll
        for (int i = 0; i < 8; ++i) { const size_t row = (size_t)u.pm * 256 + (i >> 2) * 128 + wr * 64 + 16 * (i & 3) + fr; const f32x4 sq = *(const f32x4*)((const float*)(ws + WS_CKS) + row * 8); r2s[i] = __builtin_amdgcn_rcpf(((sq[0] + sq[1]) + (sq[2] + sq[3])) * (1.f / 256.f) + EPS); }
#pragma unroll
        for (int ai = 0; ai < 2; ++ai) { const int rb = u.pm * 256 + ai * 128 + wr * 64; const RowGrp G = rowgrp(rb);
#pragma unroll
            for (int m = 0; m < 4; ++m) { const int kk = 16 * m + fr; const size_t row = (size_t)rb + kk; const float r2 = r2s[ai * 4 + m];
                f32x4 v0[2] = {acc[ai][0][m][0], acc[ai][0][m][1]}, v1[2] = {acc[ai][1][m][0], acc[ai][1][m][1]};
                if (u.pn == 0) {
                    head_row(v0, v1, g0, g1, r2, (const LAS f32x2*)nullptr, -1, fq);
                    unsigned char* img = ws + WS_KD + ((size_t)(G.b * 4 + wc) * NKT + G.ktile) * 16384 + kk * 16;
                    *(u32x4*)(img + fq * 1024) = pack8(v0[0], v0[1]); *(u32x4*)(img + (4 + fq) * 1024) = pack8(v1[0], v1[1]);
                } else {
                    const float rs = __builtin_amdgcn_sqrtf(r2); const int uu = 4 * (u.pn - 1) + wc, h = uu >> 1, half = uu & 1;
                    unsigned char* img = ws + WS_VD + ((size_t)(G.b * 4 + h) * NKT + G.ktile) * 16384 + (2 * half) * 4096 + m * 1024 + fr * 64 + fq * 16;
                    *(u32x4*)img = pack8(v0[0] * rs, v0[1] * rs); *(u32x4*)(img + 4096) = pack8(v1[0] * rs, v1[1] * rs);
                }
                asm volatile("" ::: "memory"); } }
    }
};

struct EpiNull { static constexpr bool PERM = true, AFTER_DRAIN = false;
    __device__ __forceinline__ void operator()(const f32x4 (&acc)[2][2][4][2], const Unit& u, int wr, int wc, int fr, int fq) const { asm volatile("" :: "v"(acc[0][0][0][0]), "v"(acc[1][1][3][1])); } };
struct UqkvOrder {
    int G, c;
    __device__ void init(int G_, int c_) { G = G_; c = c_; }
    __device__ static void tmpl(int L, int nM, int nN, Unit& u) { const int nwg = nM * nN; int wgid = L; { const int q = nwg / pg8::NXCD, r = nwg % pg8::NXCD, xcd = wgid % pg8::NXCD, off = wgid / pg8::NXCD; wgid = (xcd < r ? xcd * (q + 1) : r * (q + 1) + (xcd - r) * q) + off; }
        const int nig = pg8::WGM * nN, gid = wgid / nig, fm = gid * pg8::WGM, gsz = (nM - fm) < pg8::WGM ? (nM - fm) : pg8::WGM; u.pm = fm + ((wgid % nig) % gsz); u.pn = (wgid % nig) / gsz; }
    __device__ bool next(int i, Unit& u) const { const int L = i * G + c; u.k0 = 0; u.nt = 0;
        if (L < 256) { tmpl(L, MLAT / 256, 2, u); u.aux = 0; return true; }
        if (L < 256 + 408) { tmpl(L - 256, MALL / 256, 3, u); u.pm += 128; u.pn += 2; u.aux = 1; return true; }
        return false; }
    __device__ __forceinline__ void a_ready(const Unit&) const {}
    __device__ __forceinline__ void done(const Unit&) const {}
};
struct EpiUqkv {
    static constexpr bool PERM = true, AFTER_DRAIN = false;
    EpiUq q; EpiUkv kv;
    __device__ __forceinline__ void operator()(const f32x4 (&acc)[2][2][4][2], const Unit& u, int wr, int wc, int fr, int fq) const {
        if (u.aux == 0) q(acc, u, wr, wc, fr, fq);
        else { Unit v = u; v.pm -= 128; v.pn -= 2; kv(acc, v, wr, wc, fr, fq); }
    }
};
struct OddOrder {
    pg8::StaticOrder base;
    __device__ void init(int G, int c) { base.init(MLAT, 1792, G, c); }
    __device__ bool next(int i, Unit& u) const { const long L = (long)i * base.G + base.c; if (L < base.nwg) return base.next(i, u); const int q = (int)(L - base.nwg); if (q >= 16) return false; u.pm = 128 + (q >> 1); u.pn = 5 + (q & 1); u.k0 = 0; u.nt = 0; u.aux = 0; return true; }
    __device__ __forceinline__ void a_ready(const Unit&) const {}
    __device__ __forceinline__ void done(const Unit&) const {}
};

struct SplitOrder {
    pg8::StaticOrder base; int npairs;
    __device__ void init(int K, int G, int c) { base.init(MLAT, DM, G, c); npairs = K / 128; }
    __device__ bool next(int i, Unit& u) const { const long L = (long)i * base.G + base.c; if (L < base.nwg) return base.next(i, u); const int q = (int)(L - base.nwg); if (q >= 32 * NSL) return false;
        const int unit = q / NSL, sl = q % NSL, lo = npairs / NSL, rem = npairs % NSL;
        const int p0 = sl * lo + (sl < rem ? sl : rem), np = lo + (sl < rem ? 1 : 0);
        u.pm = 128 + (unit >> 2); u.pn = unit & 3; u.k0 = 128 * p0; u.nt = 2 * np; u.aux = sl; return true; }
    __device__ __forceinline__ void a_ready(const Unit&) const {}
    __device__ __forceinline__ void done(const Unit&) const {}
};

__device__ __forceinline__ void glds16(const void* gsrc, unsigned lds_dst) { unsigned keep;
    asm volatile("s_mov_b32 %0, m0\n\ts_mov_b32 m0, %2\n\ts_nop 0\n\tglobal_load_lds_dwordx4 %1, off\n\ts_mov_b32 m0, %0" : "=&s"(keep) : "v"(gsrc), "s"(lds_dst) : "memory"); }
#define AT_WAIT_BAR() asm volatile("s_waitcnt vmcnt(0) lgkmcnt(0)\n\ts_barrier" ::: "memory")

template <int DQK, int DV>
__device__ __forceinline__ void attn_pre(lds_ptr lds, const bf16_t* qptr, int ldq, const unsigned char* Kimg, const unsigned char* Vimg, int tile0, bf16x8 (&qr)[DQK / 16]) {
    constexpr int KBY = 64 * DQK * 2, VBY = 64 * DV * 2, NKR = KBY / 8192, NVR = VBY / 8192;
    int tid_ = threadIdx.x; asm volatile("" : "+v"(tid_));
    const int lane = tid_ & 63, r32 = lane & 31, hi = lane >> 5; const int wv = __builtin_amdgcn_readfirstlane(tid_ >> 6);
    const unsigned lds0 = (unsigned)(uintptr_t)lds;
    const unsigned char* gk = Kimg + (size_t)tile0 * KBY + wv * 1024 + lane * 16; const unsigned char* gv = Vimg + (size_t)tile0 * VBY + wv * 1024 + lane * 16;
#pragma unroll
    for (int tt = 0; tt < 2; ++tt) {
#pragma unroll
        for (int i = 0; i < NKR; ++i) glds16(gk + (size_t)tt * KBY + i * 8192, (unsigned)__builtin_amdgcn_readfirstlane(lds0 + tt * (KBY + VBY) + i * 8192 + wv * 1024));
#pragma unroll
        for (int i = 0; i < NVR; ++i) glds16(gv + (size_t)tt * VBY + i * 8192, (unsigned)__builtin_amdgcn_readfirstlane(lds0 + tt * (KBY + VBY) + KBY + i * 8192 + wv * 1024)); }
#pragma unroll
    for (int d0 = 0; d0 < DQK / 16; ++d0) qr[d0] = *(const bf16x8*)(qptr + (size_t)r32 * ldq + d0 * 16 + hi * 8);
}
template <int DQK, int DV, int MODE, int ABL = 0, int KSO = 1, class Pre = int>
__device__ __forceinline__ void attn_unit(lds_ptr lds, const bf16x8 (&qr)[DQK / 16], const unsigned char* Kimg, const unsigned char* Vimg,
                                          int ta0, int ta1, int tb0, int tb1, int qpos0, int win, float negMb, float l_extra, bf16_t* optr, int ldo,
                                          float lam, float dscale, const float* subln, const Pre& pre) {
    const lds_ptr keepl = lds + 73728 + __builtin_amdgcn_readfirstlane((int)threadIdx.x >> 6) * 8192 + (threadIdx.x & 63) * 16;
    constexpr int KBY = 64 * DQK * 2, VBY = 64 * DV * 2, SLOT = KBY + VBY, NKR = KBY / 8192, NVR = VBY / 8192;
    int tid_ = threadIdx.x; asm volatile("" : "+v"(tid_));
    const int tid = tid_, lane = tid & 63, r32 = lane & 31, hi = lane >> 5; const int wv = __builtin_amdgcn_readfirstlane(tid >> 6);
    const unsigned long long ts_in = TS_ATT ? __builtin_amdgcn_s_memrealtime() : 0ull; (void)ts_in;
    const int na = ta1 - ta0, nt = na + (tb1 - tb0);
    const unsigned lds0 = (unsigned)(uintptr_t)lds;
    f32x16 o[DV / 32];
#pragma unroll
    for (int d = 0; d < DV / 32; ++d)
#pragma unroll
        for (int r = 0; r < 16; ++r) o[d][r] = 0.f;
    float lsum = 0.f, lsum2 = 0.f;
#define AT_TILE(tt) ((tt) < na ? ta0 + (tt) : tb0 + ((tt) - na))
#define AT_DMA(tt, slot) do { const int t_ = AT_TILE(tt); const unsigned char* gk_ = Kimg + (size_t)t_ * KBY + wv * 1024 + lane * 16; const unsigned char* gv_ = Vimg + (size_t)t_ * VBY + wv * 1024 + lane * 16; \
        _Pragma("unroll") for (int i = 0; i < NKR; ++i) glds16(gk_ + i * 8192, (unsigned)__builtin_amdgcn_readfirstlane(lds0 + (slot) * SLOT + i * 8192 + wv * 1024)); \
        _Pragma("unroll") for (int i = 0; i < NVR; ++i) glds16(gv_ + i * 8192, (unsigned)__builtin_amdgcn_readfirstlane(lds0 + (slot) * SLOT + KBY + i * 8192 + wv * 1024)); } while (0)
#define AT_KRD(dst, i0, n, slot) do { const lds_cptr kb_ = (lds_cptr)lds + (slot) * SLOT + hi * 1024 + r32 * 16; \
        _Pragma("unroll") for (int i_ = 0; i_ < (n); ++i_) { dst[2 * i_] = *(const LAS bf16x8*)(kb_ + ((i0) + i_) * 2048); dst[2 * i_ + 1] = *(const LAS bf16x8*)(kb_ + ((i0) + i_) * 2048 + 512); } } while (0)
#define AT_QKM(P0, P1, src, i0, n) do { _Pragma("unroll") for (int i_ = 0; i_ < (n); ++i_) { const int d0 = (i0) + i_; \
        P0 = __builtin_amdgcn_mfma_f32_32x32x16_bf16(src[2 * i_], qr[d0], d0 == 0 ? z_ : P0, 0, 0, 0); P1 = __builtin_amdgcn_mfma_f32_32x32x16_bf16(src[2 * i_ + 1], qr[d0], d0 == 0 ? z_ : P1, 0, 0, 0); } } while (0)
#define AT_QK(P0, P1, slot) do { \
        const f32x16 z_ = {0.f, 0.f, 0.f, 0.f, 0.f, 0.f, 0.f, 0.f, 0.f, 0.f, 0.f, 0.f, 0.f, 0.f, 0.f, 0.f}; \
        bf16x8 kx_[4]; AT_KRD(kx_, 2, 2, slot); __builtin_amdgcn_sched_barrier(0);     \
        if constexpr (DQK == 64) { AT_QKM(P0, P1, kp, 0, 2); __builtin_amdgcn_sched_barrier(0); AT_QKM(P0, P1, kx_, 2, 2); __builtin_amdgcn_sched_barrier(0); } \
        else { bf16x8 ky_[8]; AT_QKM(P0, P1, kp, 0, 2); AT_KRD(ky_, 4, 4, slot); __builtin_amdgcn_sched_barrier(0); AT_QKM(P0, P1, kx_, 2, 2); __builtin_amdgcn_sched_barrier(0); AT_QKM(P0, P1, ky_, 4, 4); __builtin_amdgcn_sched_barrier(0); } } while (0)
#define AT_SM(P0, P1, tt) do { \
        if (win && (tt) < na) { const int dq0_ = (qpos0 + r32) - 64 * AT_TILE(tt) + 128; \
            _Pragma("unroll") for (int r = 0; r < 16; ++r) { const int k_ = crow(r, hi); if ((unsigned)(dq0_ - k_) > 256u) P0[r] = -INFINITY; if ((unsigned)(dq0_ - k_ - 32) > 256u) P1[r] = -INFINITY; } } } while (0)
#define AT_SL(P, b, w, LS) do { _Pragma("unroll") for (int r = (b); r < (b) + 8; ++r) { P[r] = __builtin_amdgcn_exp2f(P[r]); LS += P[r]; asm volatile("" : "+v"(LS)); } \
        _Pragma("unroll") for (int q = 0; q < 4; ++q) pw[w][q] = pk2(P[(b) + 2 * q], P[(b) + 2 * q + 1]); } while (0)
#define AT_VLD(slot, nslot, has_next) do { const lds_cptr vp_ = (lds_cptr)lds + (slot) * SLOT + KBY + ((lane >> 4) & 1) * 32 + (lane & 3) * 8 + (4 * hi + ((lane & 15) >> 2)) * 64; \
        _Pragma("unroll") for (int d = 0; d < DV / 32; ++d) _Pragma("unroll") for (int ks = 0; ks < 4; ++ks) { vlo[d * 4 + ks] = vtr(vp_ + d * 4096 + ks * 1024); vhi[d * 4 + ks] = vtr(vp_ + d * 4096 + ks * 1024 + 512); } \
        if (has_next) AT_KRD(kp, 0, 2, nslot);     \
        __builtin_amdgcn_sched_barrier(0); } while (0)
#define AT_PVK(ks) do { _Pragma("unroll") for (int d = 0; d < DV / 32; ++d) { const s16x4 lo_ = vlo[d * 4 + (ks)], hh_ = vhi[d * 4 + (ks)]; \
            const bf16x8 vf_ = (bf16x8){lo_[0], lo_[1], lo_[2], lo_[3], hh_[0], hh_[1], hh_[2], hh_[3]}; \
            o[d] = __builtin_amdgcn_mfma_f32_32x32x16_bf16(vf_, __builtin_bit_cast(bf16x8, pw[ks]), o[d], 0, 0, 0); } } while (0)
#define AT_PVM(P0, P1) do { if constexpr (KSO == 3) { AT_SL(P0, 0, 0, lsum); AT_SL(P0, 8, 1, lsum); AT_PVK(0); AT_PVK(1); AT_SL(P1, 0, 2, lsum2); AT_SL(P1, 8, 3, lsum2); AT_PVK(2); AT_PVK(3); } \
        else { AT_SL(P0, 0, 0, lsum); AT_PVK(0); AT_SL(P0, 8, 1, lsum); AT_PVK(1); AT_SL(P1, 0, 2, lsum2); AT_PVK(2); AT_SL(P1, 8, 3, lsum2); AT_PVK(3); } } while (0)
#define AT_SM_ALL(P0, P1, tt) do { \
        if (win && (tt) < na) { const int dq0_ = (qpos0 + r32) - 64 * AT_TILE(tt) + 128; \
            _Pragma("unroll") for (int r = 0; r < 16; ++r) { const int k_ = crow(r, hi); if ((unsigned)(dq0_ - k_) > 256u) P0[r] = -INFINITY; if ((unsigned)(dq0_ - k_ - 32) > 256u) P1[r] = -INFINITY; } } \
        _Pragma("unroll") for (int r = 0; r < 16; ++r) { P0[r] = __builtin_amdgcn_exp2f(P0[r]); P1[r] = __builtin_amdgcn_exp2f(P1[r]); lsum += P0[r]; asm volatile("" : "+v"(lsum)); lsum2 += P1[r]; asm volatile("" : "+v"(lsum2)); } \
        _Pragma("unroll") for (int q = 0; q < 4; ++q) { pw[0][q] = pk2(P0[2 * q], P0[2 * q + 1]); pw[1][q] = pk2(P0[8 + 2 * q], P0[8 + 2 * q + 1]); pw[2][q] = pk2(P1[2 * q], P1[2 * q + 1]); pw[3][q] = pk2(P1[8 + 2 * q], P1[8 + 2 * q + 1]); } } while (0)
#define AT_PVM_ALL() do { \
        _Pragma("unroll") for (int d = 0; d < DV / 32; ++d) _Pragma("unroll") for (int ks = 0; ks < 4; ++ks) { const s16x4 lo_ = vlo[d * 4 + ks], hh_ = vhi[d * 4 + ks]; \
            const bf16x8 vf_ = (bf16x8){lo_[0], lo_[1], lo_[2], lo_[3], hh_[0], hh_[1], hh_[2], hh_[3]}; \
            o[d] = __builtin_amdgcn_mfma_f32_32x32x16_bf16(vf_, __builtin_bit_cast(bf16x8, pw[ks]), o[d], 0, 0, 0); } } while (0)
#define AT_BAR() asm volatile("s_waitcnt lgkmcnt(0)\n\ts_barrier" ::: "memory")
    f32x16 sa0, sa1; u32x4 pw[4]; s16x4 vlo[DV / 8], vhi[DV / 8];
    unsigned long long ts_a = 0, ts_b = 0, ts_c = 0; (void)ts_a; (void)ts_b; (void)ts_c;
    bf16x8 kp[4];
    int sc = 0, sn = 1, sf = 2;
    for (int t = 0; t < nt; ++t) {
        AT_WAIT_BAR();
        if (TS_ATT && t == 0) ts_a = __builtin_amdgcn_s_memrealtime();
        if (!AT_DMA_LATE) { if (t + 2 < nt) AT_DMA(t + 2, sf); }
        if (t == 0) AT_KRD(kp, 0, 2, sc);
        if (!(ABL & 8)) { AT_QK(sa0, sa1, sc); }
        if (!(ABL & 4)) { AT_VLD(sc, sn, t + 1 < nt); }
        if (AT_DMA_LATE) { if (t + 2 < nt) AT_DMA(t + 2, sf); __builtin_amdgcn_sched_barrier(0); }
        if (!(ABL & 1)) { if constexpr (KSO != 0) { AT_SM(sa0, sa1, t); } else { AT_SM_ALL(sa0, sa1, t); } } else { _Pragma("unroll") for (int q = 0; q < 4; ++q) { pw[0][q] = __builtin_bit_cast(unsigned, sa0[q]); pw[1][q] = __builtin_bit_cast(unsigned, sa0[4 + q]); pw[2][q] = __builtin_bit_cast(unsigned, sa1[q]); pw[3][q] = __builtin_bit_cast(unsigned, sa1[4 + q]); } }
        if (!(ABL & 4)) { if constexpr (KSO != 0) { AT_PVM(sa0, sa1); } else { AT_PVM_ALL(); } }
        { const int s_ = sc; sc = sn; sn = sf; sf = s_; }
    }
    AT_WAIT_BAR();
    if (TS_ATT) ts_b = __builtin_amdgcn_s_memrealtime();
    pre();
#undef AT_TILE
#undef AT_DMA
#undef AT_QK
#undef AT_QKM
#undef AT_KRD
#undef AT_SM
#undef AT_SM_ALL
#undef AT_PVM_ALL
#undef AT_SL
#undef AT_PVK
#undef AT_VLD
#undef AT_PVM
#undef AT_BAR
    lsum += lsum2; lsum += shx<32>(lsum); lsum += l_extra;
    const float linv = 1.0f / lsum;
    bf16_t* orow = optr + (size_t)r32 * ldo + 8 * hi;
#define AT_ROWST(d, gp, e0, e1, e2, e3, e4, e5, e6, e7) do { const unsigned ax_ = pk2(e0, e1), ay_ = pk2(e2, e3), bx_ = pk2(e4, e5), by_ = pk2(e6, e7); \
        const auto sx_ = __builtin_amdgcn_permlane32_swap(ax_, bx_, false, false); const auto sy_ = __builtin_amdgcn_permlane32_swap(ay_, by_, false, false); \
        *(u32x4*)(orow + 32 * (d) + 16 * (gp)) = (u32x4){sx_[0], sy_[0], sx_[1], sy_[1]}; } while (0)
    if (MODE == 0) {
#pragma unroll
        for (int d = 0; d < DV / 32; ++d)
#pragma unroll
            for (int gp = 0; gp < 2; ++gp) AT_ROWST(d, gp, o[d][8 * gp] * linv, o[d][8 * gp + 1] * linv, o[d][8 * gp + 2] * linv, o[d][8 * gp + 3] * linv, o[d][8 * gp + 4] * linv, o[d][8 * gp + 5] * linv, o[d][8 * gp + 6] * linv, o[d][8 * gp + 7] * linv);
    } else if (MODE == 1) {
#pragma unroll
        for (int d = 0; d < DV / 32; ++d)
#pragma unroll
            for (int q4 = 0; q4 < 2; ++q4) { u32x4 kp;
#pragma unroll
                for (int e = 0; e < 4; ++e) { const int r = 8 * q4 + 2 * e; kp[e] = pk2(o[d][r] * linv, o[d][r + 1] * linv); }
                *(LAS u32x4*)(keepl + (d * 2 + q4) * 1024) = kp; }
    } else {
        float ss = 0.f;
#pragma unroll
        for (int d = 0; d < DV / 32; ++d)
#pragma unroll
            for (int q4 = 0; q4 < 2; ++q4) { const u32x4 kp = *(const LAS u32x4*)(keepl + (d * 2 + q4) * 1024);
#pragma unroll
                for (int e = 0; e < 4; ++e) { const int r = 8 * q4 + 2 * e; const float a0 = __builtin_bit_cast(float, kp[e] << 16), a1 = __builtin_bit_cast(float, kp[e] & 0xffff0000u);
                    const float w0 = a0 - lam * (o[d][r] * linv), w1 = a1 - lam * (o[d][r + 1] * linv); o[d][r] = w0; o[d][r + 1] = w1; ss += w0 * w0 + w1 * w1; } }
        ss += shx<32>(ss);
        const float rs = __builtin_amdgcn_rsqf(ss * (1.f / DV) + EPS) * dscale;
#pragma unroll
        for (int d = 0; d < DV / 32; ++d)
#pragma unroll
            for (int gp = 0; gp < 2; ++gp) { const f32x4 ga = *(const f32x4*)(subln + 32 * d + 16 * gp + 4 * hi) * rs, gb = *(const f32x4*)(subln + 32 * d + 16 * gp + 8 + 4 * hi) * rs;
                AT_ROWST(d, gp, o[d][8 * gp] * ga[0], o[d][8 * gp + 1] * ga[1], o[d][8 * gp + 2] * ga[2], o[d][8 * gp + 3] * ga[3], o[d][8 * gp + 4] * gb[0], o[d][8 * gp + 5] * gb[1], o[d][8 * gp + 6] * gb[2], o[d][8 * gp + 7] * gb[3]); }
    }
#undef AT_ROWST
    if (TS_ATT) { asm volatile("s_waitcnt vmcnt(0)" ::: "memory"); ts_c = __builtin_amdgcn_s_memrealtime(); if (blockIdx.x == TS_BLOCK && threadIdx.x == 0) { volatile LAS unsigned long long* ts = (volatile LAS unsigned long long*)(lds + MISC_OFF + 256); ts[24] += (ts_a - ts_in); ts[25] += (ts_b - ts_a); ts[26] += (ts_c - ts_b); ts[27] += 1; } }
}

struct AttCall { int kind  , b, hsel, ta0, ta1, tb0, tb1, qpos0, win; size_t m0; };
__device__ __forceinline__ bool att_call(const Frame& F, int n, AttCall& c) {
    const int w = F.wave; int i, sft;
    if (n < 4) { i = n >> 1; sft = n & 1; } else if (n < 8) { i = n - 2; sft = 0; } else { i = 6; sft = n - 8; }
    c.tb0 = 0; c.tb1 = 0; c.qpos0 = 0; c.win = 0;
    if (i < 2) { const int idx = F.vcu + 256 * i, j = idx >> 4, qb = idx & 15; c.kind = 1 + sft; c.b = j >> 2; c.hsel = j & 3; c.m0 = (size_t)c.b * SEQ + 256 * qb + 32 * w; c.ta0 = 0; c.ta1 = NKT; }
    else if (i < 6) { const int idx = F.vcu + 256 * (i - 2), kvh = (idx >> 6) & 1, nn = (idx >> 1) & 31, hp = idx & 1; c.kind = 0; c.b = idx >> 7; c.hsel = 4 * kvh + 2 * hp + (w >> 2);
        c.m0 = (size_t)c.b * SEQ + 128 * nn + 32 * (w & 3); c.ta0 = max(0, 2 * nn - 2); c.ta1 = min(64, 2 * nn + 4); c.tb0 = 64; c.tb1 = NKT; c.qpos0 = 128 * nn + 32 * (w & 3); c.win = 1; }
    else { if (n > 9 || F.vcu >= 128 || (F.vcu >= 32 && F.vcu < 64)) return false;
        if (F.vcu < 32) { c.kind = 1 + sft; c.b = F.vcu >> 2; c.hsel = F.vcu & 3; } else { if (sft) return false; const int j = F.vcu - 64; c.kind = 0; c.b = j >> 3; c.hsel = j & 7; }
        c.m0 = (size_t)MLAT + c.b * CTXL + 32 * w; c.ta0 = 64; c.ta1 = NKT; }
    return true;
}
__device__ __forceinline__ const unsigned char* att_K(const Frame& F, const AttCall& c) { return c.kind ? F.ws + WS_KB + (size_t)(c.b * 8 + 2 * c.hsel + (c.kind == 2 ? 1 : 0)) * NKT * 8192 : F.ws + WS_KA + (size_t)(c.b * 2 + (c.hsel >> 2)) * NKT * 8192; }
__device__ __forceinline__ const unsigned char* att_V(const Frame& F, const AttCall& c) { return c.kind ? F.ws + WS_VB + (size_t)(c.b * 4 + c.hsel) * NKT * 16384 : F.ws + WS_VA + (size_t)(c.b * 2 + (c.hsel >> 2)) * NKT * 8192; }
__device__ __forceinline__ void att_pre(const Frame& F, const AttCall& c, bf16x8 (&qr)[4]) {
    if (c.kind) attn_pre<64, 128>(F.lds, (const bf16_t*)(F.ws + WS_Q) + c.m0 * DM + 512 + 128 * c.hsel + (c.kind == 2 ? 64 : 0), DM, att_K(F, c), att_V(F, c), c.ta0, qr);
    else        attn_pre<64, 64>(F.lds, (const bf16_t*)(F.ws + WS_Q) + c.m0 * DM + 64 * c.hsel, DM, att_K(F, c), att_V(F, c), c.ta0, qr);
}
__device__ __forceinline__ void phase_attn_even(Frame& F) {
    const float MbA = 8.0f * gain_absmax64(inp(F, I_QNA)) * gain_absmax64(inp(F, I_KNA)) * LOG2E;
    const float MbB = 8.0f * gain_absmax64(inp(F, I_QNB)) * gain_absmax64(inp(F, I_KNB)) * LOG2E;
    const int w = F.wave, lane = ltid() & 63;
    float s1 = inp(F, I_LQ1)[lane] * inp(F, I_LK1)[lane], s2 = inp(F, I_LQ2)[lane] * inp(F, I_LK2)[lane];
    s1 = wave_sum(s1); s2 = wave_sum(s2);
    const float lam_init = 0.8f - 0.6f * 1.0f  , lam = expf(s1) - expf(s2) + lam_init;
    const float* subln = inp(F, I_SUBLN);
    bf16x8 qr[4];
    { AttCall c0; att_call(F, 0, c0); att_pre(F, c0, qr); }
    for (int n = 0; n < 10; ++n) {
        AttCall c; if (!att_call(F, n, c)) break;
        bf16x8 qn[4];
#pragma unroll
        for (int d = 0; d < 4; ++d) qn[d] = qr[d];
        const auto pre = [&]() { AttCall nx; if (att_call(F, n + 1, nx)) att_pre(F, nx, qn); };
        if (c.kind) {
            bf16_t* o = (bf16_t*)(F.ws + WS_MIX) + c.m0 * DM + 512 + 128 * c.hsel;
            if (c.kind == 1) attn_unit<64, 128, 1, 0, AT_KSO_B>(F.lds, qr, att_K(F, c), att_V(F, c), c.ta0, c.ta1, c.tb0, c.tb1, 0, 0, -MbB, 0.f, o, DM, lam, 1.0f - lam_init, subln, pre);
            else             attn_unit<64, 128, 2, 0, AT_KSO_B>(F.lds, qr, att_K(F, c), att_V(F, c), c.ta0, c.ta1, c.tb0, c.tb1, 0, 0, -MbB, 0.f, o, DM, lam, 1.0f - lam_init, subln, pre);
        } else {
            const float lx = __builtin_amdgcn_exp2f(inp(F, I_SINK)[c.hsel] * LOG2E);
            attn_unit<64, 64, 0, 0, AT_KSO_A>(F.lds, qr, att_K(F, c), att_V(F, c), c.ta0, c.ta1, c.tb0, c.tb1, c.qpos0, c.win, -MbA, lx, (bf16_t*)(F.ws + WS_MIX) + c.m0 * DM + 64 * c.hsel, DM, 0.f, 0.f, subln, pre);
        }
#pragma unroll
        for (int d = 0; d < 4; ++d) qr[d] = qn[d];
    }
}
__device__ __forceinline__ void phase_diff_combine(Frame& F) {
    const int lane = ltid() & 63;
    const int gw = F.vcu * NWAVES + F.wave;
    float s1 = inp(F, I_LQ1)[lane] * inp(F, I_LK1)[lane], s2 = inp(F, I_LQ2)[lane] * inp(F, I_LK2)[lane];
    s1 = wave_sum(s1); s2 = wave_sum(s2);
    const float lam_init = 0.8f - 0.6f * 1.0f  , lam = expf(s1) - expf(s2) + lam_init;
    const bf16_t* OB = (const bf16_t*)(F.ws + WS_OB); bf16_t* MIXp = (bf16_t*)(F.ws + WS_MIX);
    const int h = lane >> 4, d8 = (lane & 15) * 8;
    f32x4 g0 = *(const f32x4*)(inp(F, I_SUBLN) + d8), g1 = *(const f32x4*)(inp(F, I_SUBLN) + d8 + 4);
    for (int m = gw * 17; m < gw * 17 + 17; ++m) {
        const u32x4 a = *(const u32x4*)(OB + (size_t)m * DM + (2 * h) * 128 + d8), bq = *(const u32x4*)(OB + (size_t)m * DM + (2 * h + 1) * 128 + d8);
        float v[8]; float ss = 0.f;
#pragma unroll
        for (int j = 0; j < 4; ++j) { const float a0 = __builtin_bit_cast(float, a[j] << 16), a1 = __builtin_bit_cast(float, a[j] & 0xffff0000u), b0 = __builtin_bit_cast(float, bq[j] << 16), b1 = __builtin_bit_cast(float, bq[j] & 0xffff0000u);
            v[2 * j] = a0 - lam * b0; v[2 * j + 1] = a1 - lam * b1; ss += v[2 * j] * v[2 * j] + v[2 * j + 1] * v[2 * j + 1]; }
        ss += shx<1>(ss); ss += shx<2>(ss); ss += shx<4>(ss); ss += shx<8>(ss);
        const float rs = (1.0f - lam_init) / sqrtf(ss * (1.f / 128.f) + EPS);
        const f32x4 o0 = (f32x4){v[0], v[1], v[2], v[3]} * rs * g0, o1 = (f32x4){v[4], v[5], v[6], v[7]} * rs * g1;
        *(u32x4*)(MIXp + (size_t)m * DM + 512 + 128 * h + d8) = pack8(o0, o1);
    }
}

template <int ABL = 0> __device__ __forceinline__ void phase_attn_mla(Frame& F) {
    const float a = gain_absmax64(inp(F, I_QNN)), b2 = gain_absmax64(inp(F, I_QNR)), c = gain_absmax64(inp(F, I_KNN)), d = gain_absmax64(inp(F, I_KNR));
    const float Mb = 0.08838834764831845f * 64.0f * sqrtf((a * a + b2 * b2) * (c * c + d * d)) * LOG2E;
    const bf16_t* Q2 = (const bf16_t*)(F.ws + WS_Q2); bf16_t* MIXp = (bf16_t*)(F.ws + WS_MIX);
    bf16x8 qr[8];
    const auto mla_pre = [&](int i, bf16x8 (&q)[8]) { const int idx = F.vcu + 256 * i, j = idx >> 4, qb = idx & 15, b = j >> 2, h = j & 3; const size_t m0 = (size_t)b * SEQ + 256 * qb + 32 * F.wave;
        attn_pre<128, 128>(F.lds, Q2 + m0 * 512 + 128 * h, 512, F.ws + WS_KD + (size_t)(b * 4 + h) * NKT * 16384, F.ws + WS_VD + (size_t)(b * 4 + h) * NKT * 16384, 0, q); };
    mla_pre(0, qr);
    for (int i = 0; i < 2; ++i) { const int idx = F.vcu + 256 * i, j = idx >> 4, qb = idx & 15, b = j >> 2, h = j & 3;
        const size_t m0 = (size_t)b * SEQ + 256 * qb + 32 * F.wave;
        bf16x8 qn[8];
#pragma unroll
        for (int d = 0; d < 8; ++d) qn[d] = qr[d];
        const auto pre = [&]() { if (i + 1 < 2) mla_pre(i + 1, qn); };
        attn_unit<128, 128, 0, ABL, AT_KSO_MLA>(F.lds, qr, F.ws + WS_KD + (size_t)(b * 4 + h) * NKT * 16384, F.ws + WS_VD + (size_t)(b * 4 + h) * NKT * 16384,
                                   0, NKT, 0, 0, 0, 0, -Mb, 0.f, MIXp + m0 * DM + 512 + 128 * h, DM, 0.f, 0.f, (const float*)nullptr, pre);
#pragma unroll
        for (int d = 0; d < 8; ++d) qr[d] = qn[d]; }
}

__device__ __forceinline__ void phase_spatial(Frame& F) {
    const int tid = ltid(), lane = tid & 63, r32 = lane & 31, hi = lane >> 5, w = F.wave, pb = w >> 1, cb0 = 2 * (w & 1);
    const bf16_t* UACT = (const bf16_t*)(F.ws + WS_UACT); const bf16_t* VACT = (const bf16_t*)(F.ws + WS_VACT); const float* VSS = (const float*)(F.ws + WS_VSS);
    const bf16_t* WS = (const bf16_t*)(F.ws + WS_W_S); bf16_t* MIXp = (bf16_t*)(F.ws + WS_MIX);
    const float* cvn = inp(F, I_CVN); const float* cbs = inp(F, I_CBS);
    LAS float* rsl = (LAS float*)(F.lds + MISC_OFF + 1024);
    LAS float* bsl = (LAS float*)(F.lds + MISC_OFF + 2048);
    bsl[tid] = cbs[tid];
    for (int idx = F.vcu; idx < MLAT / 128; idx += F.G) {
        const size_t m0 = (size_t)idx * 128;
        if (tid < 128) { const f32x4 s0 = *(const f32x4*)(VSS + (m0 + tid) * 8), s1 = *(const f32x4*)(VSS + (m0 + tid) * 8 + 4);
            rsl[tid] = 1.0f / sqrtf((((s0[0] + s0[1]) + (s0[2] + s0[3])) + ((s1[0] + s1[1]) + (s1[2] + s1[3]))) * (1.f / 512.f) + EPS); }
        const int c8 = (tid & 63) * 8, g_ = c8 >> 7, cl = c8 & 127;
        u32x4 raw[16];
#pragma unroll
        for (int i = 0; i < 16; ++i) raw[i] = *(const u32x4*)(VACT + (m0 + w + 8 * i) * 512 + c8);
        const f32x4 g0 = *(const f32x4*)(cvn + c8), g1 = *(const f32x4*)(cvn + c8 + 4);
        const __amdgpu_buffer_rsrc_t urs = __builtin_amdgcn_make_buffer_rsrc((void*)(UACT + m0 * 512), (short)0, 128 * 512 * 2, 0x00020000), ors = __builtin_amdgcn_make_buffer_rsrc((void*)(MIXp + m0 * DM), (short)0, 128 * DM * 2, 0x00020000);
        const unsigned uoff = (unsigned)(((32 * pb + 4 * hi) * 512 + 32 * cb0 + r32) * 2), ooff = (unsigned)(((32 * pb + 4 * hi) * DM + 32 * cb0 + r32) * 2);
        unsigned short uA[32], uB[32];
#define SP_ULOAD(U, g) do { _Pragma("unroll") for (int r = 0; r < 16; ++r) _Pragma("unroll") for (int ci = 0; ci < 2; ++ci) U[r * 2 + ci] = (unsigned short)__builtin_amdgcn_raw_buffer_load_b16(urs, uoff, (((r & 3) + 8 * (r >> 2)) * 512 + 128 * (g) + 32 * ci) * 2, 0); } while (0)
        SP_ULOAD(uA, 0);
        s16x4 wA[16];
#define SP_WLOAD(Wf, g) do { const bf16_t* wrow_ = WS + ((size_t)(g) * 128 + 32 * pb + r32) * 128 + 4 * hi; _Pragma("unroll") for (int ks = 0; ks < 8; ++ks) { Wf[2 * ks] = *(const s16x4*)(wrow_ + 16 * ks); Wf[2 * ks + 1] = *(const s16x4*)(wrow_ + 16 * ks + 8); } } while (0)
        SP_WLOAD(wA, 0);
        __syncthreads();
        const lds_ptr vdst = F.lds + g_ * 32768 + (cl >> 5) * 8192 + w * 64 + (cl & 31) * 2;
#pragma unroll
        for (int i = 0; i < 16; ++i) { const float rs = rsl[w + 8 * i]; f32x4 a, bq; unpack8(raw[i], a, bq);
            *(LAS u32x4*)(vdst + (i >> 1) * 1024 + (i & 1) * 512) = pack8(a * rs * g0, bq * rs * g1); }
        __syncthreads();
#define SP_GROUP(g, UC, UN, WC, WN) do { \
            asm volatile("" ::: "memory");     \
            if ((g) < 3) { SP_ULOAD(UN, (g) + 1); } \
            asm volatile("" ::: "memory"); \
            f32x16 acc[2]; \
            _Pragma("unroll") for (int r = 0; r < 16; ++r) { acc[0][r] = 0.f; acc[1][r] = 0.f; } \
            const lds_cptr vp = (lds_cptr)F.lds + (g) * 32768 + ((lane >> 4) & 1) * 32 + (lane & 3) * 8 + (4 * hi + ((lane & 15) >> 2)) * 64; \
            _Pragma("unroll") for (int ks = 0; ks < 8; ++ks) { const s16x4 alo = WC[2 * ks], ahi = WC[2 * ks + 1]; \
                const bf16x8 af = (bf16x8){alo[0], alo[1], alo[2], alo[3], ahi[0], ahi[1], ahi[2], ahi[3]}; \
                _Pragma("unroll") for (int ci = 0; ci < 2; ++ci) { const s16x4 lo = vtr(vp + (cb0 + ci) * 8192 + ks * 1024), hh = vtr(vp + (cb0 + ci) * 8192 + ks * 1024 + 512); \
                    const bf16x8 vf = (bf16x8){lo[0], lo[1], lo[2], lo[3], hh[0], hh[1], hh[2], hh[3]}; \
                    acc[ci] = __builtin_amdgcn_mfma_f32_32x32x16_bf16(af, vf, acc[ci], 0, 0, 0); } } \
            asm volatile("" ::: "memory"); if ((g) < 3) { SP_WLOAD(WN, (g) + 1); } asm volatile("" ::: "memory"); \
            _Pragma("unroll") for (int r = 0; r < 16; ++r) { const int p = 32 * pb + crow(r, hi); const float bsv = bsl[(g) * 128 + p]; \
                _Pragma("unroll") for (int ci = 0; ci < 2; ++ci) \
                    __builtin_amdgcn_raw_buffer_store_b16((short)f2bf(bf2f(UC[r * 2 + ci]) * (acc[ci][r] + bsv)), ors, ooff, (((r & 3) + 8 * (r >> 2)) * DM + 128 * (g) + 32 * ci) * 2, 0); } } while (0)
        SP_GROUP(0, uA, uB, wA, wA); SP_GROUP(1, uB, uA, wA, wA); SP_GROUP(2, uA, uB, wA, wA); SP_GROUP(3, uB, uA, wA, wA);
#undef SP_GROUP
#undef SP_ULOAD
#undef SP_WLOAD
        __syncthreads();
    }
}

constexpr int N_PHASES = 17;
struct Args { const float* in[34]; float* out; unsigned char* ws; };
#ifndef DBG_PH_END
#define DBG_PH_END 17
#endif
#ifndef DBG_CHK
#define DBG_CHK 0
#endif
__global__ void __launch_bounds__(NTHR, 2) fwd(Args args) {
    extern __shared__ __attribute__((aligned(16))) unsigned char lds_raw[];
#if CODE_PF && !DBG_CHK
    u32x4 code_pf_;
    { unsigned long long pc_; asm volatile("s_getpc_b64 %0" : "=s"(pc_));
      const unsigned char* cb_ = (const unsigned char*)(pc_ & ~255ull); constexpr int CH_ = CODE_PF_BYTES / 32;
      code_pf_ = (u32x4){0u, 0u, 0u, 0u};
      if ((int)threadIdx.x < CH_ / 16) code_pf_ = *(const u32x4*)(cb_ + (blockIdx.x >> 3) * CH_ + threadIdx.x * 16); }
#endif
    const unsigned long long ts_entry_ = TS_PHASE == 119 ? __builtin_amdgcn_s_memrealtime() : 0ull; (void)ts_entry_;
    const lds_ptr lds = (lds_ptr)lds_raw;
    volatile LAS unsigned* MISC = (volatile LAS unsigned*)(lds + MISC_OFF);
    const int tid0 = threadIdx.x;
    if (tid0 == 0) {
#pragma unroll
        for (int i = 0; i < 34; ++i) ((LAS unsigned long long*)(lds + PTR_OFF))[i] = (unsigned long long)args.in[i];
        ((LAS unsigned long long*)(lds + PTR_OFF))[34] = (unsigned long long)args.ws; ((LAS unsigned long long*)(lds + PTR_OFF))[35] = (unsigned long long)args.out; }
    for (int u = tid0; u < 128; u += NTHR) MISC[u] = 0u;
    LAS f32x2* T = (LAS f32x2*)(lds + ROPE_OFF);
    for (int e = tid0; e < 1024; e += NTHR) { const int pos = e >> 4, fi = e & 15; const float inv = powf(10000.f, -(float)fi / 16.f), ang = (float)pos * inv; T[e] = (f32x2){cosf(ang), sinf(ang)}; }
    __syncthreads();
#if CODE_PF && !DBG_CHK
    asm volatile("" :: "v"(code_pf_));
#endif
#if DBG_CHK
    { XcdBarrier b0 = xcd_barrier_post((unsigned*)(args.ws + WS_CTL) + CW_BAR, MISC + 8); (void)b0; }
#else
    if (blockIdx.x == 0) for (int u = tid0; u < XCD_BAR_WORDS; u += NTHR) __hip_atomic_store((unsigned*)(args.ws + WS_CTL) + CW_BAR + u, 0u, __ATOMIC_RELAXED, __HIP_MEMORY_SCOPE_AGENT);
#endif
#if GS_AT_START && !DBG_CHK
    cooperative_groups::this_grid().sync();
    { XcdBarrier b0 = xcd_barrier_post((unsigned*)(args.ws + WS_CTL) + CW_BAR, MISC + 8); (void)b0; }
#endif
    constexpr int lo = 0, hi = DBG_PH_END;
#ifndef PH_MASK
#define PH_MASK 0x1ffff
#endif
#define IN(k) (((PH_MASK >> (k)) & 1) && lo <= (k) && (k) < hi)
#ifndef TS_PHASE
#define TS_PHASE -1
#endif
#ifndef TS_BLOCK
#define TS_BLOCK 0
#endif
#define TSTAMP(k) do { if (TS_PHASE >= 0 && ((TS_PHASE == 99 && ((k) == -1 || (k) == 16)) || (TS_PHASE >= 100 && TS_PHASE < 110 && (k) == 11) || ((k) + 1 >= TS_PHASE && (k) <= TS_PHASE)) && blockIdx.x == TS_BLOCK && threadIdx.x == 0) ((volatile LAS unsigned long long*)(lds + MISC_OFF + 256))[(k) + 1] = TS_CLK ? __builtin_amdgcn_s_memtime() : __builtin_amdgcn_s_memrealtime(); } while (0)
#define SUBTS(i) do { if (TS_PHASE >= 100 && TS_PHASE < 110 && blockIdx.x == TS_BLOCK && threadIdx.x == 0) ((volatile LAS unsigned long long*)(lds + MISC_OFF + 256))[(i)] = __builtin_amdgcn_s_memrealtime(); } while (0)
#define SEAM(k) do { const unsigned long long tsm0_ = (TS_PHASE >= 115 && TS_PHASE <= 118) ? __builtin_amdgcn_s_memrealtime() : 0ull; if (IN(k) && IN((k) + 1)) { if ((k) == 0 && DBG_CHK == 0 && !GS_AT_START) cooperative_groups::this_grid().sync(); else { XcdBarrier bar; bar.bar = (unsigned*)(mkframe().ws + WS_CTL) + CW_BAR; bar.x = xb_xcc_id(); bar.st = (volatile LAS unsigned*)(lds + MISC_OFF) + 8; xcd_barrier(bar); } } asm volatile("" ::: "memory"); if ((TS_PHASE == 115 || (TS_PHASE == 116 && (k) != 0)) && blockIdx.x == TS_BLOCK && threadIdx.x == 0) ((volatile LAS unsigned long long*)(lds + MISC_OFF + 256))[19] += __builtin_amdgcn_s_memrealtime() - tsm0_; if ((TS_PHASE == 117 || TS_PHASE == 118) && (k) >= TS_SEAM_LO && (k) <= TS_SEAM_HI && (k) != TS_SEAM_SKIP && blockIdx.x == TS_BLOCK && threadIdx.x == 0) { volatile LAS unsigned long long* ts_ = (volatile LAS unsigned long long*)(lds + MISC_OFF + 256); const unsigned long long w_ = __builtin_amdgcn_s_memrealtime() - tsm0_; if (w_ > ts_[18]) { ts_[18] = w_; ts_[20] = (unsigned long long)((k) - TS_SEAM_LO + 1); } } } while (0)
#ifndef PH_REP
#define PH_REP 0
#endif
#define REPBAR() do { XcdBarrier bar; bar.bar = (unsigned*)(mkframe().ws + WS_CTL) + CW_BAR; bar.x = xb_xcc_id(); bar.st = (volatile LAS unsigned*)(lds + MISC_OFF) + 8; xcd_barrier(bar); asm volatile("" ::: "memory"); } while (0)
#define FRAME() Frame F = mkframe(); const float* MOD = (const float*)(F.ws + WS_MOD); bf16_t* XR = (bf16_t*)(F.ws + WS_XR); const bf16_t* HN = (const bf16_t*)(F.ws + WS_HN); (void)MOD; (void)XR; (void)HN

    TSTAMP(-1);
    if (TS_PHASE == 119 && blockIdx.x == TS_BLOCK && threadIdx.x == 0) ((volatile LAS unsigned long long*)(lds + MISC_OFF + 256))[21] = __builtin_amdgcn_s_memrealtime() - ts_entry_;
    if (IN(0)) for (int rep_ = 0; rep_ <= ((PH_REP >> (0)) & 1); ++rep_) { if (rep_) REPBAR(); FRAME(); p0_prologue(F); }
    SEAM(0); TSTAMP(0);
#if !DBG_CHK && !GS_AT_START
    { XcdBarrier b0 = xcd_barrier_post((unsigned*)(args.ws + WS_CTL) + CW_BAR, MISC + 8); (void)b0; }
#endif
    if (IN(1)) for (int rep_ = 0; rep_ <= ((PH_REP >> (1)) & 1); ++rep_) { if (rep_) REPBAR(); FRAME(); mod_reduce(F); REPBAR();
        ln_phase<false>(F, 0, 0, inp(F, I_N1G), inp(F, I_X), inp(F, I_CTX), MALL, false, XR + (size_t)MLAT * DM); }
    SEAM(1); TSTAMP(1);
    if (IN(2)) for (int rep_ = 0; rep_ <= ((PH_REP >> (2)) & 1); ++rep_) { if (rep_) REPBAR(); FRAME(); Gemm g{HN, (const bf16_t*)(F.ws + WS_W_EV), MALL, 2304, DM}; pg8::StaticOrder S; S.init(MALL, 2304, F.G, obx());
        EpiEven E{F.ws, F.lds, 0.125f * LOG2E};
        pg8::gemm_phase<EpiEven, pg8::StaticOrder, PG8_ALIGN, PG8_SP2>(F.lds, g, S, E); }
    SEAM(2); TSTAMP(2);
    if (IN(3)) for (int rep_ = 0; rep_ <= ((PH_REP >> (3)) & 1); ++rep_) { if (rep_) REPBAR(); FRAME(); phase_attn_even(F); }
    SEAM(3); TSTAMP(3); TSTAMP(4);
    if (IN(5)) for (int rep_ = 0; rep_ <= ((PH_REP >> (5)) & 1); ++rep_) { if (rep_) REPBAR(); FRAME(); Gemm g{(const bf16_t*)(F.ws + WS_MIX), (const bf16_t*)(F.ws + WS_W_MIX), MALL, DM, DM}; SplitOrder S; S.init(DM, F.G, obx());
        EpiResid<false, true> E{inp(F, I_X), inp(F, I_CTX), XR, XR + (size_t)MLAT * DM, MOD + 2 * DM, (float*)(F.ws + WS_PART)};
        pg8::gemm_phase<EpiResid<false, true>, SplitOrder, PG8_ALIGN, PG8_SP2>(F.lds, g, S, E); }
    SEAM(5); TSTAMP(5);
    if (IN(6)) for (int rep_ = 0; rep_ <= ((PH_REP >> (6)) & 1); ++rep_) { if (rep_) REPBAR(); FRAME(); ln_phase<true>(F, 0, 3, inp(F, I_N2G), XR, XR + (size_t)MLAT * DM, MALL, false, XR + (size_t)MLAT * DM, (const float*)(F.ws + WS_PART)); }
    SEAM(6); TSTAMP(6);
    if (IN(7)) for (int rep_ = 0; rep_ <= ((PH_REP >> (7)) & 1); ++rep_) { if (rep_) REPBAR(); FRAME(); Gemm g{HN, (const bf16_t*)(F.ws + WS_W_FI), MALL, 2 * FFH, DM}; pg8::StaticOrder S; S.init(MALL, 2 * FFH, F.G, obx());
        EpiSwiglu E{(bf16_t*)(F.ws + WS_ACT)};
        pg8::gemm_phase<EpiSwiglu, pg8::StaticOrder, PG8_ALIGN, PG8_SP2>(F.lds, g, S, E); }
    SEAM(7); TSTAMP(7);
    if (IN(8)) for (int rep_ = 0; rep_ <= ((PH_REP >> (8)) & 1); ++rep_) { if (rep_) REPBAR(); FRAME(); int KF = FFH; asm volatile("" : "+s"(KF));
        Gemm g{(const bf16_t*)(F.ws + WS_ACT), (const bf16_t*)(F.ws + WS_W_FO), MALL, DM, KF}; SplitOrder S; S.init(KF, F.G, obx());
        EpiResid<true, true> E{XR, XR + (size_t)MLAT * DM, XR, XR + (size_t)MLAT * DM, MOD + 5 * DM, (float*)(F.ws + WS_PART)};
        pg8::gemm_phase<EpiResid<true, true>, SplitOrder, PG8_ALIGN, PG8_SP2>(F.lds, g, S, E); }
    SEAM(8); TSTAMP(8);
    if (IN(9)) for (int rep_ = 0; rep_ <= ((PH_REP >> (9)) & 1); ++rep_) { if (rep_) REPBAR(); FRAME(); ln_phase<true>(F, 1, 0, inp(F, I_N1G) + DM, XR, XR + (size_t)MLAT * DM, MALL, false, XR + (size_t)MLAT * DM, (const float*)(F.ws + WS_PART)); }
    SEAM(9); TSTAMP(9);
    if (IN(10)) for (int rep_ = 0; rep_ <= ((PH_REP >> (10)) & 1); ++rep_) { if (rep_) REPBAR(); FRAME(); Gemm g{HN, (const bf16_t*)(F.ws + WS_W_OD), MALL, 1792, DM}; OddOrder S; S.init(F.G, obx());
        EpiOdd E{F.ws, F.lds};
        pg8::gemm_phase<EpiOdd, OddOrder, PG8_ALIGN, PG8_SP2>(F.lds, g, S, E); }
    SEAM(10); TSTAMP(10);
    if (IN(11)) for (int rep_ = 0; rep_ <= ((PH_REP >> (11)) & 1); ++rep_) { if (rep_) REPBAR(); FRAME();
        int K256 = 256; asm volatile("" : "+s"(K256));
        SUBTS(20);
        { Gemm g{(const bf16_t*)(F.ws + WS_CQ), (const bf16_t*)(F.ws + WS_W_UQ), MLAT + MALL, 1280, K256}; UqkvOrder S; S.init(F.G, obx());
          EpiUqkv E{EpiUq{F.ws, F.lds, 0.08838834764831845f * LOG2E}, EpiUkv{F.ws, F.lds}};
          pg8::gemm_phase<EpiUqkv, UqkvOrder, PG8_ALIGN, PG8_SP2>(F.lds, g, S, E); }
        SUBTS(21);
        SUBTS(22);
        phase_spatial(F);
        SUBTS(23);
        if ((PH_REP >> 17) & 1) { REPBAR(); phase_spatial(F); }
        if ((PH_REP >> 18) & 1) { REPBAR();
          { Gemm g{(const bf16_t*)(F.ws + WS_CQ), (const bf16_t*)(F.ws + WS_W_UQ), MLAT, 512, K256}; pg8::StaticOrder S; S.init(MLAT, 512, F.G, obx()); EpiUq E{F.ws, F.lds, 0.08838834764831845f * LOG2E}; pg8::gemm_phase<EpiUq, pg8::StaticOrder, PG8_ALIGN, PG8_SP2>(F.lds, g, S, E); }
          { Gemm g{(const bf16_t*)(F.ws + WS_CKV), (const bf16_t*)(F.ws + WS_W_UKV), MALL, 768, K256}; pg8::StaticOrder S; S.init(MALL, 768, F.G, obx()); EpiUkv E{F.ws, F.lds}; pg8::gemm_phase<EpiUkv, pg8::StaticOrder, PG8_ALIGN, PG8_SP2>(F.lds, g, S, E); } }
        if ((PH_REP >> 19) & 1) { REPBAR();
          { Gemm g{(const bf16_t*)(F.ws + WS_CQ), (const bf16_t*)(F.ws + WS_W_UQ), MLAT, 512, K256}; pg8::StaticOrder S; S.init(MLAT, 512, F.G, obx()); EpiNull E; pg8::gemm_phase<EpiNull, pg8::StaticOrder, PG8_ALIGN, PG8_SP2>(F.lds, g, S, E); }
          { Gemm g{(const bf16_t*)(F.ws + WS_CKV), (const bf16_t*)(F.ws + WS_W_UKV), MALL, 768, K256}; pg8::StaticOrder S; S.init(MALL, 768, F.G, obx()); EpiNull E; pg8::gemm_phase<EpiNull, pg8::StaticOrder, PG8_ALIGN, PG8_SP2>(F.lds, g, S, E); } }
    }
    SEAM(11); TSTAMP(11);
#if AT_ABL
    if (IN(12)) { FRAME(); phase_attn_mla<AT_ABL>(F); REPBAR(); if (blockIdx.x == TS_BLOCK && threadIdx.x == 0) ((volatile LAS unsigned long long*)(lds + MISC_OFF + 256))[13] = __builtin_amdgcn_s_memrealtime(); phase_attn_mla<0>(F); }
    SEAM(12);
#else
    if (IN(12)) for (int rep_ = 0; rep_ <= ((PH_REP >> (12)) & 1); ++rep_) { if (rep_) REPBAR(); FRAME(); phase_attn_mla<0>(F); }
    SEAM(12); TSTAMP(12);
#endif
    if (IN(13)) for (int rep_ = 0; rep_ <= ((PH_REP >> (13)) & 1); ++rep_) { if (rep_) REPBAR(); FRAME(); Gemm g{(const bf16_t*)(F.ws + WS_MIX), (const bf16_t*)(F.ws + WS_W_MIX + 2 * MiB), MLAT, DM, DM}; pg8::StaticOrder S; S.init(MLAT, DM, F.G, obx());
        EpiResid<true, true> E{XR, XR, XR, XR, MOD + 9 * 6144 + 2 * DM, nullptr};
        pg8::gemm_phase<EpiResid<true, true>, pg8::StaticOrder, PG8_ALIGN, PG8_SP2>(F.lds, g, S, E); }
    SEAM(13); TSTAMP(13);
    if (IN(14)) for (int rep_ = 0; rep_ <= ((PH_REP >> (14)) & 1); ++rep_) { if (rep_) REPBAR(); FRAME(); ln_phase<true>(F, 1, 3, inp(F, I_N2G) + DM, XR, XR, MLAT, false); }
    SEAM(14); TSTAMP(14);
    if (IN(15)) for (int rep_ = 0; rep_ <= ((PH_REP >> (15)) & 1); ++rep_) { if (rep_) REPBAR(); FRAME(); Gemm g{HN, (const bf16_t*)(F.ws + WS_W_FI + 11 * MiB), MLAT, 2 * FFH, DM}; pg8::StaticOrder S; S.init(MLAT, 2 * FFH, F.G, obx());
        EpiSwiglu E{(bf16_t*)(F.ws + WS_ACT)};
        pg8::gemm_phase<EpiSwiglu, pg8::StaticOrder, PG8_ALIGN, PG8_SP2>(F.lds, g, S, E); }
    SEAM(15); TSTAMP(15);
    if (IN(16)) for (int rep_ = 0; rep_ <= ((PH_REP >> (16)) & 1); ++rep_) { if (rep_) REPBAR(); FRAME(); Gemm g{(const bf16_t*)(F.ws + WS_ACT), (const bf16_t*)(F.ws + WS_W_FO + 6 * MiB), MLAT, DM, FFH}; pg8::StaticOrder S; S.init(MLAT, DM, F.G, obx());
        EpiResid<true, false> E{XR, XR, F.out, F.out, MOD + 9 * 6144 + 5 * DM, nullptr};
        pg8::gemm_phase<EpiResid<true, false>, pg8::StaticOrder, PG8_ALIGN, PG8_SP2>(F.lds, g, S, E); }
    if (TS_PHASE >= 0) { TSTAMP(16); REPBAR();
        if (blockIdx.x == TS_BLOCK && threadIdx.x == 0) { volatile LAS unsigned long long* ts = (volatile LAS unsigned long long*)(lds + MISC_OFF + 256); const float us = TS_PHASE == 119 ? (float)ts[21] * 0.01f : TS_PHASE == 118 ? (float)ts[18] * 0.1f : TS_PHASE == 117 ? ((float)ts[20] * 10.f + fminf((float)ts[18] * 0.001f, 9.f)) * 100.f : TS_PHASE == 113 ? (float)ts[29] * 0.1f : (TS_PHASE == 115 || TS_PHASE == 116) ? (float)ts[19] * 0.01f : TS_PHASE == 110 ? (float)ts[28] * 0.1f : TS_PHASE == 111 ? (float)ts[29] * 0.01f : TS_PHASE == 112 ? (float)ts[30] * 0.01f : TS_PHASE == 105 ? (float)ts[24] * 0.1f : TS_PHASE == 106 ? (float)ts[25] * 0.01f : TS_PHASE == 107 ? (float)ts[26] * 0.1f : TS_PHASE == 108 ? (float)ts[27] * 10.f : TS_PHASE == 99 ? (float)(ts[17] - ts[0]) * 0.01f - 2000.f : TS_PHASE == 101 ? (float)(ts[21] - ts[20]) * 0.1f : TS_PHASE == 102 ? (float)(ts[22] - ts[21]) * 0.1f : TS_PHASE == 103 ? (float)(ts[23] - ts[22]) * 0.1f : TS_PHASE == 104 ? (float)(ts[12] - ts[23]) * 0.1f : (float)(ts[TS_PHASE < 100 ? TS_PHASE + 1 : 0] - ts[TS_PHASE < 100 ? TS_PHASE : 0]) * 0.01f; mkframe().out[0] += (us - (float)TS_SUB) * 0.01f * TS_SCALE; } }
#undef IN
#undef SEAM
#undef FRAME
}
}

#ifndef DBG_CHK
#define DBG_CHK 0
#endif
#ifndef DBG_PH_END
#define DBG_PH_END 17
#endif

#if DBG_CHK
namespace dbg {
using namespace mk;
constexpr int RS = 3, NRS = (nv::R + RS - 1) / RS;
__device__ __forceinline__ size_t mrow(int r) { return r < 4096 ? (size_t)r : (size_t)MLAT + (r - 4096); }
__device__ __forceinline__ float kimg_get(const unsigned char* base, int slot_bytes, int bh, int r, int d) {
    const int kt = r >> 6, kk = r & 63; const unsigned char* img = base + ((size_t)bh * NKT + kt) * slot_bytes; return bf2f(*(const bf16_t*)(img + (d >> 3) * 1024 + kk * 16 + (d & 7) * 2)); }
__device__ __forceinline__ float vimg_get(const unsigned char* base, int slot_bytes, int bh, int r, int dv) {
    const int kt = r >> 6, kk = r & 63; const unsigned char* img = base + ((size_t)bh * NKT + kt) * slot_bytes; return bf2f(*(const bf16_t*)(img + (dv >> 5) * 4096 + (kk >> 4) * 1024 + (kk & 15) * 64 + (dv & 31) * 2)); }
template <int CHK> __device__ __forceinline__ int ncols() { return CHK == 2 ? 2304 : CHK == 6 ? 2048 : 1024; }
template <int CHK> __global__ void k_snap(const unsigned char* ws, float* SNAP) {
    const int NC = ncols<CHK>(); const size_t idx = (size_t)blockIdx.x * 256 + threadIdx.x; if (idx >= (size_t)NRS * NC) return;
    const int rs = (int)(idx / NC), c = (int)(idx % NC), r = rs * RS; const size_t m = mrow(r); float v = 0.f;
    if (CHK == 1) v = bf2f(((const bf16_t*)(ws + WS_HN))[m * DM + c]);
    else if (CHK == 2) {
        if (c < 1024) v = bf2f(((const bf16_t*)(ws + WS_Q))[m * DM + c]) / (0.125f * LOG2E);
        else if (c < 1152) v = kimg_get(ws + WS_KA, 8192, (c - 1024) >> 6, r, c & 63);
        else if (c < 1280) v = vimg_get(ws + WS_VA, 8192, (c - 1152) >> 6, r, c & 63);
        else if (c < 1792) v = kimg_get(ws + WS_KB, 8192, (c - 1280) >> 6, r, c & 63);
        else v = vimg_get(ws + WS_VB, 16384, (c - 1792) >> 7, r, (c - 1792) & 127);
    } else if (CHK == 3 || CHK == 7) v = bf2f(((const bf16_t*)(ws + WS_MIX))[m * DM + c]);
    else if (CHK == 4 || CHK == 5) v = bf2f(((const bf16_t*)(ws + WS_XR))[m * DM + c]);
    else if (CHK == 6) {
        if (c < 512) v = r < 4096 ? bf2f(((const bf16_t*)(ws + WS_Q2))[m * 512 + c]) / (0.08838834764831845f * LOG2E) : 0.f;
        else if (c < 1024) v = kimg_get(ws + WS_KD, 16384, (c - 512) >> 7, r, (c - 512) & 127);
        else if (c < 1536) v = vimg_get(ws + WS_VD, 16384, (c - 1024) >> 7, r, (c - 1024) & 127);
        else v = r < 4096 ? bf2f(((const bf16_t*)(ws + WS_MIX))[m * DM + (c - 1536)]) : 0.f;
    }
    SNAP[idx] = v;
}
template <int CHK> __global__ void k_cmp(nv::Bufs B, const float* SNAP, unsigned* res) {
    const int NC = ncols<CHK>(); const size_t idx = (size_t)blockIdx.x * 256 + threadIdx.x; if (idx >= (size_t)NRS * NC) return;
    const int rs = (int)(idx / NC), c = (int)(idx % NC), r = rs * RS; float ref = 0.f; bool skip = false;
    if (CHK == 1) ref = B.H[(size_t)r * 1024 + c];
    else if (CHK == 2) ref = B.PL[(size_t)r * 2304 + c];
    else if (CHK == 3) ref = B.MIX[(size_t)r * 1024 + c];
    else if (CHK == 7) { ref = B.MIX[(size_t)r * 1024 + c]; skip = r >= 4096; }
    else if (CHK == 4 || CHK == 5) ref = B.X[(size_t)r * 1024 + c];
    else if (CHK == 6) {
        if (c < 512) { ref = B.QU[(size_t)r * 512 + c]; skip = r >= 4096; }
        else if (c < 1024) ref = B.KC[(size_t)r * 512 + (c - 512)];
        else if (c < 1536) { const int h = (c - 1024) >> 7, dv = (c - 1024) & 127; ref = B.KVU[(size_t)r * 768 + h * 192 + 64 + dv]; }
        else { ref = B.MIX[(size_t)r * 1024 + (c - 1536)]; skip = r >= 4096; }
    }
    if (skip) return;
    const float d = fabsf(ref - SNAP[idx]);
    atomicMax(res + 0, __float_as_uint(d == d ? d : INFINITY)); atomicMax(res + 1, __float_as_uint(fabsf(ref)));
}
__global__ void k_cmp_mod(const float* modA, const float* modB, unsigned* res) {
    const int idx = blockIdx.x * 256 + threadIdx.x; if (idx >= 2 * 9 * 6144) return;
    const float d = fabsf(modA[idx] - modB[idx]); atomicMax(res + 0, __float_as_uint(d == d ? d : INFINITY)); atomicMax(res + 1, __float_as_uint(fabsf(modA[idx])));
}
__global__ void k_code(float* out, size_t n, const unsigned* res, float thresh) {
    const float md = __uint_as_float(res[0]), mr = __uint_as_float(res[1]); const float rel = md / fmaxf(mr, 1e-20f);
    float code = 0.f; if (!(rel <= thresh)) code = 10.f + log10f(fminf(fmaxf(rel, 1e-9f), 1e9f));
    if (mr == 0.f) code = 77.f;
    if (code == 0.f) return;
    for (size_t i = (size_t)blockIdx.x * 256 + threadIdx.x; i < n; i += (size_t)gridDim.x * 256) out[i] += code;
}
static float* g_snap; static unsigned* g_res; static const float* g_mod_mk;
static void hook(int k, const nv::Bufs& B, hipStream_t st) {
    if (k != DBG_CHK) return;
    const size_t n = (size_t)NRS * (DBG_CHK == 2 ? 2304 : DBG_CHK == 6 ? 2048 : 1024);
    hipLaunchKernelGGL(k_cmp<DBG_CHK>, dim3((unsigned)((n + 255) / 256)), dim3(256), 0, st, B, (const float*)g_snap, g_res);
    if (DBG_CHK == 1) hipLaunchKernelGGL(k_cmp_mod, dim3((2 * 9 * 6144 + 255) / 256), dim3(256), 0, st, (const float*)B.MOD, g_mod_mk, g_res);
}
}
#endif

extern "C" void kernel_launch(void* const* d_in, const int* in_sizes, int n_in, void* d_out, int out_size, void* d_ws, size_t ws_size, hipStream_t stream) {
    static int grid = 0;
    if (grid == 0) {
        int dev = 0, cus = 0, per_cu = 0;
        hipGetDevice(&dev); hipDeviceGetAttribute(&cus, hipDeviceAttributeMultiprocessorCount, dev);
        if (hipFuncSetAttribute((const void*)mk::fwd, hipFuncAttributeMaxDynamicSharedMemorySize, mk::LDS_BYTES) != hipSuccess) fprintf(stderr, "kernel_launch: hipFuncSetAttribute failed\n");
        if (hipOccupancyMaxActiveBlocksPerMultiprocessor(&per_cu, (const void*)mk::fwd, mk::NTHR, mk::LDS_BYTES) != hipSuccess || per_cu < 1) { fprintf(stderr, "kernel_launch: occupancy query says %d\n", per_cu); per_cu = 1; }
        (void)hipGetLastError();
        grid = cus * per_cu;
        if (grid != 256) fprintf(stderr, "kernel_launch: grid %d (cus %d x %d) != 256: the static work split assumes 256 workgroups\n", grid, cus, per_cu);
        if (n_in != 34 || ws_size < mk::WS_END) fprintf(stderr, "kernel_launch: unexpected n_in %d / ws_size %zu\n", n_in, ws_size);
    }
#if DBG_CHK
    hipMemsetAsync((char*)d_ws + mk::WS_CTL, 0, mk::CTL_ZERO_BYTES, stream);
#endif
    mk::Args a{};
    for (int i = 0; i < 34; ++i) a.in[i] = (const float*)d_in[i];
    a.out = (float*)d_out; a.ws = (unsigned char*)d_ws;
#if DBG_CHK
    {
        hipLaunchKernelGGL(mk::fwd, dim3(grid), dim3(mk::NTHR), mk::LDS_BYTES, stream, a);
        float* SNAP = (float*)((char*)d_ws + mk::WS_SNAP); unsigned* res = (unsigned*)((char*)d_ws + mk::WS_END - 4096);
        const size_t n = (size_t)dbg::NRS * (DBG_CHK == 2 ? 2304 : DBG_CHK == 6 ? 2048 : 1024);
        hipLaunchKernelGGL(dbg::k_snap<DBG_CHK>, dim3((unsigned)((n + 255) / 256)), dim3(256), 0, stream, (const unsigned char*)d_ws, SNAP);
        float* modc = (float*)((char*)d_ws + mk::WS_END - 1024 * 1024);
        hipMemcpyAsync(modc, (char*)d_ws + mk::WS_MOD, 2 * 9 * 6144 * 4, hipMemcpyDeviceToDevice, stream);
        hipMemsetAsync(res, 0, 64, stream);
        dbg::g_snap = SNAP; dbg::g_res = res; dbg::g_mod_mk = modc;
        nv::In I; const float** ip = (const float**)&I; for (int i = 0; i < 34; ++i) ip[i] = (const float*)d_in[i];
        nv::forward(I, (float*)d_out, (float*)d_ws, 0, 8, stream, dbg::hook);
        hipLaunchKernelGGL(dbg::k_code, dim3(1024), dim3(256), 0, stream, (float*)d_out, (size_t)out_size, (const unsigned*)res, 0.03f);
    }
#else
    void* args[] = {&a};
    hipError_t e = hipLaunchCooperativeKernel((const void*)mk::fwd, dim3(grid), dim3(mk::NTHR), args, mk::LDS_BYTES, stream);
    if (e != hipSuccess) fprintf(stderr, "kernel_launch: cooperative launch failed: %s (grid %d)\n", hipGetErrorString(e), grid);
#endif
}
```
